# Optimizing an MI355X kernel written in HIP

```python
import math
import jax, jax.numpy as jnp
from jax import lax
import numpy as np

D_MODEL = 1024
BATCH = 4
SEQ = 8192
DEPTH = 2

PLE_DIM = 256
MIX_WIDTH = D_MODEL
RET_HEAD_DIM = 128
RET_HEADS = (MIX_WIDTH // 2) // RET_HEAD_DIM
RET_WIDTH = RET_HEADS * RET_HEAD_DIM
MOBA_HEAD_DIM = 128
MOBA_HEADS = (MIX_WIDTH - RET_WIDTH) // MOBA_HEAD_DIM
MOBA_WIDTH = MOBA_HEADS * MOBA_HEAD_DIM
SPLIT_SIZES = [RET_WIDTH] * 4 + [MOBA_WIDTH] * 4
IN_WIDTH = sum(SPLIT_SIZES)
RET_CHUNK = 128
MOBA_BLOCK = 256
MOBA_TOPK = 3
MOBA_Q_CHUNK = 64
N_BUCKETS = 32
MAX_DISTANCE = 2048
ROPE_THETA = 10000.0
EPS = 1e-6
NEG_INF = -1e30

kernel_name = "hymba_retention_moba_hybrid"


def rms_norm(x, g=None):
    xf = x.astype(jnp.float32)
    y = xf * lax.rsqrt(jnp.mean(xf * xf, axis=-1, keepdims=True) + EPS)
    if g is not None:
        y = y * g.astype(jnp.float32)
    return y.astype(x.dtype)


def rotary(x, pos):
    half = x.shape[-1] // 2
    inv = ROPE_THETA ** (-jnp.arange(half, dtype=jnp.float32) / half)
    ang = pos.astype(jnp.float32)[:, None] * inv[None, :]
    cos = jnp.cos(ang)[None, :, None, :]
    sin = jnp.sin(ang)[None, :, None, :]
    x1, x2 = x[..., :half], x[..., half:]
    return jnp.concatenate([x1 * cos - x2 * sin, x1 * sin + x2 * cos], axis=-1)


def t5_bucket(n):
    max_exact = N_BUCKETS // 2
    nf = jnp.maximum(n, 1).astype(jnp.float32)
    large = max_exact + (jnp.log(nf / max_exact) / math.log(MAX_DISTANCE / max_exact)
                         * (N_BUCKETS - max_exact)).astype(jnp.int32)
    large = jnp.minimum(large, N_BUCKETS - 1)
    return jnp.where(n < max_exact, n, large)


def retention(q, k, v, gain):
    B, S, H, d = q.shape
    C = RET_CHUNK
    nc = S // C
    log_g = jnp.log1p(-jnp.power(2.0, -5.0 - jnp.arange(H, dtype=jnp.float32)))

    def chunks(t):
        return t.reshape(B, nc, C, H, d).transpose(0, 3, 1, 2, 4)

    qc, kc, vc = chunks(q), chunks(k * (d ** -0.5)), chunks(v)
    j = jnp.arange(C, dtype=jnp.float32)
    rel = j[:, None] - j[None, :]
    decay = jnp.where(rel >= 0, jnp.exp(log_g[:, None, None] * jnp.maximum(rel, 0.0)[None]), 0.0)
    s = jnp.einsum('bhcnd,bhcmd->bhcnm', qc, kc) * decay[None, :, None]
    inner = jnp.einsum('bhcnm,bhcme->bhcne', s, vc)
    k_dec = kc * jnp.exp(log_g[:, None] * (C - 1 - j)[None])[None, :, None, :, None]
    kv = jnp.einsum('bhcmd,bhcme->cbhde', k_dec, vc)
    chunk_decay = jnp.exp(log_g * C)[None, :, None, None]

    def step(state, kv_c):
        return state * chunk_decay + kv_c, state

    _, prev = lax.scan(step, jnp.zeros((B, H, d, d), jnp.float32), kv)
    q_dec = qc * jnp.exp(log_g[:, None] * (j + 1.0)[None])[None, :, None, :, None]
    cross = jnp.einsum('bhcnd,cbhde->bhcne', q_dec, prev)
    o = (inner + cross).transpose(0, 2, 3, 1, 4).reshape(B, S, H, d)
    mu = jnp.mean(o, axis=-1, keepdims=True)
    var = jnp.mean(jnp.square(o - mu), axis=-1, keepdims=True)
    o = (o - mu) * lax.rsqrt(var + EPS)
    return o.reshape(B, S, H * d) * gain.astype(jnp.float32)


def moba(q, k, v, rel_bias):
    B, S, H, d = q.shape
    BLK, QC = MOBA_BLOCK, MOBA_Q_CHUNK
    nb = -(-S // BLK)
    pad = nb * BLK - S
    q = q.transpose(0, 2, 1, 3) * (d ** -0.5)
    kp = jnp.pad(k.transpose(0, 2, 1, 3), ((0, 0), (0, 0), (0, pad), (0, 0)))
    vp = jnp.pad(v.transpose(0, 2, 1, 3), ((0, 0), (0, 0), (0, pad), (0, 0)))
    kb = kp.reshape(B, H, nb, BLK, d)
    vb = vp.reshape(B, H, nb, BLK, d)
    kmean = jnp.mean(kb, axis=3)

    qpos = jnp.arange(S)
    qblock = qpos // BLK
    gate = jnp.einsum('bhsd,bhnd->bhsn', q, kmean)
    past = jnp.arange(nb)[None, :] < qblock[:, None]
    gate = jnp.where(past[None, None], gate, NEG_INF)
    n_sel = min(MOBA_TOPK, nb)
    _, top_idx = lax.top_k(gate, n_sel)

    nq = S // QC
    qx = q.reshape(B, H, nq, QC, d).transpose(2, 0, 1, 3, 4)
    ix = top_idx.reshape(B, H, nq, QC, n_sel).transpose(2, 0, 1, 3, 4)
    bi = jnp.arange(B)[:, None, None, None]
    hi = jnp.arange(H)[None, :, None, None]
    offs = jnp.arange(BLK)
    bias_h = rel_bias.astype(jnp.float32).T

    def one_chunk(args):
        c, qc, ic = args
        qp = c * QC + jnp.arange(QC)
        qblk = (c * QC) // BLK
        ksel = kb[bi, hi, ic]
        vsel = vb[bi, hi, ic]
        kpos = ic[..., None] * BLK + offs
        dist = qp[None, None, :, None, None] - kpos
        ok = (ic < qblk)[..., None]
        s_sel = (jnp.einsum('bhqd,bhqnkd->bhqnk', qc, ksel)
                 + bias_h[hi[..., None], t5_bucket(jnp.maximum(dist, 0))])
        s_sel = jnp.where(ok, s_sel, NEG_INF).reshape(B, H, QC, n_sel * BLK)
        kown = lax.dynamic_index_in_dim(kb, qblk, axis=2, keepdims=False)
        vown = lax.dynamic_index_in_dim(vb, qblk, axis=2, keepdims=False)
        dist_own = qp[:, None] - (qblk * BLK + offs)[None, :]
        s_own = (jnp.einsum('bhqd,bhkd->bhqk', qc, kown)
                 + bias_h[:, t5_bucket(jnp.maximum(dist_own, 0))][None])
        s_own = jnp.where(dist_own >= 0, s_own, NEG_INF)
        pr = jax.nn.softmax(jnp.concatenate([s_sel, s_own], axis=-1), axis=-1)
        p_sel = pr[..., :n_sel * BLK].reshape(B, H, QC, n_sel, BLK)
        p_own = pr[..., n_sel * BLK:]
        return (jnp.einsum('bhqnk,bhqnkd->bhqd', p_sel, vsel)
                + jnp.einsum('bhqk,bhkd->bhqd', p_own, vown))

    out = lax.map(one_chunk, (jnp.arange(nq), qx, ix))
    return out.transpose(1, 0, 3, 2, 4).reshape(B, S, H * d)


def setup_inputs(seed: int = 0) -> dict:
    key = jax.random.key(seed)
    ks = jax.random.split(key, 12)
    f = jnp.float32
    nrm = jax.random.normal
    return {
        "x": nrm(ks[0], (BATCH, SEQ, D_MODEL), f),
        "p": nrm(ks[1], (DEPTH, BATCH, SEQ, PLE_DIM), f),
        "norm_g": 1.0 + 0.02 * nrm(ks[2], (DEPTH, D_MODEL), f),
        "w_in": nrm(ks[3], (DEPTH, D_MODEL, IN_WIDTH), f) * D_MODEL ** -0.5,
        "ret_norm_g": 1.0 + 0.02 * nrm(ks[4], (DEPTH, RET_WIDTH), f),
        "q_norm_g": 1.0 + 0.02 * nrm(ks[5], (DEPTH, MOBA_HEAD_DIM), f),
        "k_norm_g": 1.0 + 0.02 * nrm(ks[6], (DEPTH, MOBA_HEAD_DIM), f),
        "rel_bias": 0.5 * nrm(ks[7], (N_BUCKETS, MOBA_HEADS), f),
        "w_out": nrm(ks[8], (DEPTH, MIX_WIDTH, D_MODEL), f) * MIX_WIDTH ** -0.5,
        "w_ple": nrm(ks[9], (DEPTH, PLE_DIM, D_MODEL), f) * PLE_DIM ** -0.5,
        "ple_norm_g": 1.0 + 0.02 * nrm(ks[10], (DEPTH, D_MODEL), f),
        "w_ple_gate": nrm(ks[11], (DEPTH, D_MODEL, D_MODEL), f) * D_MODEL ** -0.5,
    }


def reference(x, p, norm_g, w_in, ret_norm_g, q_norm_g, k_norm_g, rel_bias,
              w_out, w_ple, ple_norm_g, w_ple_gate):
    B, S, _ = x.shape
    f32 = jnp.float32
    pos = jnp.arange(S)
    cuts = list(np.cumsum(SPLIT_SIZES)[:-1])

    def heads(t, H):
        return t.astype(f32).reshape(B, S, H, -1)

    for i in range(DEPTH):
        h = rms_norm(x, norm_g[i])
        proj = h @ w_in[i]
        rq, rk, rv, rz, mq, mk, mv, mz = jnp.split(proj, cuts, axis=-1)
        r_out = retention(rotary(heads(rq, RET_HEADS), pos), rotary(heads(rk, RET_HEADS), pos),
                          heads(rv, RET_HEADS), ret_norm_g[i])
        r_out = jax.nn.silu(rz.astype(f32)) * r_out
        q_m = rms_norm(heads(mq, MOBA_HEADS), q_norm_g[i])
        k_m = rms_norm(heads(mk, MOBA_HEADS), k_norm_g[i])
        m_out = moba(q_m, k_m, heads(mv, MOBA_HEADS), rel_bias)
        m_out = jax.nn.silu(mz.astype(f32)) * m_out
        y = jnp.concatenate([r_out, m_out], axis=-1).astype(x.dtype) @ w_out[i]
        x = x + y
        gate = jax.nn.sigmoid((rms_norm(x) @ w_ple_gate[i]).astype(f32))
        e = rms_norm(p[i] @ w_ple[i], ple_norm_g[i]).astype(f32)
        x = x + (gate * e).astype(x.dtype)
    return x
```

```cpp
#include <hip/hip_runtime.h>
#include <cstdio>
#include <cstdint>

namespace pg8 {
#define PG8_LAS __attribute__((address_space(3)))
typedef unsigned short bf16_t;
typedef short bf16x8 __attribute__((ext_vector_type(8)));
typedef float f32x4 __attribute__((ext_vector_type(4)));
typedef unsigned u32x4 __attribute__((ext_vector_type(4)));
typedef unsigned u32x2 __attribute__((ext_vector_type(2)));
constexpr int BM = 256, BK = 64, HALF = 128, HTB = HALF * BK * 2  , STAGE_BYTES = 8 * HTB, NXCD = 8, WGM = 8;

__host__ __device__ __forceinline__ int lds_byte(int r, int c) { const int st = (r >> 4) * 2 + (c >> 5), rr = r & 15, cc = c & 31, ob = rr * 64 + cc * 2; return st * 1024 + (ob ^ (((ob >> 9) & 1) << 5)); }
__host__ __device__ __forceinline__ void stage_rc(int b, int& R, int& C) { const int st = b / 1024, sb = b % 1024, swz = sb ^ (((sb >> 9) & 1) << 5); R = (st >> 1) * 16 + swz / 64; C = (st & 1) * 32 + (swz % 64) / 2; }
__host__ __device__ __forceinline__ int perm32(int rho) { const int n = rho >> 4, i = rho & 15; return 8 * (i >> 2) + 4 * n + (i & 3); }

struct Unit { int pm, pn; };
struct Gemm { const bf16_t* A; const bf16_t* Bt; int M, N, K, lda; };

struct StaticOrder {
    int nM, nN, nwg, G, c;
    __host__ __device__ void init(int M, int N, int G_, int c_) { nM = M / BM; nN = N / BM; nwg = nM * nN; G = G_; c = c_; }
    __host__ __device__ bool next(int i, Unit& u) const {
        const long L = (long)i * G + c; if (L >= nwg) return false;
        int wgid = (int)L; { const int q = nwg / NXCD, r = nwg % NXCD, xcd = wgid % NXCD, off = wgid / NXCD; wgid = (xcd < r ? xcd * (q + 1) : r * (q + 1) + (xcd - r) * q) + off; }
        const int nig = WGM * nN, gid = wgid / nig, fm = gid * WGM, gsz = (nM - fm) < WGM ? (nM - fm) : WGM;
        u.pm = fm + ((wgid % nig) % gsz); u.pn = (wgid % nig) / gsz; return true;
    }
    __device__ __forceinline__ void a_ready(const Unit&) const {}
    __device__ __forceinline__ void done(const Unit&) const {}
};

typedef float f32x2 __attribute__((ext_vector_type(2)));
typedef __bf16 bf16x2_t __attribute__((ext_vector_type(2)));
__device__ __forceinline__ unsigned pk2(float lo, float hi) { f32x2 v = {lo, hi}; bf16x2_t b = __builtin_convertvector(v, bf16x2_t); return __builtin_bit_cast(unsigned, b); }
__device__ __forceinline__ float bflo(unsigned w) { return __uint_as_float(w << 16); }
__device__ __forceinline__ float bfhi(unsigned w) { return __uint_as_float(w & 0xffff0000u); }
__device__ __forceinline__ float sum16(const float* p) {
    const f32x4 a = *(const f32x4*)p, b = *(const f32x4*)(p + 4), c = *(const f32x4*)(p + 8), d = *(const f32x4*)(p + 12);
    return (((a[0] + a[1]) + (a[2] + a[3])) + ((b[0] + b[1]) + (b[2] + b[3]))) + (((c[0] + c[1]) + (c[2] + c[3])) + ((d[0] + d[1]) + (d[2] + d[3])));
}
constexpr float EPS = 1e-6f;

struct EpiProj {
    static constexpr bool PERM = true, AFTER_DRAIN = false;
    bf16_t* O; int ldc; const float* rss;
    __device__ __forceinline__ void operator()(const f32x4 (&acc)[2][2][4][2], const Unit& u, int wr, int wc, int fr, int fq) const {
        const int row0 = u.pm * BM + wr * 64 + fr, col0 = u.pn * BM + wc * 32 + 8 * fq;
#pragma unroll
        for (int ai = 0; ai < 2; ++ai)
#pragma unroll
            for (int m = 0; m < 4; ++m) { const int row = row0 + ai * HALF + m * 16;
                const float rstd = 1.0f / sqrtf(sum16(rss + (size_t)row * 16) * (1.0f / 1024.0f) + EPS);
                bf16_t* rowp = O + (size_t)row * ldc + col0;
#pragma unroll
                for (int bj = 0; bj < 2; ++bj) { const f32x4 v0 = acc[ai][bj][m][0] * rstd, v1 = acc[ai][bj][m][1] * rstd;
                    u32x4 w; w.x = pk2(v0[0], v0[1]); w.y = pk2(v0[2], v0[3]); w.z = pk2(v1[0], v1[1]); w.w = pk2(v1[2], v1[3]);
                    *(u32x4*)(rowp + bj * HALF) = w; } }
    }
};
struct EpiE {
    static constexpr bool PERM = true, AFTER_DRAIN = false;
    bf16_t* O; int ldc; float* rs;
    __device__ __forceinline__ void operator()(const f32x4 (&acc)[2][2][4][2], const Unit& u, int wr, int wc, int fr, int fq) const {
        const int row0 = u.pm * BM + wr * 64 + fr, col0 = u.pn * BM + wc * 32 + 8 * fq;
#pragma unroll
        for (int ai = 0; ai < 2; ++ai)
#pragma unroll
            for (int m = 0; m < 4; ++m) { const int row = row0 + ai * HALF + m * 16; float s = 0.f;
                bf16_t* rowp = O + (size_t)row * ldc + col0;
#pragma unroll
                for (int bj = 0; bj < 2; ++bj) { const f32x4 v0 = acc[ai][bj][m][0], v1 = acc[ai][bj][m][1];
                    s += (v0[0] * v0[0] + v0[1] * v0[1]) + (v0[2] * v0[2] + v0[3] * v0[3]); s += (v1[0] * v1[0] + v1[1] * v1[1]) + (v1[2] * v1[2] + v1[3] * v1[3]);
                    u32x4 w; w.x = pk2(v0[0], v0[1]); w.y = pk2(v0[2], v0[3]); w.z = pk2(v1[0], v1[1]); w.w = pk2(v1[2], v1[3]);
                    *(u32x4*)(rowp + bj * HALF) = w; }
                s += __shfl_xor(s, 16); s += __shfl_xor(s, 32);
                if (fq == 0) rs[(size_t)row * 16 + u.pn * 4 + wc] = s; }
    }
};
struct EpiRes {
    static constexpr bool PERM = false, AFTER_DRAIN = false;
    const float* base; float* out; bf16_t* xb; float* rs; int ldc; int ldxb;
    __device__ __forceinline__ void operator()(const f32x4 (&acc)[2][2][4][2], const Unit& u, int wr, int wc, int fr, int fq) const {
        const int row0 = u.pm * BM + wr * 64 + fr, col0 = u.pn * BM + wc * 32 + 4 * fq;
#pragma unroll
        for (int ai = 0; ai < 2; ++ai)
#pragma unroll
            for (int m = 0; m < 4; ++m) { const int row = row0 + ai * HALF + m * 16; float s = 0.f; const size_t off = (size_t)row * ldc + col0, offb = (size_t)row * ldxb + col0;
#pragma unroll
                for (int bj = 0; bj < 2; ++bj)
#pragma unroll
                    for (int n = 0; n < 2; ++n) { const size_t o = off + bj * HALF + n * 16;
                        const f32x4 x = *(const f32x4*)(base + o) + acc[ai][bj][m][n];
                        *(f32x4*)(out + o) = x; s += (x[0] * x[0] + x[1] * x[1]) + (x[2] * x[2] + x[3] * x[3]);
                        u32x2 w; w.x = pk2(x[0], x[1]); w.y = pk2(x[2], x[3]); *(u32x2*)(xb + offb + bj * HALF + n * 16) = w; }
                s += __shfl_xor(s, 16); s += __shfl_xor(s, 32);
                if (fq == 0) rs[(size_t)row * 16 + u.pn * 4 + wc] = s; }
    }
};
struct EpiGate {
    static constexpr bool PERM = false, AFTER_DRAIN = false;
    float* xio; const bf16_t* epre; const float* rs1; const float* rse; const float* pg; bf16_t* xb; float* rso; int ldc;
    __device__ __forceinline__ void operator()(const f32x4 (&acc)[2][2][4][2], const Unit& u, int wr, int wc, int fr, int fq) const {
        const int row0 = u.pm * BM + wr * 64 + fr, col0 = u.pn * BM + wc * 32 + 4 * fq;
#pragma unroll
        for (int ai = 0; ai < 2; ++ai)
#pragma unroll
            for (int m = 0; m < 4; ++m) { const int row = row0 + ai * HALF + m * 16; float s = 0.f; const size_t off = (size_t)row * ldc + col0;
                const float r1 = 1.0f / sqrtf(sum16(rs1 + (size_t)row * 16) * (1.0f / 1024.0f) + EPS);
                const float re = 1.0f / sqrtf(sum16(rse + (size_t)row * 16) * (1.0f / 1024.0f) + EPS);
#pragma unroll
                for (int bj = 0; bj < 2; ++bj)
#pragma unroll
                    for (int n = 0; n < 2; ++n) { const size_t o = off + bj * HALF + n * 16; const int c = col0 + bj * HALF + n * 16;
                        const f32x4 a = acc[ai][bj][m][n] * r1; const u32x2 ew = *(const u32x2*)(epre + o); const f32x4 g = *(const f32x4*)(pg + c);
                        f32x4 e; e[0] = bflo(ew.x); e[1] = bfhi(ew.x); e[2] = bflo(ew.y); e[3] = bfhi(ew.y); e = e * re * g;
                        f32x4 sg; sg[0] = 1.0f / (1.0f + __expf(-a[0])); sg[1] = 1.0f / (1.0f + __expf(-a[1])); sg[2] = 1.0f / (1.0f + __expf(-a[2])); sg[3] = 1.0f / (1.0f + __expf(-a[3]));
                        const f32x4 x = *(const f32x4*)(xio + o) + sg * e;
                        *(f32x4*)(xio + o) = x; s += (x[0] * x[0] + x[1] * x[1]) + (x[2] * x[2] + x[3] * x[3]);
                        u32x2 w; w.x = pk2(x[0], x[1]); w.y = pk2(x[2], x[3]); *(u32x2*)(xb + o) = w; }
                s += __shfl_xor(s, 16); s += __shfl_xor(s, 32);
                if (fq == 0) rso[(size_t)row * 16 + u.pn * 4 + wc] = s; }
    }
};

template <class Epi, class Sched, bool ALIGN_EPI = false, bool SP2 = false>
__device__ __forceinline__ void gemm_phase(PG8_LAS unsigned char* lds, const Gemm g, const Sched& S, const Epi& E) {
    int tid = threadIdx.x; asm volatile("" : "+v"(tid));
    const int wid = __builtin_amdgcn_readfirstlane(tid >> 6), lane = tid & 63, wr = wid >> 2, wc = wid & 3, fr = lane & 15, fq = lane >> 4;
    const int K = g.K, lda = g.lda, nt = K / BK;
    unsigned voffA[2], voffB[2];
#pragma unroll
    for (int i = 0; i < 2; ++i) { int R, C; stage_rc(tid * 16 + i * 8192, R, C); const int Rb = Epi::PERM ? ((R & ~31) + perm32(R & 31)) : R;
        voffA[i] = (unsigned)(R * lda + C) * 2u; voffB[i] = (unsigned)(Rb * K + C) * 2u; }
    const size_t kstep = (size_t)(BK * 2);
    const size_t hstepB = (size_t)HALF * K * 2, hstepA = (size_t)HALF * lda * 2;
    const size_t tstepB = 2 * hstepB, tstepA = 2 * hstepA;
    const unsigned ldsw = (unsigned)wid * 1024u;
    const int aoff = lds_byte(wr * 64 + fr, fq * 8), boff = lds_byte(wc * 32 + fr, fq * 8);
#define PG8_SA(b, h) (((b) * 2 + (h)) * HTB)
#define PG8_SB(b, h) ((4 + (b) * 2 + (h)) * HTB)
#define PG8_STAGE(bufoff, gbase, voff) do { _Pragma("unroll") for (int _i = 0; _i < 2; ++_i) \
        __builtin_amdgcn_global_load_lds((const unsigned*)((const char*)(gbase) + (voff)[_i]), (PG8_LAS unsigned*)(lds + (bufoff) + ldsw + _i * 8192), 16, 0, 0); } while (0)
#define PG8_LDA(dst, b, h) do { _Pragma("unroll") for (int m = 0; m < 4; ++m) _Pragma("unroll") for (int k = 0; k < 2; ++k) dst[m][k] = *(const PG8_LAS bf16x8*)(lds + PG8_SA(b, h) + aoff + m * 2048 + k * 1024); } while (0)
#define PG8_LDB(dst, b, h) do { _Pragma("unroll") for (int n = 0; n < 2; ++n) _Pragma("unroll") for (int k = 0; k < 2; ++k) dst[n][k] = *(const PG8_LAS bf16x8*)(lds + PG8_SB(b, h) + boff + n * 2048 + k * 1024); } while (0)
#define PG8_MMA(ai, bj, At, Bt) do { __builtin_amdgcn_s_setprio(1); _Pragma("unroll") for (int m = 0; m < 4; ++m) _Pragma("unroll") for (int n = 0; n < 2; ++n) _Pragma("unroll") for (int k = 0; k < 2; ++k) \
        acc[ai][bj][m][n] = __builtin_amdgcn_mfma_f32_16x16x32_bf16(Bt[n][k], At[m][k], acc[ai][bj][m][n], 0, 0, 0); __builtin_amdgcn_s_setprio(0); } while (0)
#define PG8_WAIT_V(n) asm volatile("s_waitcnt vmcnt(" #n ")" ::: "memory")
#define PG8_WAIT_L(n) asm volatile("s_waitcnt lgkmcnt(" #n ")" ::: "memory")
#define PG8_BAR __builtin_amdgcn_s_barrier()
#define PG8_SCHED __builtin_amdgcn_sched_barrier(0)
    Unit cur, nxt; int ui = 0;
    if (!S.next(0, cur)) return;
    f32x4 acc[2][2][4][2];
#pragma unroll
    for (int a = 0; a < 2; ++a)
#pragma unroll
        for (int b = 0; b < 2; ++b)
#pragma unroll
            for (int m = 0; m < 4; ++m)
#pragma unroll
                for (int n = 0; n < 2; ++n) acc[a][b][m][n] = (f32x4){0.f, 0.f, 0.f, 0.f};
    bf16x8 At[4][2], B0[2][2], B1[2][2];
    const char* cA = (const char*)g.A + (size_t)cur.pm * tstepA; const char* cB = (const char*)g.Bt + (size_t)cur.pn * tstepB;
    S.a_ready(cur);
    if constexpr (SP2) {
        PG8_STAGE(PG8_SB(0, 0), cB, voffB); PG8_STAGE(PG8_SB(0, 1), cB + hstepB, voffB); PG8_STAGE(PG8_SA(0, 0), cA, voffA); PG8_STAGE(PG8_SA(0, 1), cA + hstepA, voffA);
        if (wr == 1) PG8_BAR;
        PG8_WAIT_V(2); PG8_BAR;
        PG8_STAGE(PG8_SB(1, 0), cB + kstep, voffB); PG8_STAGE(PG8_SA(1, 0), cA + kstep, voffA); PG8_STAGE(PG8_SB(1, 1), cB + hstepB + kstep, voffB);
        PG8_WAIT_V(6); PG8_BAR;
    } else {
        PG8_STAGE(PG8_SB(0, 0), cB, voffB); PG8_STAGE(PG8_SA(0, 0), cA, voffA); PG8_STAGE(PG8_SB(0, 1), cB + hstepB, voffB); PG8_STAGE(PG8_SA(0, 1), cA + hstepA, voffA);
        if (wr == 1) PG8_BAR;
        PG8_WAIT_V(4); PG8_BAR;
        PG8_STAGE(PG8_SB(1, 0), cB + kstep, voffB); PG8_STAGE(PG8_SA(1, 0), cA + kstep, voffA); PG8_STAGE(PG8_SB(1, 1), cB + hstepB + kstep, voffB);
        PG8_WAIT_V(6); PG8_BAR;
    }
    for (;;) {
        const bool has_next = S.next(ui + 1, nxt);
        const char* nA = has_next ? (const char*)g.A + (size_t)nxt.pm * tstepA : cA; const char* nB = has_next ? (const char*)g.Bt + (size_t)nxt.pn * tstepB : cB;
#pragma nounroll
        for (int t = 0; t < nt; t += 2) {
            const bool last = (t == nt - 2);
            const char* a1 = cA + (size_t)(t + 1) * kstep;
            const char* a2 = last ? nA : cA + (size_t)(t + 2) * kstep; const char* b2 = last ? nB : cB + (size_t)(t + 2) * kstep;
            const char* a3 = a2 + kstep; const char* b3 = b2 + kstep;
            if (last && has_next) S.a_ready(nxt);
            if constexpr (SP2) {
            PG8_LDB(B0, 0, 0); PG8_LDB(B1, 0, 1); PG8_SCHED; PG8_LDA(At, 0, 0); PG8_STAGE(PG8_SA(1, 1), a1 + hstepA, voffA);
            PG8_WAIT_V(8); PG8_WAIT_L(0); PG8_BAR; PG8_MMA(0, 0, At, B0); PG8_MMA(0, 1, At, B1); PG8_BAR; PG8_SCHED;
            PG8_LDA(At, 0, 1); PG8_STAGE(PG8_SB(0, 0), b2, voffB); PG8_STAGE(PG8_SB(0, 1), b2 + hstepB, voffB); PG8_STAGE(PG8_SA(0, 0), a2, voffA);
            PG8_WAIT_V(8); PG8_WAIT_L(0); PG8_BAR; PG8_MMA(1, 0, At, B0); PG8_MMA(1, 1, At, B1); PG8_BAR; PG8_SCHED;
            PG8_LDB(B0, 1, 0); PG8_LDB(B1, 1, 1); PG8_SCHED; PG8_LDA(At, 1, 0); PG8_STAGE(PG8_SA(0, 1), a2 + hstepA, voffA);
            PG8_WAIT_V(8); PG8_WAIT_L(0); PG8_BAR; PG8_MMA(0, 0, At, B0); PG8_MMA(0, 1, At, B1); PG8_BAR; PG8_SCHED;
            PG8_LDA(At, 1, 1); PG8_STAGE(PG8_SB(1, 0), b3, voffB); PG8_STAGE(PG8_SB(1, 1), b3 + hstepB, voffB); PG8_STAGE(PG8_SA(1, 0), a3, voffA);
            PG8_WAIT_V(8); PG8_WAIT_L(0); PG8_BAR; PG8_MMA(1, 0, At, B0); PG8_MMA(1, 1, At, B1); PG8_BAR; PG8_SCHED;
            } else {
            PG8_LDB(B0, 0, 0); PG8_SCHED; PG8_LDA(At, 0, 0); PG8_STAGE(PG8_SA(1, 1), a1 + hstepA, voffA);
            PG8_WAIT_L(8); PG8_BAR; PG8_WAIT_L(0); PG8_MMA(0, 0, At, B0); PG8_BAR; PG8_SCHED;
            PG8_LDB(B1, 0, 1); PG8_STAGE(PG8_SB(0, 0), b2, voffB);
            PG8_BAR; PG8_WAIT_L(0); PG8_MMA(0, 1, At, B1); PG8_BAR;
            PG8_LDA(At, 0, 1); PG8_STAGE(PG8_SA(0, 0), a2, voffA);
            PG8_BAR; PG8_WAIT_L(0); PG8_MMA(1, 0, At, B0); PG8_BAR; PG8_SCHED;
            PG8_STAGE(PG8_SB(0, 1), b2 + hstepB, voffB);
            PG8_WAIT_V(6); PG8_BAR; PG8_MMA(1, 1, At, B1); PG8_BAR;
            PG8_LDB(B0, 1, 0); PG8_SCHED; PG8_LDA(At, 1, 0); PG8_STAGE(PG8_SA(0, 1), a2 + hstepA, voffA);
            PG8_WAIT_L(8); PG8_BAR; PG8_WAIT_L(0); PG8_MMA(0, 0, At, B0); PG8_BAR; PG8_SCHED;
            PG8_LDB(B1, 1, 1); PG8_STAGE(PG8_SB(1, 0), b3, voffB);
            PG8_BAR; PG8_WAIT_L(0); PG8_MMA(0, 1, At, B1); PG8_BAR;
            PG8_LDA(At, 1, 1); PG8_STAGE(PG8_SA(1, 0), a3, voffA);
            PG8_BAR; PG8_WAIT_L(0); PG8_MMA(1, 0, At, B0); PG8_BAR; PG8_SCHED;
            PG8_STAGE(PG8_SB(1, 1), b3 + hstepB, voffB);
            PG8_WAIT_V(6); PG8_BAR; PG8_MMA(1, 1, At, B1); PG8_BAR;
            }
        }
        if constexpr (ALIGN_EPI) { if (wr == 0) PG8_BAR; }
        if constexpr (!Epi::AFTER_DRAIN) { E(acc, cur, wr, wc, fr, fq); S.done(cur); }
        if (!has_next) break;
#pragma unroll
        for (int a = 0; a < 2; ++a)
#pragma unroll
            for (int b = 0; b < 2; ++b)
#pragma unroll
                for (int m = 0; m < 4; ++m)
#pragma unroll
                    for (int n = 0; n < 2; ++n) acc[a][b][m][n] = (f32x4){0.f, 0.f, 0.f, 0.f};
        cur = nxt; cA = nA; cB = nB; ++ui;
        if constexpr (ALIGN_EPI) { if (wr == 1) PG8_BAR; }
    }
    PG8_WAIT_V(0);
    if constexpr (!ALIGN_EPI) { if (wr == 0) PG8_BAR; }
    PG8_BAR;
    if constexpr (Epi::AFTER_DRAIN) { E.fused(acc, cur, wr, wc, fr, fq, lds, wid, lane); S.done(cur); }
#undef PG8_SA
#undef PG8_SB
#undef PG8_STAGE
#undef PG8_LDA
#undef PG8_LDB
#undef PG8_MMA
#undef PG8_WAIT_V
#undef PG8_WAIT_L
#undef PG8_BAR
#undef PG8_SCHED
}
}

constexpr int NWAVES = 8;
constexpr int DM = 1024, SEQ = 8192, NBATCH = 4, M = NBATCH * SEQ, INW = 4096, PLE = 256, DEPTH = 2, HD = 128, NH = 4, NBLK = 32  , NCH = 64  ;
constexpr int C_RQ = 0, C_MQ = 512, C_RK = 1024, C_RV = 1536, C_RZ = 2048, C_MK = 2560, C_MV = 3072, C_MZ = 3584;
constexpr int C_X1B = 1024;
constexpr float RSQRT_HD = 0.08838834764831845f;

constexpr size_t MiB = 1u << 20;
constexpr size_t WS_CTL = 0, CTL_ZERO_BYTES = 1 * MiB;
constexpr size_t WS_WIN = 1 * MiB;
constexpr size_t WS_WOUT = 17 * MiB;
constexpr size_t WS_WG = 21 * MiB;
constexpr size_t WS_WPLE = 25 * MiB;
constexpr size_t WS_TAB = 26 * MiB;
constexpr size_t WS_LUT = 30 * MiB;
constexpr size_t WS_KMEAN = 30 * MiB + 128 * 1024;
constexpr size_t WS_SEL = 30 * MiB + 512 * 1024;
constexpr size_t WS_RSX = 31 * MiB;
constexpr size_t WS_RSX1 = 33 * MiB;
constexpr size_t WS_RSE = 35 * MiB;
constexpr size_t WS_PE = 37 * MiB;
constexpr size_t WS_KV = 53 * MiB;
constexpr size_t WS_EPRE = 85 * MiB;
constexpr size_t WS_XB = 149 * MiB;
constexpr size_t WS_PROJ = 245 * MiB;
constexpr size_t WS_END = 501 * MiB;
constexpr int CW_BAR = 4096;

constexpr int RING_OFF = 0, RING_BYTES = 131072;
constexpr int LDSCTL_OFF = 143360, MISC_OFF = LDSCTL_OFF + 320;
constexpr int LDS_BYTES = 147456;

#define GAS __attribute__((address_space(1)))
#define LAS __attribute__((address_space(3)))
typedef unsigned short bf16;
typedef unsigned v4u __attribute__((ext_vector_type(4)));
typedef unsigned v2u __attribute__((ext_vector_type(2)));
typedef float f32x4 __attribute__((ext_vector_type(4)));
typedef float f32x2v __attribute__((ext_vector_type(2)));
typedef GAS unsigned gu32;
#define RLX_AGENT __ATOMIC_RELAXED, __HIP_MEMORY_SCOPE_AGENT
#define LDS_WAIT() asm volatile("s_waitcnt lgkmcnt(0)" ::: "memory")
#define VM_WAIT() asm volatile("s_waitcnt vmcnt(0)" ::: "memory")
using pg8::pk2; using pg8::bflo; using pg8::bfhi;
__device__ __forceinline__ float bf2f(unsigned short u) { return __uint_as_float(((unsigned)u) << 16); }
#define XB_TMO      128
#define XB_XCNT(j)  (256  + 64 * (j))
#define XB_XSUB(j)  (1280 + 64 * (j))
#define XB_XGEN(j)  (2304 + 64 * (j))
#define XB_TOP      3328
#define XB_TOPGEN   3392
#define XCD_BAR_WORDS 3456
#define XB_SPIN_CAP (1u << 18)

__device__ __forceinline__ unsigned xb_ld(unsigned* p)              { return __hip_atomic_load(p, __ATOMIC_RELAXED, __HIP_MEMORY_SCOPE_AGENT); }
__device__ __forceinline__ unsigned xb_add(unsigned* p, unsigned v) { return __hip_atomic_fetch_add(p, v, __ATOMIC_RELAXED, __HIP_MEMORY_SCOPE_AGENT); }
__device__ __forceinline__ unsigned xb_xcc_id() { return (unsigned)__builtin_amdgcn_s_getreg((3 << 11) | 20) & 0xFu; }
#define XB_SPIN(cond, bar) do { unsigned _sp = 0; while (cond) { __builtin_amdgcn_s_sleep(1); \
    if ((++_sp & 255u) == 0u) { if (xb_ld(&(bar)[XB_TMO])) break; if (_sp > XB_SPIN_CAP) { atomicAdd(&(bar)[XB_TMO], 1u); break; } } } } while (0)

struct XcdBarrier {
    unsigned* bar; unsigned x;
    volatile LAS unsigned* st;
};

__device__ __forceinline__ XcdBarrier xcd_barrier_post(unsigned* bar, volatile LAS unsigned* st) {
    XcdBarrier b; b.bar = bar; b.x = xb_xcc_id(); b.st = st;
    if (threadIdx.x == 0) (void)xb_add(&bar[XB_XCNT(b.x)], 1u);
    return b;
}
__device__ __forceinline__ void xcd_barrier_complete(unsigned* bar, unsigned x, unsigned& nloc, unsigned& nx) {
    const unsigned G = gridDim.x * gridDim.y * gridDim.z;
    unsigned sum, cnt, mine, sp = 0u;
    for (;;) {
        sum = 0u; cnt = 0u; mine = 0u;
#pragma nounroll
        for (unsigned j = 0; j < 16; ++j) { const unsigned c = xb_ld(&bar[XB_XCNT(j)]); sum += c; cnt += (c > 0u) ? 1u : 0u; mine = (j == x) ? c : mine; }
        if (sum == G) break;
        __builtin_amdgcn_s_sleep(1);
        if ((++sp & 255u) == 0u) { if (xb_ld(&bar[XB_TMO])) break; if (sp > XB_SPIN_CAP) { atomicAdd(&bar[XB_TMO], 1u); break; } }
    }
    nloc = mine > 0u ? mine : 1u; nx = cnt > 0u ? cnt : 1u;
}

__device__ __forceinline__ void xcd_barrier(const XcdBarrier& b) {
    asm volatile("s_waitcnt vmcnt(0)" ::: "memory");
    __syncthreads();
    if (threadIdx.x == 0) {
        unsigned* bar = b.bar;
        __builtin_amdgcn_s_waitcnt(0);
        unsigned nloc = b.st[0], nx = b.st[1];
        if (nloc == 0u) { xcd_barrier_complete(bar, b.x, nloc, nx); b.st[0] = nloc; b.st[1] = nx; }
        const unsigned old = xb_add(&bar[XB_XSUB(b.x)], 1u);
        const unsigned gen = old / nloc;
        if (old + 1u == (gen + 1u) * nloc) {
            __builtin_amdgcn_fence(__ATOMIC_RELEASE, "agent");
            asm volatile("s_waitcnt vmcnt(0)" ::: "memory");
            const unsigned og = xb_add(&bar[XB_TOP], 1u);
            const unsigned tg = og / nx;
            if (og + 1u == (tg + 1u) * nx) xb_add(&bar[XB_TOPGEN], 1u);
            else XB_SPIN(xb_ld(&bar[XB_TOPGEN]) == tg, bar);
            __builtin_amdgcn_fence(__ATOMIC_ACQUIRE, "agent");
            xb_add(&bar[XB_XGEN(b.x)], 1u);
            asm volatile("s_waitcnt vmcnt(0)" ::: "memory");
        } else {
            XB_SPIN(xb_ld(&bar[XB_XGEN(b.x)]) == gen, bar);
            __builtin_amdgcn_fence(__ATOMIC_ACQUIRE, "agent");
            asm volatile("s_waitcnt vmcnt(0)" ::: "memory");
        }
    }
    __syncthreads();
}

__device__ __forceinline__ float wave_sum(float v) {
#pragma unroll
    for (int o = 1; o < 64; o <<= 1) v += __shfl_xor(v, o);
    return v;
}
__device__ __forceinline__ float wave_max(float v) {
#pragma unroll
    for (int o = 1; o < 64; o <<= 1) v = fmaxf(v, __shfl_xor(v, o));
    return v;
}
__device__ __forceinline__ float ret_log2g(int h) { return log2f(1.0f - exp2f(-5.0f - (float)h)); }

__device__ __forceinline__ int win_dst(int c) {
    const int g = c >> 9, w = c & 511, hd = w >> 7, i = w & 127;
    const int base = (g == 0) ? C_RQ : (g == 1) ? C_RK : (g == 2) ? C_RV : (g == 3) ? C_RZ : (g == 4) ? C_MQ : (g == 5) ? C_MK : (g == 6) ? C_MV : C_MZ;
    const int pos = (g <= 1) ? ((i < 64) ? 2 * i : 2 * (i - 64) + 1) : i;
    return base + hd * 128 + pos;
}
template <int MODE>
__device__ __forceinline__ void p0_transpose_item(const float* W, int K, int N, bf16* WT, const float* gk, LAS float* scr, int item, int lane) {
    const int nblk = N / 32, kb = item / nblk, nb = item % nblk, k0 = 64 * kb, n0 = 32 * nb;
#pragma unroll 8
    for (int i = 0; i < 32; ++i) { const int kk = 2 * i + (lane >> 5); float v = W[(size_t)(k0 + kk) * N + n0 + (lane & 31)]; if (MODE == 1) v *= gk[k0 + kk]; scr[kk * 33 + (lane & 31)] = v; }
    LDS_WAIT(); asm volatile("" ::: "memory");
    const int c = lane & 7;
#pragma unroll
    for (int j = 0; j < 4; ++j) { const int n = (lane >> 3) + 8 * j; const LAS float* s = scr + (8 * c) * 33 + n;
        v4u o; o.x = pk2(s[0 * 33], s[1 * 33]); o.y = pk2(s[2 * 33], s[3 * 33]); o.z = pk2(s[4 * 33], s[5 * 33]); o.w = pk2(s[6 * 33], s[7 * 33]);
        const int dst = (MODE == 1) ? win_dst(n0 + n) : (n0 + n);
        *(v4u*)(WT + (size_t)dst * K + k0 + 8 * c) = o; }
    LDS_WAIT(); asm volatile("" ::: "memory");
}
__device__ __forceinline__ void x_row_to_bf16(const float* xrow, bf16* orow, float* rs16, int lane) {
    const f32x4* xr = (const f32x4*)xrow + lane;
    f32x4 v[4]; float s = 0.f;
#pragma unroll
    for (int j = 0; j < 4; ++j) { v[j] = xr[64 * j]; s += (v[j][0] * v[j][0] + v[j][1] * v[j][1]) + (v[j][2] * v[j][2] + v[j][3] * v[j][3]); }
    s = wave_sum(s);
    v2u* o8 = (v2u*)orow + lane;
#pragma unroll
    for (int j = 0; j < 4; ++j) { v2u w; w.x = pk2(v[j][0], v[j][1]); w.y = pk2(v[j][2], v[j][3]); o8[64 * j] = w; }
    if (lane < 16) rs16[lane] = (lane == 0) ? s : 0.f;
}
__device__ __forceinline__ void cvt_f32_bf16(const float* src, bf16* dst, long n8, long gtid, long gthreads) {
    for (long i = gtid; i < n8; i += gthreads) {
        const f32x4 a = *(const f32x4*)(src + i * 8), b = *(const f32x4*)(src + i * 8 + 4);
        v4u w; w.x = pk2(a[0], a[1]); w.y = pk2(a[2], a[3]); w.z = pk2(b[0], b[1]); w.w = pk2(b[2], b[3]);
        *(v4u*)(dst + i * 8) = w; }
}
__device__ __forceinline__ void sincos_d(double a, double& s, double& c) {
    const double k = rint(a * 0.63661977236758134308);
    double r = fma(-k, 1.57079632679489655800e+00, a); r = fma(-k, 6.12323399573676603587e-17, r);
    const double r2 = r * r;
    double sp = 1.0 / 6227020800.0; sp = fma(sp, r2, -1.0 / 39916800.0); sp = fma(sp, r2, 1.0 / 362880.0); sp = fma(sp, r2, -1.0 / 5040.0); sp = fma(sp, r2, 1.0 / 120.0); sp = fma(sp, r2, -1.0 / 6.0); sp = fma(sp * r2, r, r);
    double cp = 1.0 / 87178291200.0; cp = fma(cp, r2, -1.0 / 479001600.0); cp = fma(cp, r2, 1.0 / 3628800.0); cp = fma(cp, r2, -1.0 / 40320.0); cp = fma(cp, r2, 1.0 / 720.0); cp = fma(cp, r2, -1.0 / 24.0); cp = fma(cp, r2, 0.5); cp = fma(-cp, r2, 1.0);
    const int q = ((int)k) & 3;
    s = (q == 0) ? sp : (q == 1) ? cp : (q == 2) ? -sp : -cp;
    c = (q == 0) ? cp : (q == 1) ? -sp : (q == 2) ? -cp : sp;
}
__device__ __forceinline__ int t5_bucket(int n) {
    if (n < 16) return n;
    const float v = logf((float)n * (1.0f / 16.0f)) / 4.852030263919617f * 16.0f;
    int b = 16 + (int)v; return b > 31 ? 31 : b;
}

struct Args {
    const float* x; const float* p; const float* norm_g; const float* w_in; const float* ret_norm_g; const float* q_norm_g; const float* k_norm_g; const float* rel_bias;
    const float* w_out; const float* w_ple; const float* ple_norm_g; const float* w_ple_gate; float* out; unsigned char* ws;
};
typedef const __attribute__((address_space(4))) Args* KA;
__device__ __forceinline__ KA get_ka() { KA p = (KA)__builtin_amdgcn_kernarg_segment_ptr(); asm volatile("" : "+s"(p)); return p; }
#define PHASE_IDS() int tid = threadIdx.x; asm volatile("" : "+v"(tid)); const int lane = tid & 63; const int wave = __builtin_amdgcn_readfirstlane(tid >> 6); \
    int bx_ = blockIdx.x; asm volatile("" : "+s"(bx_)); const int G = gridDim.x; const int vcu = (G % 8 == 0) ? (bx_ % 8) * (G / 8) + bx_ / 8 : bx_; (void)lane; (void)wave; (void)vcu

__device__ __forceinline__ void p0_prologue(KA A, LAS unsigned char* lds) {
    PHASE_IDS();
    unsigned char* ws = A->ws;
    LAS float* scr = (LAS float*)(lds + RING_OFF + wave * 16384);
    const int gw = vcu * NWAVES + wave, NGW = G * NWAVES;
    constexpr int I_IN = (DM / 64) * (INW / 32), I_O = (DM / 64) * (DM / 32), I_G = I_O, I_P = (PLE / 64) * (DM / 32), I_L = I_IN + I_O + I_G + I_P;
    for (int it = gw; it < DEPTH * I_L; it += NGW) {
        const int L = it / I_L; int r = it % I_L;
        if (r < I_IN) { p0_transpose_item<1>(A->w_in + (size_t)L * DM * INW, DM, INW, (bf16*)(ws + WS_WIN) + (size_t)L * INW * DM, A->norm_g + L * DM, scr, r, lane); continue; } r -= I_IN;
        if (r < I_O) { p0_transpose_item<0>(A->w_out + (size_t)L * DM * DM, DM, DM, (bf16*)(ws + WS_WOUT) + (size_t)L * DM * DM, nullptr, scr, r, lane); continue; } r -= I_O;
        if (r < I_G) { p0_transpose_item<0>(A->w_ple_gate + (size_t)L * DM * DM, DM, DM, (bf16*)(ws + WS_WG) + (size_t)L * DM * DM, nullptr, scr, r, lane); continue; } r -= I_G;
        p0_transpose_item<0>(A->w_ple + (size_t)L * PLE * DM, PLE, DM, (bf16*)(ws + WS_WPLE) + (size_t)L * DM * PLE, nullptr, scr, r, lane);
    }
    for (int m = gw; m < M; m += NGW) x_row_to_bf16(A->x + (size_t)m * DM, (bf16*)(ws + WS_XB) + (size_t)m * DM, (float*)(ws + WS_RSX) + (size_t)m * 16, lane);
    const long gtid = (long)vcu * (NWAVES * 64) + tid, gthreads = (long)G * NWAVES * 64;
    cvt_f32_bf16(A->p, (bf16*)(ws + WS_PE), (long)M * PLE / 8, gtid, gthreads);
    for (long i = gtid; i < (long)SEQ * 64; i += gthreads) {
        const int pos = (int)(i >> 6), fi = (int)(i & 63);
        const float inv = (float)exp2(-(double)fi * (1.0 / 64.0) * 13.287712379549449);
        const float ang = (float)pos * inv;
        double s, c; sincos_d((double)ang, s, c);
        ((f32x2v*)(ws + WS_TAB))[i] = (f32x2v){(float)c, (float)s};
    }
    for (long i = gtid; i < (long)NH * SEQ; i += gthreads) {
        const int h = (int)(i >> 13), n = (int)(i & 8191);
        ((float*)(ws + WS_LUT))[i] = A->rel_bias[t5_bucket(n) * NH + h];
    }
}

__device__ __forceinline__ void p1b_rowops(KA A, int L) {
    PHASE_IDS();
    unsigned char* ws = A->ws; bf16* PROJ = (bf16*)(ws + WS_PROJ);
    const int gw = vcu * NWAVES + wave, NGW = G * NWAVES;
    const int hd = lane >> 4, i0 = (lane & 15) * 4;
    const float lg2 = ret_log2g(hd);
    const float* qg = A->q_norm_g + L * HD + (lane & 15) * 8; const float* kg = A->k_norm_g + L * HD + (lane & 15) * 8;
    const f32x4 qg0 = *(const f32x4*)qg, qg1 = *(const f32x4*)(qg + 4), kg0 = *(const f32x4*)kg, kg1 = *(const f32x4*)(kg + 4);
    for (int t = gw; t < M; t += NGW) {
        const int pos = t & (SEQ - 1), j = pos & 127;
        bf16* row = PROJ + (size_t)t * INW;
        const f32x4* cs = (const f32x4*)((const f32x2v*)(ws + WS_TAB) + (size_t)pos * 64 + i0);
        const f32x4 cs0 = cs[0], cs1 = cs[1];
        const float gq = exp2f((float)j * lg2), gk = RSQRT_HD * exp2f(-(float)j * lg2);
        {   v4u w = *(v4u*)(row + C_RQ + 8 * lane);
            float a, b;
            a = bflo(w.x); b = bfhi(w.x); w.x = pk2((a * cs0[0] - b * cs0[1]) * gq, (a * cs0[1] + b * cs0[0]) * gq);
            a = bflo(w.y); b = bfhi(w.y); w.y = pk2((a * cs0[2] - b * cs0[3]) * gq, (a * cs0[3] + b * cs0[2]) * gq);
            a = bflo(w.z); b = bfhi(w.z); w.z = pk2((a * cs1[0] - b * cs1[1]) * gq, (a * cs1[1] + b * cs1[0]) * gq);
            a = bflo(w.w); b = bfhi(w.w); w.w = pk2((a * cs1[2] - b * cs1[3]) * gq, (a * cs1[3] + b * cs1[2]) * gq);
            *(v4u*)(row + C_RQ + 8 * lane) = w; }
        {   v4u w = *(v4u*)(row + C_RK + 8 * lane);
            float a, b;
            a = bflo(w.x); b = bfhi(w.x); w.x = pk2((a * cs0[0] - b * cs0[1]) * gk, (a * cs0[1] + b * cs0[0]) * gk);
            a = bflo(w.y); b = bfhi(w.y); w.y = pk2((a * cs0[2] - b * cs0[3]) * gk, (a * cs0[3] + b * cs0[2]) * gk);
            a = bflo(w.z); b = bfhi(w.z); w.z = pk2((a * cs1[0] - b * cs1[1]) * gk, (a * cs1[1] + b * cs1[0]) * gk);
            a = bflo(w.w); b = bfhi(w.w); w.w = pk2((a * cs1[2] - b * cs1[3]) * gk, (a * cs1[3] + b * cs1[2]) * gk);
            *(v4u*)(row + C_RK + 8 * lane) = w; }
        {   v4u w = *(v4u*)(row + C_MQ + 8 * lane);
            float v[8] = {bflo(w.x), bfhi(w.x), bflo(w.y), bfhi(w.y), bflo(w.z), bfhi(w.z), bflo(w.w), bfhi(w.w)};
            float ss = 0.f;
#pragma unroll
            for (int e = 0; e < 8; ++e) ss += v[e] * v[e];
            ss += __shfl_xor(ss, 1); ss += __shfl_xor(ss, 2); ss += __shfl_xor(ss, 4); ss += __shfl_xor(ss, 8);
            const float r = RSQRT_HD / sqrtf(ss * (1.0f / 128.0f) + pg8::EPS);
            w.x = pk2(v[0] * r * qg0[0], v[1] * r * qg0[1]); w.y = pk2(v[2] * r * qg0[2], v[3] * r * qg0[3]); w.z = pk2(v[4] * r * qg1[0], v[5] * r * qg1[1]); w.w = pk2(v[6] * r * qg1[2], v[7] * r * qg1[3]);
            *(v4u*)(row + C_MQ + 8 * lane) = w; }
        {   v4u w = *(v4u*)(row + C_MK + 8 * lane);
            float v[8] = {bflo(w.x), bfhi(w.x), bflo(w.y), bfhi(w.y), bflo(w.z), bfhi(w.z), bflo(w.w), bfhi(w.w)};
            float ss = 0.f;
#pragma unroll
            for (int e = 0; e < 8; ++e) ss += v[e] * v[e];
            ss += __shfl_xor(ss, 1); ss += __shfl_xor(ss, 2); ss += __shfl_xor(ss, 4); ss += __shfl_xor(ss, 8);
            const float r = 1.0f / sqrtf(ss * (1.0f / 128.0f) + pg8::EPS);
            w.x = pk2(v[0] * r * kg0[0], v[1] * r * kg0[1]); w.y = pk2(v[2] * r * kg0[2], v[3] * r * kg0[3]); w.z = pk2(v[4] * r * kg1[0], v[5] * r * kg1[1]); w.w = pk2(v[6] * r * kg1[2], v[7] * r * kg1[3]);
            *(v4u*)(row + C_MK + 8 * lane) = w; }
    }
}

__device__ __forceinline__ void p2_kmean(KA A) {
    PHASE_IDS();
    unsigned char* ws = A->ws; const bf16* PROJ = (const bf16*)(ws + WS_PROJ); float* KM = (float*)(ws + WS_KMEAN);
    for (int idx = vcu * (NWAVES * 64) + tid; idx < 16 * NBLK * HD; idx += G * NWAVES * 64) {
        const int bh = idx >> 12, blk = (idx >> 7) & 31, col = idx & 127, b = bh >> 2, h = bh & 3;
        const bf16* src = PROJ + (size_t)(b * SEQ + blk * 256) * INW + C_MK + h * HD + col;
        float s = 0.f;
#pragma unroll 8
        for (int r = 0; r < 256; ++r) s += bf2f(src[(size_t)r * INW]);
        KM[idx] = s * (1.0f / 256.0f);
    }
}
static_assert(4 * 128 * 272 <= LDSCTL_OFF, "retention tiles must stay below the LDS control words");
constexpr int TROW = 272;
__device__ __forceinline__ void stage_tile128(const bf16* g, size_t ld, unsigned char* dst, int tid) {
#pragma unroll
    for (int i = 0; i < 4; ++i) { const int ch = tid + i * 512, r = ch >> 4, c = ch & 15;
        *(v4u*)(dst + r * TROW + c * 16) = *(const v4u*)(g + (size_t)r * ld + c * 8); }
}
__device__ __forceinline__ void p2_kvsum(KA A, unsigned char* lds) {
    PHASE_IDS();
    unsigned char* ws = A->ws; const bf16* PROJ = (const bf16*)(ws + WS_PROJ); bf16* ST = (bf16*)(ws + WS_KV);
    unsigned char* Kt = lds; unsigned char* Vt = lds + 128 * TROW;
    const int e = tid >> 2, dp = tid & 3;
    for (int it = vcu; it < 16 * NCH; it += G) {
        const int bh = it >> 6, c = it & 63, b = bh >> 2, h = bh & 3;
        const size_t t0 = (size_t)b * SEQ + c * 128;
        stage_tile128(PROJ + t0 * INW + C_RK + h * HD, INW, Kt, tid);
        stage_tile128(PROJ + t0 * INW + C_RV + h * HD, INW, Vt, tid);
        __syncthreads();
        float acc[32];
#pragma unroll
        for (int i = 0; i < 32; ++i) acc[i] = 0.f;
        for (int m = 0; m < 128; ++m) {
            const float v = bf2f(*(const bf16*)(Vt + m * TROW + e * 2));
#pragma unroll
            for (int q = 0; q < 4; ++q) { const v4u w = *(const v4u*)(Kt + m * TROW + dp * 64 + q * 16);
                acc[q * 8 + 0] += v * bflo(w.x); acc[q * 8 + 1] += v * bfhi(w.x); acc[q * 8 + 2] += v * bflo(w.y); acc[q * 8 + 3] += v * bfhi(w.y);
                acc[q * 8 + 4] += v * bflo(w.z); acc[q * 8 + 5] += v * bfhi(w.z); acc[q * 8 + 6] += v * bflo(w.w); acc[q * 8 + 7] += v * bfhi(w.w); }
        }
        bf16* o = ST + ((size_t)it * 128 + e) * 128 + dp * 32;
#pragma unroll
        for (int q = 0; q < 4; ++q) { v4u w; w.x = pk2(acc[q * 8 + 0], acc[q * 8 + 1]); w.y = pk2(acc[q * 8 + 2], acc[q * 8 + 3]); w.z = pk2(acc[q * 8 + 4], acc[q * 8 + 5]); w.w = pk2(acc[q * 8 + 6], acc[q * 8 + 7]);
            *(v4u*)(o + q * 8) = w; }
        __syncthreads();
    }
}

__device__ __forceinline__ void p2b_gating(KA A, unsigned char* lds) {
    PHASE_IDS();
    unsigned char* ws = A->ws; const bf16* PROJ = (const bf16*)(ws + WS_PROJ); const float* KM = (const float*)(ws + WS_KMEAN); unsigned* SEL = (unsigned*)(ws + WS_SEL);
    float* km = (float*)lds;
    const int q = tid >> 1, half = tid & 1;
    for (int it = vcu; it < 16 * NBLK; it += G) {
        const int bh = it >> 5, qb = it & 31, b = bh >> 2, h = bh & 3;
        for (int i = tid; i < qb * 32; i += NWAVES * 64) ((f32x4*)km)[i] = ((const f32x4*)(KM + (size_t)bh * NBLK * HD))[i];
        __syncthreads();
        const size_t t = (size_t)b * SEQ + qb * 256 + q;
        const bf16* qp = PROJ + t * INW + C_MQ + h * HD + half * 64;
        float qf[64];
#pragma unroll
        for (int c = 0; c < 8; ++c) { const v4u w = *(const v4u*)(qp + c * 8);
            qf[c * 8 + 0] = bflo(w.x); qf[c * 8 + 1] = bfhi(w.x); qf[c * 8 + 2] = bflo(w.y); qf[c * 8 + 3] = bfhi(w.y); qf[c * 8 + 4] = bflo(w.z); qf[c * 8 + 5] = bfhi(w.z); qf[c * 8 + 6] = bflo(w.w); qf[c * 8 + 7] = bfhi(w.w); }
        float v0 = -3e38f, v1 = -3e38f, v2 = -3e38f; int i0 = -1, i1 = -1, i2 = -1;
        for (int n = 0; n < qb; ++n) {
            const f32x4* kr = (const f32x4*)(km + n * HD + half * 64);
            float d0 = 0.f, d1 = 0.f, d2 = 0.f, d3 = 0.f;
#pragma unroll
            for (int c = 0; c < 16; ++c) { const f32x4 k4 = kr[c]; d0 += qf[c * 4 + 0] * k4[0]; d1 += qf[c * 4 + 1] * k4[1]; d2 += qf[c * 4 + 2] * k4[2]; d3 += qf[c * 4 + 3] * k4[3]; }
            float d = (d0 + d1) + (d2 + d3);
            d += __shfl_xor(d, 1);
            if (d > v0) { v2 = v1; i2 = i1; v1 = v0; i1 = i0; v0 = d; i0 = n; }
            else if (d > v1) { v2 = v1; i2 = i1; v1 = d; i1 = n; }
            else if (d > v2) { v2 = d; i2 = n; }
        }
        unsigned mask = 0u;
        if (i0 >= 0) mask |= 1u << i0; if (i1 >= 0) mask |= 1u << i1; if (i2 >= 0) mask |= 1u << i2;
        if (half == 0) SEL[t * NH + h] = mask;
        __syncthreads();
    }
}

__device__ __forceinline__ void p3_scan(KA A) {
    PHASE_IDS();
    unsigned* ST = (unsigned*)(A->ws + WS_KV);
    for (int idx = vcu * (NWAVES * 64) + tid; idx < 16 * 8192; idx += G * NWAVES * 64) {
        const int bh = idx >> 13, pr = idx & 8191, h = bh & 3;
        const float lg2 = ret_log2g(h), g1 = exp2f(lg2), g127 = exp2f(127.f * lg2), g128 = exp2f(128.f * lg2);
        unsigned* p = ST + (size_t)bh * NCH * 8192 + pr;
        float s0 = 0.f, s1 = 0.f;
#pragma unroll 8
        for (int c = 0; c < NCH; ++c) {
            const unsigned w = p[(size_t)c * 8192];
            p[(size_t)c * 8192] = pk2(g1 * s0, g1 * s1);
            s0 = s0 * g128 + g127 * bflo(w); s1 = s1 * g128 + g127 * bfhi(w);
        }
    }
}

__device__ __forceinline__ void p3_moba_naive(KA A, unsigned char* lds) {
    PHASE_IDS();
    unsigned char* ws = A->ws; bf16* PROJ = (bf16*)(ws + WS_PROJ); const unsigned* SEL = (const unsigned*)(ws + WS_SEL); const float* LUT = (const float*)(ws + WS_LUT);
    float* qs = (float*)(lds + wave * 5120);
    float* ps = qs + 128;
    const int gw = vcu * NWAVES + wave, NGW = G * NWAVES;
    for (int item = gw; item < M * NH; item += NGW) {
        const int t = item >> 2, h = item & 3, b = t >> 13, pos = t & (SEQ - 1), qb = pos >> 8;
        const unsigned mask = SEL[item];
        int blk[4]; int nsel = 0;
        { unsigned mm = mask; const int a0 = mm ? __builtin_ctz(mm) : 0; if (mm) { mm &= mm - 1; ++nsel; } const int a1 = mm ? __builtin_ctz(mm) : 0; if (mm) { mm &= mm - 1; ++nsel; } const int a2 = mm ? __builtin_ctz(mm) : 0; if (mm) { ++nsel; }
          blk[0] = a0; blk[1] = a1; blk[2] = a2; blk[3] = qb; }
        const unsigned qw = *(const unsigned*)(PROJ + (size_t)t * INW + C_MQ + h * HD + 2 * lane);
        qs[2 * lane] = bflo(qw); qs[2 * lane + 1] = bfhi(qw);
        LDS_WAIT();
        const float* lut = LUT + h * SEQ;
        float sc[16]; float mx = -1e30f;
#pragma unroll
        for (int sl = 0; sl < 4; ++sl) {
            const bool on = (sl == 3) || (sl < nsel);
#pragma unroll
            for (int kk = 0; kk < 4; ++kk) {
                float s = -1e30f;
                if (on) {
                    const int kpos = blk[sl] * 256 + kk * 64 + lane;
                    const bf16* kp = PROJ + ((size_t)b * SEQ + kpos) * INW + C_MK + h * HD;
                    float d = 0.f;
#pragma unroll
                    for (int c = 0; c < 16; ++c) { const v4u w = *(const v4u*)(kp + c * 8); const f32x4 q0 = *(const f32x4*)(qs + c * 8), q1 = *(const f32x4*)(qs + c * 8 + 4);
                        d += (bflo(w.x) * q0[0] + bfhi(w.x) * q0[1]) + (bflo(w.y) * q0[2] + bfhi(w.y) * q0[3]) + (bflo(w.z) * q1[0] + bfhi(w.z) * q1[1]) + (bflo(w.w) * q1[2] + bfhi(w.w) * q1[3]); }
                    const int dist = pos - kpos;
                    if (dist >= 0) s = d + lut[dist];
                }
                sc[sl * 4 + kk] = s; mx = fmaxf(mx, s);
            }
        }
        mx = wave_max(mx);
        float l = 0.f;
#pragma unroll
        for (int i = 0; i < 16; ++i) { const float pz = (sc[i] > -1e29f) ? __expf(sc[i] - mx) : 0.f; l += pz; ps[i * 64 + lane] = pz; }
        l = wave_sum(l);
        LDS_WAIT();
        float o0 = 0.f, o1 = 0.f;
#pragma unroll
        for (int sl = 0; sl < 4; ++sl) {
            const bool on = (sl == 3) || (sl < nsel);
            if (on) {
                const bf16* vp = PROJ + ((size_t)b * SEQ + blk[sl] * 256) * INW + C_MV + h * HD + 2 * lane;
#pragma unroll 8
                for (int k = 0; k < 256; ++k) { const float pz = ps[sl * 256 + k]; const unsigned w = *(const unsigned*)(vp + (size_t)k * INW); o0 += pz * bflo(w); o1 += pz * bfhi(w); }
            }
        }
        const float inv = 1.0f / l;
        const unsigned zw = *(const unsigned*)(PROJ + (size_t)t * INW + C_MZ + h * HD + 2 * lane);
        const float z0 = bflo(zw), z1 = bfhi(zw);
        const float r0 = o0 * inv * (z0 / (1.0f + __expf(-z0))), r1 = o1 * inv * (z1 / (1.0f + __expf(-z1)));
        *(unsigned*)(PROJ + (size_t)t * INW + C_MQ + h * HD + 2 * lane) = pk2(r0, r1);
        LDS_WAIT();
    }
}

__device__ __forceinline__ void p4_ret_naive(KA A, int L, unsigned char* lds) {
    PHASE_IDS();
    unsigned char* ws = A->ws; bf16* PROJ = (bf16*)(ws + WS_PROJ); const bf16* ST = (const bf16*)(ws + WS_KV);
    unsigned char* Qt = lds; unsigned char* Kt = lds + 128 * TROW; unsigned char* Vt = lds + 2 * 128 * TROW; unsigned char* St = lds + 3 * 128 * TROW;
    const int n = tid >> 2, part = tid & 3;
    for (int it = vcu; it < 16 * NCH; it += G) {
        const int bh = it >> 6, c = it & 63, b = bh >> 2, h = bh & 3;
        const size_t t0 = (size_t)b * SEQ + c * 128;
        stage_tile128(PROJ + t0 * INW + C_RQ + h * HD, INW, Qt, tid);
        stage_tile128(PROJ + t0 * INW + C_RK + h * HD, INW, Kt, tid);
        stage_tile128(PROJ + t0 * INW + C_RV + h * HD, INW, Vt, tid);
        stage_tile128(ST + (size_t)it * 128 * 128, 128, St, tid);
        __syncthreads();
        float qf[32];
#pragma unroll
        for (int q = 0; q < 4; ++q) { const v4u w = *(const v4u*)(Qt + n * TROW + part * 64 + q * 16);
            qf[q * 8 + 0] = bflo(w.x); qf[q * 8 + 1] = bfhi(w.x); qf[q * 8 + 2] = bflo(w.y); qf[q * 8 + 3] = bfhi(w.y); qf[q * 8 + 4] = bflo(w.z); qf[q * 8 + 5] = bfhi(w.z); qf[q * 8 + 6] = bflo(w.w); qf[q * 8 + 7] = bfhi(w.w); }
        float o[32];
#pragma unroll
        for (int i = 0; i < 32; ++i) o[i] = 0.f;
        const int mend = (n | 15) + 1;
        for (int m = 0; m < mend; ++m) {
            float s = 0.f;
#pragma unroll
            for (int q = 0; q < 4; ++q) { const v4u w = *(const v4u*)(Kt + m * TROW + part * 64 + q * 16);
                s += (qf[q * 8 + 0] * bflo(w.x) + qf[q * 8 + 1] * bfhi(w.x)) + (qf[q * 8 + 2] * bflo(w.y) + qf[q * 8 + 3] * bfhi(w.y)) + (qf[q * 8 + 4] * bflo(w.z) + qf[q * 8 + 5] * bfhi(w.z)) + (qf[q * 8 + 6] * bflo(w.w) + qf[q * 8 + 7] * bfhi(w.w)); }
            s += __shfl_xor(s, 1); s += __shfl_xor(s, 2);
            if (m > n) s = 0.f;
#pragma unroll
            for (int q = 0; q < 4; ++q) { const v4u w = *(const v4u*)(Vt + m * TROW + part * 64 + q * 16);
                o[q * 8 + 0] += s * bflo(w.x); o[q * 8 + 1] += s * bfhi(w.x); o[q * 8 + 2] += s * bflo(w.y); o[q * 8 + 3] += s * bfhi(w.y); o[q * 8 + 4] += s * bflo(w.z); o[q * 8 + 5] += s * bfhi(w.z); o[q * 8 + 6] += s * bflo(w.w); o[q * 8 + 7] += s * bfhi(w.w); }
        }
        for (int d8 = 0; d8 < 16; ++d8) {
            const v4u qw = *(const v4u*)(Qt + n * TROW + d8 * 16);
            const float q0 = bflo(qw.x), q1 = bfhi(qw.x), q2 = bflo(qw.y), q3 = bfhi(qw.y), q4 = bflo(qw.z), q5 = bfhi(qw.z), q6 = bflo(qw.w), q7 = bfhi(qw.w);
#pragma unroll
            for (int ee = 0; ee < 32; ++ee) { const v4u w = *(const v4u*)(St + (part * 32 + ee) * TROW + d8 * 16);
                o[ee] += (q0 * bflo(w.x) + q1 * bfhi(w.x)) + (q2 * bflo(w.y) + q3 * bfhi(w.y)) + (q4 * bflo(w.z) + q5 * bfhi(w.z)) + (q6 * bflo(w.w) + q7 * bfhi(w.w)); }
        }
        float sm = 0.f;
#pragma unroll
        for (int i = 0; i < 32; ++i) sm += o[i];
        sm += __shfl_xor(sm, 1); sm += __shfl_xor(sm, 2);
        const float mean = sm * (1.0f / 128.0f);
        float vr = 0.f;
#pragma unroll
        for (int i = 0; i < 32; ++i) { const float dlt = o[i] - mean; vr += dlt * dlt; }
        vr += __shfl_xor(vr, 1); vr += __shfl_xor(vr, 2);
        const float rstd = 1.0f / sqrtf(vr * (1.0f / 128.0f) + pg8::EPS);
        const float* gn = A->ret_norm_g + L * 512 + h * HD + part * 32;
        bf16* zrow = PROJ + (t0 + n) * INW + C_RZ + h * HD + part * 32;
        bf16* orow = PROJ + (t0 + n) * INW + C_RQ + h * HD + part * 32;
#pragma unroll
        for (int q = 0; q < 4; ++q) { const v4u zw = *(const v4u*)(zrow + q * 8); const f32x4 g0 = *(const f32x4*)(gn + q * 8), g1 = *(const f32x4*)(gn + q * 8 + 4);
            float z[8] = {bflo(zw.x), bfhi(zw.x), bflo(zw.y), bfhi(zw.y), bflo(zw.z), bfhi(zw.z), bflo(zw.w), bfhi(zw.w)};
            float r[8];
#pragma unroll
            for (int e = 0; e < 8; ++e) { const float gg = (e < 4) ? g0[e & 3] : g1[e & 3]; r[e] = (o[q * 8 + e] - mean) * rstd * gg * (z[e] / (1.0f + __expf(-z[e]))); }
            v4u w; w.x = pk2(r[0], r[1]); w.y = pk2(r[2], r[3]); w.z = pk2(r[4], r[5]); w.w = pk2(r[6], r[7]);
            *(v4u*)(orow + q * 8) = w; }
        __syncthreads();
    }
}

__global__ void __launch_bounds__(NWAVES * 64, 2) hymba_fwd(Args args_unused) {
    extern __shared__ __attribute__((aligned(16))) unsigned char lds[];
    LAS unsigned char* ldsl = (LAS unsigned char*)lds;
    volatile LAS unsigned* MISC = (volatile LAS unsigned*)(ldsl + MISC_OFF);
    { const int tid = threadIdx.x; for (int u = tid; u < (LDS_BYTES - LDSCTL_OFF) / 4; u += NWAVES * 64) ((LAS unsigned*)(ldsl + LDSCTL_OFF))[u] = 0u; }
    __syncthreads();
    XcdBarrier bar = xcd_barrier_post((unsigned*)(get_ka()->ws + WS_CTL) + CW_BAR, MISC + 8);
#define GRID_BAR() do { XcdBarrier b_ = bar; b_.bar = (unsigned*)(get_ka()->ws + WS_CTL) + CW_BAR; xcd_barrier(b_); } while (0)
#define WSP(T, off) ((T*)(ka->ws + (off)))

    p0_prologue(get_ka(), ldsl);
    GRID_BAR();

    for (int L = 0; L < DEPTH; ++L) {
        {   KA ka = get_ka(); int bx = blockIdx.x; asm volatile("" : "+s"(bx)); const int G = gridDim.x;
            pg8::Gemm g{WSP(bf16, WS_XB), WSP(const bf16, WS_WIN) + (size_t)L * INW * DM, M, INW, DM, DM}; pg8::StaticOrder S; S.init(M, INW, G, bx);
            pg8::EpiProj E{WSP(bf16, WS_PROJ), INW, WSP(float, WS_RSX)};
            pg8::gemm_phase<pg8::EpiProj, pg8::StaticOrder, true, true>(ldsl + RING_OFF, g, S, E); }
        {   KA ka = get_ka(); int bx = blockIdx.x; asm volatile("" : "+s"(bx)); const int G = gridDim.x;
            pg8::Gemm g{WSP(bf16, WS_PE), WSP(const bf16, WS_WPLE) + (size_t)L * DM * PLE, M, DM, PLE, PLE}; pg8::StaticOrder S; S.init(M, DM, G, bx);
            pg8::EpiE E{WSP(bf16, WS_EPRE), DM, WSP(float, WS_RSE)};
            pg8::gemm_phase<pg8::EpiE, pg8::StaticOrder, true, true>(ldsl + RING_OFF, g, S, E); }
        GRID_BAR();
        p1b_rowops(get_ka(), L);
        GRID_BAR();
        p2_kmean(get_ka());
        p2_kvsum(get_ka(), lds);
        GRID_BAR();
        p2b_gating(get_ka(), lds);
        GRID_BAR();
        p3_scan(get_ka());
        p3_moba_naive(get_ka(), lds);
        GRID_BAR();
        p4_ret_naive(get_ka(), L, lds);
        GRID_BAR();
        {   KA ka = get_ka(); int bx = blockIdx.x; asm volatile("" : "+s"(bx)); const int G = gridDim.x;
            pg8::Gemm g{WSP(bf16, WS_PROJ), WSP(const bf16, WS_WOUT) + (size_t)L * DM * DM, M, DM, DM, INW}; pg8::StaticOrder S; S.init(M, DM, G, bx);
            pg8::EpiRes E{(L == 0) ? ka->x : (const float*)ka->out, ka->out, WSP(bf16, WS_PROJ) + C_X1B, WSP(float, WS_RSX1), DM, INW};
            pg8::gemm_phase<pg8::EpiRes, pg8::StaticOrder, true, true>(ldsl + RING_OFF, g, S, E); }
        GRID_BAR();
        {   KA ka = get_ka(); int bx = blockIdx.x; asm volatile("" : "+s"(bx)); const int G = gridDim.x;
            pg8::Gemm g{WSP(bf16, WS_PROJ) + C_X1B, WSP(const bf16, WS_WG) + (size_t)L * DM * DM, M, DM, DM, INW}; pg8::StaticOrder S; S.init(M, DM, G, bx);
            pg8::EpiGate E{ka->out, WSP(const bf16, WS_EPRE), WSP(const float, WS_RSX1), WSP(const float, WS_RSE), ka->ple_norm_g + L * DM, WSP(bf16, WS_XB), WSP(float, WS_RSX), DM};
            pg8::gemm_phase<pg8::EpiGate, pg8::StaticOrder, true, true>(ldsl + RING_OFF, g, S, E); }
        if (L + 1 < DEPTH) {
            {   KA ka = get_ka(); PHASE_IDS();
                const long gtid = (long)vcu * (NWAVES * 64) + tid, gthreads = (long)G * NWAVES * 64;
                cvt_f32_bf16(ka->p + (size_t)(L + 1) * M * PLE, WSP(bf16, WS_PE), (long)M * PLE / 8, gtid, gthreads); }
            GRID_BAR();
        }
    }
}

extern "C" void kernel_launch(void* const* d_in, const int* in_sizes, int n_in, void* d_out, int out_size, void* d_ws, size_t ws_size, hipStream_t stream) {
    static int grid = 0;
    if (grid == 0) {
        if (n_in != 12 || in_sizes[0] != M * DM || out_size != M * DM || ws_size < WS_END) {
            fprintf(stderr, "kernel_launch: shape mismatch: n_in %d in0 %d out %d ws %zu (need >= %zu)\n", n_in, n_in > 0 ? in_sizes[0] : -1, out_size, ws_size, (size_t)WS_END); grid = -1; return; }
        int dev = 0, cus = 0, per_cu = 0;
        if (hipGetDevice(&dev) != hipSuccess || hipDeviceGetAttribute(&cus, hipDeviceAttributeMultiprocessorCount, dev) != hipSuccess) { fprintf(stderr, "kernel_launch: device query failed\n"); grid = -1; return; }
        if (hipFuncSetAttribute((const void*)hymba_fwd, hipFuncAttributeMaxDynamicSharedMemorySize, LDS_BYTES) != hipSuccess) { fprintf(stderr, "kernel_launch: hipFuncSetAttribute failed\n"); grid = -1; return; }
        if (hipOccupancyMaxActiveBlocksPerMultiprocessor(&per_cu, (const void*)hymba_fwd, NWAVES * 64, LDS_BYTES) != hipSuccess || per_cu < 1)
            fprintf(stderr, "kernel_launch: note: occupancy query reports %d workgroups per CU\n", per_cu);
        (void)hipGetLastError();
        grid = cus;
        fprintf(stderr, "kernel_launch: grid %d, ws %zu bytes\n", grid, ws_size);
    }
    if (grid < 0) return;
    if (hipMemsetAsync((char*)d_ws + WS_CTL, 0, CTL_ZERO_BYTES, stream) != hipSuccess) { fprintf(stderr, "kernel_launch: memset failed\n"); return; }
    Args a{};
    a.x = (const float*)d_in[0]; a.p = (const float*)d_in[1]; a.norm_g = (const float*)d_in[2]; a.w_in = (const float*)d_in[3]; a.ret_norm_g = (const float*)d_in[4];
    a.q_norm_g = (const float*)d_in[5]; a.k_norm_g = (const float*)d_in[6]; a.rel_bias = (const float*)d_in[7]; a.w_out = (const float*)d_in[8]; a.w_ple = (const float*)d_in[9];
    a.ple_norm_g = (const float*)d_in[10]; a.w_ple_gate = (const float*)d_in[11]; a.out = (float*)d_out; a.ws = (unsigned char*)d_ws;
    hipLaunchKernelGGL(hymba_fwd, dim3(grid), dim3(NWAVES * 64), LDS_BYTES, stream, a);
    const hipError_t le = hipPeekAtLastError();
    if (le != hipSuccess) fprintf(stderr, "kernel_launch: launch failed: %s\n", hipGetErrorName(le));
}
```

```cpp
#include <hip/hip_runtime.h>
#include <cstdio>
#include <cstdint>

namespace pg8 {
#define PG8_LAS __attribute__((address_space(3)))
typedef unsigned short bf16_t;
typedef short bf16x8 __attribute__((ext_vector_type(8)));
typedef float f32x4 __attribute__((ext_vector_type(4)));
typedef unsigned u32x4 __attribute__((ext_vector_type(4)));
typedef unsigned u32x2 __attribute__((ext_vector_type(2)));
constexpr int BM = 256, BK = 64, HALF = 128, HTB = HALF * BK * 2  , STAGE_BYTES = 8 * HTB, NXCD = 8, WGM = 8;

__host__ __device__ __forceinline__ int lds_byte(int r, int c) { const int st = (r >> 4) * 2 + (c >> 5), rr = r & 15, cc = c & 31, ob = rr * 64 + cc * 2; return st * 1024 + (ob ^ (((ob >> 9) & 1) << 5)); }
__host__ __device__ __forceinline__ void stage_rc(int b, int& R, int& C) { const int st = b / 1024, sb = b % 1024, swz = sb ^ (((sb >> 9) & 1) << 5); R = (st >> 1) * 16 + swz / 64; C = (st & 1) * 32 + (swz % 64) / 2; }
__host__ __device__ __forceinline__ int perm32(int rho) { const int n = rho >> 4, i = rho & 15; return 8 * (i >> 2) + 4 * n + (i & 3); }

struct Unit { int pm, pn; };
struct Gemm { const bf16_t* A; const bf16_t* Bt; int M, N, K, lda; };

struct StaticOrder {
    int nM, nN, nwg, G, c;
    __host__ __device__ void init(int M, int N, int G_, int c_) { nM = M / BM; nN = N / BM; nwg = nM * nN; G = G_; c = c_; }
    __host__ __device__ bool next(int i, Unit& u) const {
        const long L = (long)i * G + c; if (L >= nwg) return false;
        int wgid = (int)L; { const int q = nwg / NXCD, r = nwg % NXCD, xcd = wgid % NXCD, off = wgid / NXCD; wgid = (xcd < r ? xcd * (q + 1) : r * (q + 1) + (xcd - r) * q) + off; }
        const int nig = WGM * nN, gid = wgid / nig, fm = gid * WGM, gsz = (nM - fm) < WGM ? (nM - fm) : WGM;
        u.pm = fm + ((wgid % nig) % gsz); u.pn = (wgid % nig) / gsz; return true;
    }
    __device__ __forceinline__ void a_ready(const Unit&) const {}
    __device__ __forceinline__ void done(const Unit&) const {}
};

typedef float f32x2 __attribute__((ext_vector_type(2)));
typedef __bf16 bf16x2_t __attribute__((ext_vector_type(2)));
__device__ __forceinline__ unsigned pk2(float lo, float hi) { f32x2 v = {lo, hi}; bf16x2_t b = __builtin_convertvector(v, bf16x2_t); return __builtin_bit_cast(unsigned, b); }
__device__ __forceinline__ float bflo(unsigned w) { return __uint_as_float(w << 16); }
__device__ __forceinline__ float bfhi(unsigned w) { return __uint_as_float(w & 0xffff0000u); }
__device__ __forceinline__ float sum16(const float* p) {
    const f32x4 a = *(const f32x4*)p, b = *(const f32x4*)(p + 4), c = *(const f32x4*)(p + 8), d = *(const f32x4*)(p + 12);
    return (((a[0] + a[1]) + (a[2] + a[3])) + ((b[0] + b[1]) + (b[2] + b[3]))) + (((c[0] + c[1]) + (c[2] + c[3])) + ((d[0] + d[1]) + (d[2] + d[3])));
}
constexpr float EPS = 1e-6f;

struct EpiProj {
    static constexpr bool PERM = true, AFTER_DRAIN = false;
    bf16_t* O; int ldc; const float* rss;
    __device__ __forceinline__ void operator()(const f32x4 (&acc)[2][2][4][2], const Unit& u, int wr, int wc, int fr, int fq) const {
        const int row0 = u.pm * BM + wr * 64 + fr, col0 = u.pn * BM + wc * 32 + 8 * fq;
#pragma unroll
        for (int ai = 0; ai < 2; ++ai)
#pragma unroll
            for (int m = 0; m < 4; ++m) { const int row = row0 + ai * HALF + m * 16;
                const float rstd = 1.0f / sqrtf(sum16(rss + (size_t)row * 16) * (1.0f / 1024.0f) + EPS);
                bf16_t* rowp = O + (size_t)row * ldc + col0;
#pragma unroll
                for (int bj = 0; bj < 2; ++bj) { const f32x4 v0 = acc[ai][bj][m][0] * rstd, v1 = acc[ai][bj][m][1] * rstd;
                    u32x4 w; w.x = pk2(v0[0], v0[1]); w.y = pk2(v0[2], v0[3]); w.z = pk2(v1[0], v1[1]); w.w = pk2(v1[2], v1[3]);
                    *(u32x4*)(rowp + bj * HALF) = w; } }
    }
};
struct EpiE {
    static constexpr bool PERM = true, AFTER_DRAIN = false;
    bf16_t* O; int ldc; float* rs;
    __device__ __forceinline__ void operator()(const f32x4 (&acc)[2][2][4][2], const Unit& u, int wr, int wc, int fr, int fq) const {
        const int row0 = u.pm * BM + wr * 64 + fr, col0 = u.pn * BM + wc * 32 + 8 * fq;
#pragma unroll
        for (int ai = 0; ai < 2; ++ai)
#pragma unroll
            for (int m = 0; m < 4; ++m) { const int row = row0 + ai * HALF + m * 16; float s = 0.f;
                bf16_t* rowp = O + (size_t)row * ldc + col0;
#pragma unroll
                for (int bj = 0; bj < 2; ++bj) { const f32x4 v0 = acc[ai][bj][m][0], v1 = acc[ai][bj][m][1];
                    s += (v0[0] * v0[0] + v0[1] * v0[1]) + (v0[2] * v0[2] + v0[3] * v0[3]); s += (v1[0] * v1[0] + v1[1] * v1[1]) + (v1[2] * v1[2] + v1[3] * v1[3]);
                    u32x4 w; w.x = pk2(v0[0], v0[1]); w.y = pk2(v0[2], v0[3]); w.z = pk2(v1[0], v1[1]); w.w = pk2(v1[2], v1[3]);
                    *(u32x4*)(rowp + bj * HALF) = w; }
                s += __shfl_xor(s, 16); s += __shfl_xor(s, 32);
                if (fq == 0) rs[(size_t)row * 16 + u.pn * 4 + wc] = s; }
    }
};
struct EpiRes {
    static constexpr bool PERM = false, AFTER_DRAIN = false;
    const float* base; float* out; bf16_t* xb; float* rs; int ldc; int ldxb;
    __device__ __forceinline__ void operator()(const f32x4 (&acc)[2][2][4][2], const Unit& u, int wr, int wc, int fr, int fq) const {
        const int row0 = u.pm * BM + wr * 64 + fr, col0 = u.pn * BM + wc * 32 + 4 * fq;
#pragma unroll
        for (int ai = 0; ai < 2; ++ai)
#pragma unroll
            for (int m = 0; m < 4; ++m) { const int row = row0 + ai * HALF + m * 16; float s = 0.f; const size_t off = (size_t)row * ldc + col0, offb = (size_t)row * ldxb + col0;
#pragma unroll
                for (int bj = 0; bj < 2; ++bj)
#pragma unroll
                    for (int n = 0; n < 2; ++n) { const size_t o = off + bj * HALF + n * 16;
                        const f32x4 x = *(const f32x4*)(base + o) + acc[ai][bj][m][n];
                        *(f32x4*)(out + o) = x; s += (x[0] * x[0] + x[1] * x[1]) + (x[2] * x[2] + x[3] * x[3]);
                        u32x2 w; w.x = pk2(x[0], x[1]); w.y = pk2(x[2], x[3]); *(u32x2*)(xb + offb + bj * HALF + n * 16) = w; }
                s += __shfl_xor(s, 16); s += __shfl_xor(s, 32);
                if (fq == 0) rs[(size_t)row * 16 + u.pn * 4 + wc] = s; }
    }
};
struct EpiGate {
    static constexpr bool PERM = false, AFTER_DRAIN = false;
    float* xio; const bf16_t* epre; const float* rs1; const float* rse; const float* pg; bf16_t* xb; float* rso; int ldc;
    __device__ __forceinline__ void operator()(const f32x4 (&acc)[2][2][4][2], const Unit& u, int wr, int wc, int fr, int fq) const {
        const int row0 = u.pm * BM + wr * 64 + fr, col0 = u.pn * BM + wc * 32 + 4 * fq;
#pragma unroll
        for (int ai = 0; ai < 2; ++ai)
#pragma unroll
            for (int m = 0; m < 4; ++m) { const int row = row0 + ai * HALF + m * 16; float s = 0.f; const size_t off = (size_t)row * ldc + col0;
                const float r1 = 1.0f / sqrtf(sum16(rs1 + (size_t)row * 16) * (1.0f / 1024.0f) + EPS);
                const float re = 1.0f / sqrtf(sum16(rse + (size_t)row * 16) * (1.0f / 1024.0f) + EPS);
#pragma unroll
                for (int bj = 0; bj < 2; ++bj)
#pragma unroll
                    for (int n = 0; n < 2; ++n) { const size_t o = off + bj * HALF + n * 16; const int c = col0 + bj * HALF + n * 16;
                        const f32x4 a = acc[ai][bj][m][n] * r1; const u32x2 ew = *(const u32x2*)(epre + o); const f32x4 g = *(const f32x4*)(pg + c);
                        f32x4 e; e[0] = bflo(ew.x); e[1] = bfhi(ew.x); e[2] = bflo(ew.y); e[3] = bfhi(ew.y); e = e * re * g;
                        f32x4 sg; sg[0] = 1.0f / (1.0f + __expf(-a[0])); sg[1] = 1.0f / (1.0f + __expf(-a[1])); sg[2] = 1.0f / (1.0f + __expf(-a[2])); sg[3] = 1.0f / (1.0f + __expf(-a[3]));
                        const f32x4 x = *(const f32x4*)(xio + o) + sg * e;
                        *(f32x4*)(xio + o) = x; s += (x[0] * x[0] + x[1] * x[1]) + (x[2] * x[2] + x[3] * x[3]);
                        u32x2 w; w.x = pk2(x[0], x[1]); w.y = pk2(x[2], x[3]); *(u32x2*)(xb + o) = w; }
                s += __shfl_xor(s, 16); s += __shfl_xor(s, 32);
                if (fq == 0) rso[(size_t)row * 16 + u.pn * 4 + wc] = s; }
    }
};

template <class Epi, class Sched, bool ALIGN_EPI = false, bool SP2 = false>
__device__ __forceinline__ void gemm_phase(PG8_LAS unsigned char* lds, const Gemm g, const Sched& S, const Epi& E) {
    int tid = threadIdx.x; asm volatile("" : "+v"(tid));
    const int wid = __builtin_amdgcn_readfirstlane(tid >> 6), lane = tid & 63, wr = wid >> 2, wc = wid & 3, fr = lane & 15, fq = lane >> 4;
    const int K = g.K, lda = g.lda, nt = K / BK;
    unsigned voffA[2], voffB[2];
#pragma unroll
    for (int i = 0; i < 2; ++i) { int R, C; stage_rc(tid * 16 + i * 8192, R, C); const int Rb = Epi::PERM ? ((R & ~31) + perm32(R & 31)) : R;
        voffA[i] = (unsigned)(R * lda + C) * 2u; voffB[i] = (unsigned)(Rb * K + C) * 2u; }
    const size_t kstep = (size_t)(BK * 2);
    const size_t hstepB = (size_t)HALF * K * 2, hstepA = (size_t)HALF * lda * 2;
    const size_t tstepB = 2 * hstepB, tstepA = 2 * hstepA;
    const unsigned ldsw = (unsigned)wid * 1024u;
    const int aoff = lds_byte(wr * 64 + fr, fq * 8), boff = lds_byte(wc * 32 + fr, fq * 8);
#define PG8_SA(b, h) (((b) * 2 + (h)) * HTB)
#define PG8_SB(b, h) ((4 + (b) * 2 + (h)) * HTB)
#define PG8_STAGE(bufoff, gbase, voff) do { _Pragma("unroll") for (int _i = 0; _i < 2; ++_i) \
        __builtin_amdgcn_global_load_lds((const unsigned*)((const char*)(gbase) + (voff)[_i]), (PG8_LAS unsigned*)(lds + (bufoff) + ldsw + _i * 8192), 16, 0, 0); } while (0)
#define PG8_LDA(dst, b, h) do { _Pragma("unroll") for (int m = 0; m < 4; ++m) _Pragma("unroll") for (int k = 0; k < 2; ++k) dst[m][k] = *(const PG8_LAS bf16x8*)(lds + PG8_SA(b, h) + aoff + m * 2048 + k * 1024); } while (0)
#define PG8_LDB(dst, b, h) do { _Pragma("unroll") for (int n = 0; n < 2; ++n) _Pragma("unroll") for (int k = 0; k < 2; ++k) dst[n][k] = *(const PG8_LAS bf16x8*)(lds + PG8_SB(b, h) + boff + n * 2048 + k * 1024); } while (0)
#define PG8_MMA(ai, bj, At, Bt) do { __builtin_amdgcn_s_setprio(1); _Pragma("unroll") for (int m = 0; m < 4; ++m) _Pragma("unroll") for (int n = 0; n < 2; ++n) _Pragma("unroll") for (int k = 0; k < 2; ++k) \
        acc[ai][bj][m][n] = __builtin_amdgcn_mfma_f32_16x16x32_bf16(Bt[n][k], At[m][k], acc[ai][bj][m][n], 0, 0, 0); __builtin_amdgcn_s_setprio(0); } while (0)
#define PG8_WAIT_V(n) asm volatile("s_waitcnt vmcnt(" #n ")" ::: "memory")
#define PG8_WAIT_L(n) asm volatile("s_waitcnt lgkmcnt(" #n ")" ::: "memory")
#define PG8_BAR __builtin_amdgcn_s_barrier()
#define PG8_SCHED __builtin_amdgcn_sched_barrier(0)
    Unit cur, nxt; int ui = 0;
    if (!S.next(0, cur)) return;
    f32x4 acc[2][2][4][2];
#pragma unroll
    for (int a = 0; a < 2; ++a)
#pragma unroll
        for (int b = 0; b < 2; ++b)
#pragma unroll
            for (int m = 0; m < 4; ++m)
#pragma unroll
                for (int n = 0; n < 2; ++n) acc[a][b][m][n] = (f32x4){0.f, 0.f, 0.f, 0.f};
    bf16x8 At[4][2], B0[2][2], B1[2][2];
    const char* cA = (const char*)g.A + (size_t)cur.pm * tstepA; const char* cB = (const char*)g.Bt + (size_t)cur.pn * tstepB;
    S.a_ready(cur);
    if constexpr (SP2) {
        PG8_STAGE(PG8_SB(0, 0), cB, voffB); PG8_STAGE(PG8_SB(0, 1), cB + hstepB, voffB); PG8_STAGE(PG8_SA(0, 0), cA, voffA); PG8_STAGE(PG8_SA(0, 1), cA + hstepA, voffA);
        if (wr == 1) PG8_BAR;
        PG8_WAIT_V(2); PG8_BAR;
        PG8_STAGE(PG8_SB(1, 0), cB + kstep, voffB); PG8_STAGE(PG8_SA(1, 0), cA + kstep, voffA); PG8_STAGE(PG8_SB(1, 1), cB + hstepB + kstep, voffB);
        PG8_WAIT_V(6); PG8_BAR;
    } else {
        PG8_STAGE(PG8_SB(0, 0), cB, voffB); PG8_STAGE(PG8_SA(0, 0), cA, voffA); PG8_STAGE(PG8_SB(0, 1), cB + hstepB, voffB); PG8_STAGE(PG8_SA(0, 1), cA + hstepA, voffA);
        if (wr == 1) PG8_BAR;
        PG8_WAIT_V(4); PG8_BAR;
        PG8_STAGE(PG8_SB(1, 0), cB + kstep, voffB); PG8_STAGE(PG8_SA(1, 0), cA + kstep, voffA); PG8_STAGE(PG8_SB(1, 1), cB + hstepB + kstep, voffB);
        PG8_WAIT_V(6); PG8_BAR;
    }
    for (;;) {
        const bool has_next = S.next(ui + 1, nxt);
        const char* nA = has_next ? (const char*)g.A + (size_t)nxt.pm * tstepA : cA; const char* nB = has_next ? (const char*)g.Bt + (size_t)nxt.pn * tstepB : cB;
#pragma nounroll
        for (int t = 0; t < nt; t += 2) {
            const bool last = (t == nt - 2);
            const char* a1 = cA + (size_t)(t + 1) * kstep;
            const char* a2 = last ? nA : cA + (size_t)(t + 2) * kstep; const char* b2 = last ? nB : cB + (size_t)(t + 2) * kstep;
            const char* a3 = a2 + kstep; const char* b3 = b2 + kstep;
            if (last && has_next) S.a_ready(nxt);
            if constexpr (SP2) {
            PG8_LDB(B0, 0, 0); PG8_LDB(B1, 0, 1); PG8_SCHED; PG8_LDA(At, 0, 0); PG8_STAGE(PG8_SA(1, 1), a1 + hstepA, voffA);
            PG8_WAIT_V(8); PG8_WAIT_L(0); PG8_BAR; PG8_MMA(0, 0, At, B0); PG8_MMA(0, 1, At, B1); PG8_BAR; PG8_SCHED;
            PG8_LDA(At, 0, 1); PG8_STAGE(PG8_SB(0, 0), b2, voffB); PG8_STAGE(PG8_SB(0, 1), b2 + hstepB, voffB); PG8_STAGE(PG8_SA(0, 0), a2, voffA);
            PG8_WAIT_V(8); PG8_WAIT_L(0); PG8_BAR; PG8_MMA(1, 0, At, B0); PG8_MMA(1, 1, At, B1); PG8_BAR; PG8_SCHED;
            PG8_LDB(B0, 1, 0); PG8_LDB(B1, 1, 1); PG8_SCHED; PG8_LDA(At, 1, 0); PG8_STAGE(PG8_SA(0, 1), a2 + hstepA, voffA);
            PG8_WAIT_V(8); PG8_WAIT_L(0); PG8_BAR; PG8_MMA(0, 0, At, B0); PG8_MMA(0, 1, At, B1); PG8_BAR; PG8_SCHED;
            PG8_LDA(At, 1, 1); PG8_STAGE(PG8_SB(1, 0), b3, voffB); PG8_STAGE(PG8_SB(1, 1), b3 + hstepB, voffB); PG8_STAGE(PG8_SA(1, 0), a3, voffA);
            PG8_WAIT_V(8); PG8_WAIT_L(0); PG8_BAR; PG8_MMA(1, 0, At, B0); PG8_MMA(1, 1, At, B1); PG8_BAR; PG8_SCHED;
            } else {
            PG8_LDB(B0, 0, 0); PG8_SCHED; PG8_LDA(At, 0, 0); PG8_STAGE(PG8_SA(1, 1), a1 + hstepA, voffA);
            PG8_WAIT_L(8); PG8_BAR; PG8_WAIT_L(0); PG8_MMA(0, 0, At, B0); PG8_BAR; PG8_SCHED;
            PG8_LDB(B1, 0, 1); PG8_STAGE(PG8_SB(0, 0), b2, voffB);
            PG8_BAR; PG8_WAIT_L(0); PG8_MMA(0, 1, At, B1); PG8_BAR;
            PG8_LDA(At, 0, 1); PG8_STAGE(PG8_SA(0, 0), a2, voffA);
            PG8_BAR; PG8_WAIT_L(0); PG8_MMA(1, 0, At, B0); PG8_BAR; PG8_SCHED;
            PG8_STAGE(PG8_SB(0, 1), b2 + hstepB, voffB);
            PG8_WAIT_V(6); PG8_BAR; PG8_MMA(1, 1, At, B1); PG8_BAR;
            PG8_LDB(B0, 1, 0); PG8_SCHED; PG8_LDA(At, 1, 0); PG8_STAGE(PG8_SA(0, 1), a2 + hstepA, voffA);
            PG8_WAIT_L(8); PG8_BAR; PG8_WAIT_L(0); PG8_MMA(0, 0, At, B0); PG8_BAR; PG8_SCHED;
            PG8_LDB(B1, 1, 1); PG8_STAGE(PG8_SB(1, 0), b3, voffB);
            PG8_BAR; PG8_WAIT_L(0); PG8_MMA(0, 1, At, B1); PG8_BAR;
            PG8_LDA(At, 1, 1); PG8_STAGE(PG8_SA(1, 0), a3, voffA);
            PG8_BAR; PG8_WAIT_L(0); PG8_MMA(1, 0, At, B0); PG8_BAR; PG8_SCHED;
            PG8_STAGE(PG8_SB(1, 1), b3 + hstepB, voffB);
            PG8_WAIT_V(6); PG8_BAR; PG8_MMA(1, 1, At, B1); PG8_BAR;
            }
        }
        if constexpr (ALIGN_EPI) { if (wr == 0) PG8_BAR; }
        if constexpr (!Epi::AFTER_DRAIN) { E(acc, cur, wr, wc, fr, fq); S.done(cur); }
        if (!has_next) break;
#pragma unroll
        for (int a = 0; a < 2; ++a)
#pragma unroll
            for (int b = 0; b < 2; ++b)
#pragma unroll
                for (int m = 0; m < 4; ++m)
#pragma unroll
                    for (int n = 0; n < 2; ++n) acc[a][b][m][n] = (f32x4){0.f, 0.f, 0.f, 0.f};
        cur = nxt; cA = nA; cB = nB; ++ui;
        if constexpr (ALIGN_EPI) { if (wr == 1) PG8_BAR; }
    }
    PG8_WAIT_V(0);
    if constexpr (!ALIGN_EPI) { if (wr == 0) PG8_BAR; }
    PG8_BAR;
    if constexpr (Epi::AFTER_DRAIN) { E.fused(acc, cur, wr, wc, fr, fq, lds, wid, lane); S.done(cur); }
#undef PG8_SA
#undef PG8_SB
#undef PG8_STAGE
#undef PG8_LDA
#undef PG8_LDB
#undef PG8_MMA
#undef PG8_WAIT_V
#undef PG8_WAIT_L
#undef PG8_BAR
#undef PG8_SCHED
}
}

constexpr int NWAVES = 8;
constexpr int DM = 1024, SEQ = 8192, NBATCH = 4, M = NBATCH * SEQ, INW = 4096, PLE = 256, DEPTH = 2, HD = 128, NH = 4, NBLK = 32  , NCH = 64  ;
constexpr int C_RQ = 0, C_MQ = 512, C_RK = 1024, C_RV = 1536, C_RZ = 2048, C_MK = 2560, C_MV = 3072, C_MZ = 3584;
constexpr int C_X1B = 1024;
constexpr float RSQRT_HD = 0.08838834764831845f;

constexpr size_t MiB = 1u << 20;
constexpr size_t WS_CTL = 0, CTL_ZERO_BYTES = 1 * MiB;
constexpr size_t WS_WIN = 1 * MiB;
constexpr size_t WS_WOUT = 17 * MiB;
constexpr size_t WS_WG = 21 * MiB;
constexpr size_t WS_WPLE = 25 * MiB;
constexpr size_t WS_TAB = 26 * MiB;
constexpr size_t WS_LUT = 30 * MiB;
constexpr size_t WS_KMEAN = 30 * MiB + 128 * 1024;
constexpr size_t WS_SEL = 30 * MiB + 512 * 1024;
constexpr size_t WS_RSX = 31 * MiB;
constexpr size_t WS_RSX1 = 33 * MiB;
constexpr size_t WS_RSE = 35 * MiB;
constexpr size_t WS_PE = 37 * MiB;
constexpr size_t WS_KV = 53 * MiB;
constexpr size_t WS_EPRE = 85 * MiB;
constexpr size_t WS_XB = 149 * MiB;
constexpr size_t WS_PROJ = 245 * MiB;
constexpr size_t WS_END = 501 * MiB;
constexpr int CW_BAR = 4096;

constexpr int RING_OFF = 0, RING_BYTES = 131072;
constexpr int LDSCTL_OFF = 143360, MISC_OFF = LDSCTL_OFF + 320;
constexpr int LDS_BYTES = 147456;

#define GAS __attribute__((address_space(1)))
#define LAS __attribute__((address_space(3)))
typedef unsigned short bf16;
typedef unsigned v4u __attribute__((ext_vector_type(4)));
typedef unsigned v2u __attribute__((ext_vector_type(2)));
typedef float f32x4 __attribute__((ext_vector_type(4)));
typedef float f32x2v __attribute__((ext_vector_type(2)));
typedef GAS unsigned gu32;
#define RLX_AGENT __ATOMIC_RELAXED, __HIP_MEMORY_SCOPE_AGENT
#define LDS_WAIT() asm volatile("s_waitcnt lgkmcnt(0)" ::: "memory")
#define VM_WAIT() asm volatile("s_waitcnt vmcnt(0)" ::: "memory")
using pg8::pk2; using pg8::bflo; using pg8::bfhi;
__device__ __forceinline__ float bf2f(unsigned short u) { return __uint_as_float(((unsigned)u) << 16); }
#define XB_TMO      128
#define XB_XCNT(j)  (256  + 64 * (j))
#define XB_XSUB(j)  (1280 + 64 * (j))
#define XB_XGEN(j)  (2304 + 64 * (j))
#define XB_TOP      3328
#define XB_TOPGEN   3392
#define XCD_BAR_WORDS 3456
#define XB_SPIN_CAP (1u << 18)

__device__ __forceinline__ unsigned xb_ld(unsigned* p)              { return __hip_atomic_load(p, __ATOMIC_RELAXED, __HIP_MEMORY_SCOPE_AGENT); }
__device__ __forceinline__ unsigned xb_add(unsigned* p, unsigned v) { return __hip_atomic_fetch_add(p, v, __ATOMIC_RELAXED, __HIP_MEMORY_SCOPE_AGENT); }
__device__ __forceinline__ unsigned xb_xcc_id() { return (unsigned)__builtin_amdgcn_s_getreg((3 << 11) | 20) & 0xFu; }
#define XB_SPIN(cond, bar) do { unsigned _sp = 0; while (cond) { __builtin_amdgcn_s_sleep(1); \
    if ((++_sp & 255u) == 0u) { if (xb_ld(&(bar)[XB_TMO])) break; if (_sp > XB_SPIN_CAP) { atomicAdd(&(bar)[XB_TMO], 1u); break; } } } } while (0)

struct XcdBarrier {
    unsigned* bar; unsigned x;
    volatile LAS unsigned* st;
};

__device__ __forceinline__ XcdBarrier xcd_barrier_post(unsigned* bar, volatile LAS unsigned* st) {
    XcdBarrier b; b.bar = bar; b.x = xb_xcc_id(); b.st = st;
    if (threadIdx.x == 0) (void)xb_add(&bar[XB_XCNT(b.x)], 1u);
    return b;
}
__device__ __forceinline__ void xcd_barrier_complete(unsigned* bar, unsigned x, unsigned& nloc, unsigned& nx) {
    const unsigned G = gridDim.x * gridDim.y * gridDim.z;
    unsigned sum, cnt, mine, sp = 0u;
    for (;;) {
        sum = 0u; cnt = 0u; mine = 0u;
#pragma nounroll
        for (unsigned j = 0; j < 16; ++j) { const unsigned c = xb_ld(&bar[XB_XCNT(j)]); sum += c; cnt += (c > 0u) ? 1u : 0u; mine = (j == x) ? c : mine; }
        if (sum == G) break;
        __builtin_amdgcn_s_sleep(1);
        if ((++sp & 255u) == 0u) { if (xb_ld(&bar[XB_TMO])) break; if (sp > XB_SPIN_CAP) { atomicAdd(&bar[XB_TMO], 1u); break; } }
    }
    nloc = mine > 0u ? mine : 1u; nx = cnt > 0u ? cnt : 1u;
}

__device__ __forceinline__ void xcd_barrier(const XcdBarrier& b) {
    asm volatile("s_waitcnt vmcnt(0)" ::: "memory");
    __syncthreads();
    if (threadIdx.x == 0) {
        unsigned* bar = b.bar;
        __builtin_amdgcn_s_waitcnt(0);
        unsigned nloc = b.st[0], nx = b.st[1];
        if (nloc == 0u) { xcd_barrier_complete(bar, b.x, nloc, nx); b.st[0] = nloc; b.st[1] = nx; }
        const unsigned old = xb_add(&bar[XB_XSUB(b.x)], 1u);
        const unsigned gen = old / nloc;
        if (old + 1u == (gen + 1u) * nloc) {
            __builtin_amdgcn_fence(__ATOMIC_RELEASE, "agent");
            asm volatile("s_waitcnt vmcnt(0)" ::: "memory");
            const unsigned og = xb_add(&bar[XB_TOP], 1u);
            const unsigned tg = og / nx;
            if (og + 1u == (tg + 1u) * nx) xb_add(&bar[XB_TOPGEN], 1u);
            else XB_SPIN(xb_ld(&bar[XB_TOPGEN]) == tg, bar);
            __builtin_amdgcn_fence(__ATOMIC_ACQUIRE, "agent");
            xb_add(&bar[XB_XGEN(b.x)], 1u);
            asm volatile("s_waitcnt vmcnt(0)" ::: "memory");
        } else {
            XB_SPIN(xb_ld(&bar[XB_XGEN(b.x)]) == gen, bar);
            __builtin_amdgcn_fence(__ATOMIC_ACQUIRE, "agent");
            asm volatile("s_waitcnt vmcnt(0)" ::: "memory");
        }
    }
    __syncthreads();
}

__device__ __forceinline__ float wave_sum(float v) {
#pragma unroll
    for (int o = 1; o < 64; o <<= 1) v += __shfl_xor(v, o);
    return v;
}
__device__ __forceinline__ float wave_max(float v) {
#pragma unroll
    for (int o = 1; o < 64; o <<= 1) v = fmaxf(v, __shfl_xor(v, o));
    return v;
}
__device__ __forceinline__ float ret_log2g(int h) { return log2f(1.0f - exp2f(-5.0f - (float)h)); }

__device__ __forceinline__ int win_dst(int c) {
    const int g = c >> 9, w = c & 511, hd = w >> 7, i = w & 127;
    const int base = (g == 0) ? C_RQ : (g == 1) ? C_RK : (g == 2) ? C_RV : (g == 3) ? C_RZ : (g == 4) ? C_MQ : (g == 5) ? C_MK : (g == 6) ? C_MV : C_MZ;
    const int pos = (g <= 1) ? ((i < 64) ? 2 * i : 2 * (i - 64) + 1) : i;
    return base + hd * 128 + pos;
}
template <int MODE>
__device__ __forceinline__ void p0_transpose_item(const float* W, int K, int N, bf16* WT, const float* gk, LAS float* scr, int item, int lane) {
    const int nblk = N / 32, kb = item / nblk, nb = item % nblk, k0 = 64 * kb, n0 = 32 * nb;
#pragma unroll 8
    for (int i = 0; i < 32; ++i) { const int kk = 2 * i + (lane >> 5); float v = W[(size_t)(k0 + kk) * N + n0 + (lane & 31)]; if (MODE == 1) v *= gk[k0 + kk]; scr[kk * 33 + (lane & 31)] = v; }
    LDS_WAIT(); asm volatile("" ::: "memory");
    const int c = lane & 7;
#pragma unroll
    for (int j = 0; j < 4; ++j) { const int n = (lane >> 3) + 8 * j; const LAS float* s = scr + (8 * c) * 33 + n;
        v4u o; o.x = pk2(s[0 * 33], s[1 * 33]); o.y = pk2(s[2 * 33], s[3 * 33]); o.z = pk2(s[4 * 33], s[5 * 33]); o.w = pk2(s[6 * 33], s[7 * 33]);
        const int dst = (MODE == 1) ? win_dst(n0 + n) : (n0 + n);
        *(v4u*)(WT + (size_t)dst * K + k0 + 8 * c) = o; }
    LDS_WAIT(); asm volatile("" ::: "memory");
}
__device__ __forceinline__ void x_row_to_bf16(const float* xrow, bf16* orow, float* rs16, int lane) {
    const f32x4* xr = (const f32x4*)xrow + lane;
    f32x4 v[4]; float s = 0.f;
#pragma unroll
    for (int j = 0; j < 4; ++j) { v[j] = xr[64 * j]; s += (v[j][0] * v[j][0] + v[j][1] * v[j][1]) + (v[j][2] * v[j][2] + v[j][3] * v[j][3]); }
    s = wave_sum(s);
    v2u* o8 = (v2u*)orow + lane;
#pragma unroll
    for (int j = 0; j < 4; ++j) { v2u w; w.x = pk2(v[j][0], v[j][1]); w.y = pk2(v[j][2], v[j][3]); o8[64 * j] = w; }
    if (lane < 16) rs16[lane] = (lane == 0) ? s : 0.f;
}
__device__ __forceinline__ void cvt_f32_bf16(const float* src, bf16* dst, long n8, long gtid, long gthreads) {
    for (long i = gtid; i < n8; i += gthreads) {
        const f32x4 a = *(const f32x4*)(src + i * 8), b = *(const f32x4*)(src + i * 8 + 4);
        v4u w; w.x = pk2(a[0], a[1]); w.y = pk2(a[2], a[3]); w.z = pk2(b[0], b[1]); w.w = pk2(b[2], b[3]);
        *(v4u*)(dst + i * 8) = w; }
}
__device__ __forceinline__ void sincos_d(double a, double& s, double& c) {
    const double k = rint(a * 0.63661977236758134308);
    double r = fma(-k, 1.57079632679489655800e+00, a); r = fma(-k, 6.12323399573676603587e-17, r);
    const double r2 = r * r;
    double sp = 1.0 / 6227020800.0; sp = fma(sp, r2, -1.0 / 39916800.0); sp = fma(sp, r2, 1.0 / 362880.0); sp = fma(sp, r2, -1.0 / 5040.0); sp = fma(sp, r2, 1.0 / 120.0); sp = fma(sp, r2, -1.0 / 6.0); sp = fma(sp * r2, r, r);
    double cp = 1.0 / 87178291200.0; cp = fma(cp, r2, -1.0 / 479001600.0); cp = fma(cp, r2, 1.0 / 3628800.0); cp = fma(cp, r2, -1.0 / 40320.0); cp = fma(cp, r2, 1.0 / 720.0); cp = fma(cp, r2, -1.0 / 24.0); cp = fma(cp, r2, 0.5); cp = fma(-cp, r2, 1.0);
    const int q = ((int)k) & 3;
    s = (q == 0) ? sp : (q == 1) ? cp : (q == 2) ? -sp : -cp;
    c = (q == 0) ? cp : (q == 1) ? -sp : (q == 2) ? -cp : sp;
}
__device__ __forceinline__ int t5_bucket(int n) {
    if (n < 16) return n;
    const float v = logf((float)n * (1.0f / 16.0f)) / 4.852030263919617f * 16.0f;
    int b = 16 + (int)v; return b > 31 ? 31 : b;
}

struct Args {
    const float* x; const float* p; const float* norm_g; const float* w_in; const float* ret_norm_g; const float* q_norm_g; const float* k_norm_g; const float* rel_bias;
    const float* w_out; const float* w_ple; const float* ple_norm_g; const float* w_ple_gate; float* out; unsigned char* ws;
};
typedef const __attribute__((address_space(4))) Args* KA;
__device__ __forceinline__ KA get_ka() { KA p = (KA)__builtin_amdgcn_kernarg_segment_ptr(); asm volatile("" : "+s"(p)); return p; }
#define PHASE_IDS() int tid = threadIdx.x; asm volatile("" : "+v"(tid)); const int lane = tid & 63; const int wave = __builtin_amdgcn_readfirstlane(tid >> 6); \
    int bx_ = blockIdx.x; asm volatile("" : "+s"(bx_)); const int G = gridDim.x; const int vcu = (G % 8 == 0) ? (bx_ % 8) * (G / 8) + bx_ / 8 : bx_; (void)lane; (void)wave; (void)vcu

__device__ __forceinline__ void p0_prologue(KA A, LAS unsigned char* lds) {
    PHASE_IDS();
    unsigned char* ws = A->ws;
    LAS float* scr = (LAS float*)(lds + RING_OFF + wave * 16384);
    const int gw = vcu * NWAVES + wave, NGW = G * NWAVES;
    constexpr int I_IN = (DM / 64) * (INW / 32), I_O = (DM / 64) * (DM / 32), I_G = I_O, I_P = (PLE / 64) * (DM / 32), I_L = I_IN + I_O + I_G + I_P;
    for (int it = gw; it < DEPTH * I_L; it += NGW) {
        const int L = it / I_L; int r = it % I_L;
        if (r < I_IN) { p0_transpose_item<1>(A->w_in + (size_t)L * DM * INW, DM, INW, (bf16*)(ws + WS_WIN) + (size_t)L * INW * DM, A->norm_g + L * DM, scr, r, lane); continue; } r -= I_IN;
        if (r < I_O) { p0_transpose_item<0>(A->w_out + (size_t)L * DM * DM, DM, DM, (bf16*)(ws + WS_WOUT) + (size_t)L * DM * DM, nullptr, scr, r, lane); continue; } r -= I_O;
        if (r < I_G) { p0_transpose_item<0>(A->w_ple_gate + (size_t)L * DM * DM, DM, DM, (bf16*)(ws + WS_WG) + (size_t)L * DM * DM, nullptr, scr, r, lane); continue; } r -= I_G;
        p0_transpose_item<0>(A->w_ple + (size_t)L * PLE * DM, PLE, DM, (bf16*)(ws + WS_WPLE) + (size_t)L * DM * PLE, nullptr, scr, r, lane);
    }
    for (int m = gw; m < M; m += NGW) x_row_to_bf16(A->x + (size_t)m * DM, (bf16*)(ws + WS_XB) + (size_t)m * DM, (float*)(ws + WS_RSX) + (size_t)m * 16, lane);
    const long gtid = (long)vcu * (NWAVES * 64) + tid, gthreads = (long)G * NWAVES * 64;
    cvt_f32_bf16(A->p, (bf16*)(ws + WS_PE), (long)M * PLE / 8, gtid, gthreads);
    for (long i = gtid; i < (long)SEQ * 64; i += gthreads) {
        const int pos = (int)(i >> 6), fi = (int)(i & 63);
        const float inv = (float)exp2(-(double)fi * (1.0 / 64.0) * 13.287712379549449);
        const float ang = (float)pos * inv;
        double s, c; sincos_d((double)ang, s, c);
        ((f32x2v*)(ws + WS_TAB))[i] = (f32x2v){(float)c, (float)s};
    }
    for (long i = gtid; i < (long)NH * SEQ; i += gthreads) {
        const int h = (int)(i >> 13), n = (int)(i & 8191);
        ((float*)(ws + WS_LUT))[i] = A->rel_bias[t5_bucket(n) * NH + h];
    }
}

__device__ __forceinline__ void p1b_rowops(KA A, int L) {
    PHASE_IDS();
    unsigned char* ws = A->ws; bf16* PROJ = (bf16*)(ws + WS_PROJ);
    const int gw = vcu * NWAVES + wave, NGW = G * NWAVES;
    const int hd = lane >> 4, i0 = (lane & 15) * 4;
    const float lg2 = ret_log2g(hd);
    const float* qg = A->q_norm_g + L * HD + (lane & 15) * 8; const float* kg = A->k_norm_g + L * HD + (lane & 15) * 8;
    const f32x4 qg0 = *(const f32x4*)qg, qg1 = *(const f32x4*)(qg + 4), kg0 = *(const f32x4*)kg, kg1 = *(const f32x4*)(kg + 4);
    for (int t = gw; t < M; t += NGW) {
        const int pos = t & (SEQ - 1), j = pos & 127;
        bf16* row = PROJ + (size_t)t * INW;
        const f32x4* cs = (const f32x4*)((const f32x2v*)(ws + WS_TAB) + (size_t)pos * 64 + i0);
        const f32x4 cs0 = cs[0], cs1 = cs[1];
        const float gq = exp2f((float)j * lg2), gk = RSQRT_HD * exp2f(-(float)j * lg2);
        {   v4u w = *(v4u*)(row + C_RQ + 8 * lane);
            float a, b;
            a = bflo(w.x); b = bfhi(w.x); w.x = pk2((a * cs0[0] - b * cs0[1]) * gq, (a * cs0[1] + b * cs0[0]) * gq);
            a = bflo(w.y); b = bfhi(w.y); w.y = pk2((a * cs0[2] - b * cs0[3]) * gq, (a * cs0[3] + b * cs0[2]) * gq);
            a = bflo(w.z); b = bfhi(w.z); w.z = pk2((a * cs1[0] - b * cs1[1]) * gq, (a * cs1[1] + b * cs1[0]) * gq);
            a = bflo(w.w); b = bfhi(w.w); w.w = pk2((a * cs1[2] - b * cs1[3]) * gq, (a * cs1[3] + b * cs1[2]) * gq);
            *(v4u*)(row + C_RQ + 8 * lane) = w; }
        {   v4u w = *(v4u*)(row + C_RK + 8 * lane);
            float a, b;
            a = bflo(w.x); b = bfhi(w.x); w.x = pk2((a * cs0[0] - b * cs0[1]) * gk, (a * cs0[1] + b * cs0[0]) * gk);
            a = bflo(w.y); b = bfhi(w.y); w.y = pk2((a * cs0[2] - b * cs0[3]) * gk, (a * cs0[3] + b * cs0[2]) * gk);
            a = bflo(w.z); b = bfhi(w.z); w.z = pk2((a * cs1[0] - b * cs1[1]) * gk, (a * cs1[1] + b * cs1[0]) * gk);
            a = bflo(w.w); b = bfhi(w.w); w.w = pk2((a * cs1[2] - b * cs1[3]) * gk, (a * cs1[3] + b * cs1[2]) * gk);
            *(v4u*)(row + C_RK + 8 * lane) = w; }
        {   v4u w = *(v4u*)(row + C_MQ + 8 * lane);
            float v[8] = {bflo(w.x), bfhi(w.x), bflo(w.y), bfhi(w.y), bflo(w.z), bfhi(w.z), bflo(w.w), bfhi(w.w)};
            float ss = 0.f;
#pragma unroll
            for (int e = 0; e < 8; ++e) ss += v[e] * v[e];
            ss += __shfl_xor(ss, 1); ss += __shfl_xor(ss, 2); ss += __shfl_xor(ss, 4); ss += __shfl_xor(ss, 8);
            const float r = RSQRT_HD / sqrtf(ss * (1.0f / 128.0f) + pg8::EPS);
            w.x = pk2(v[0] * r * qg0[0], v[1] * r * qg0[1]); w.y = pk2(v[2] * r * qg0[2], v[3] * r * qg0[3]); w.z = pk2(v[4] * r * qg1[0], v[5] * r * qg1[1]); w.w = pk2(v[6] * r * qg1[2], v[7] * r * qg1[3]);
            *(v4u*)(row + C_MQ + 8 * lane) = w; }
        {   v4u w = *(v4u*)(row + C_MK + 8 * lane);
            float v[8] = {bflo(w.x), bfhi(w.x), bflo(w.y), bfhi(w.y), bflo(w.z), bfhi(w.z), bflo(w.w), bfhi(w.w)};
            float ss = 0.f;
#pragma unroll
            for (int e = 0; e < 8; ++e) ss += v[e] * v[e];
            ss += __shfl_xor(ss, 1); ss += __shfl_xor(ss, 2); ss += __shfl_xor(ss, 4); ss += __shfl_xor(ss, 8);
            const float r = 1.0f / sqrtf(ss * (1.0f / 128.0f) + pg8::EPS);
            w.x = pk2(v[0] * r * kg0[0], v[1] * r * kg0[1]); w.y = pk2(v[2] * r * kg0[2], v[3] * r * kg0[3]); w.z = pk2(v[4] * r * kg1[0], v[5] * r * kg1[1]); w.w = pk2(v[6] * r * kg1[2], v[7] * r * kg1[3]);
            *(v4u*)(row + C_MK + 8 * lane) = w; }
    }
}

__device__ __forceinline__ void p2_kmean(KA A) {
    PHASE_IDS();
    unsigned char* ws = A->ws; const bf16* PROJ = (const bf16*)(ws + WS_PROJ); float* KM = (float*)(ws + WS_KMEAN);
    for (int idx = vcu * (NWAVES * 64) + tid; idx < 16 * NBLK * HD; idx += G * NWAVES * 64) {
        const int bh = idx >> 12, blk = (idx >> 7) & 31, col = idx & 127, b = bh >> 2, h = bh & 3;
        const bf16* src = PROJ + (size_t)(b * SEQ + blk * 256) * INW + C_MK + h * HD + col;
        float s = 0.f;
#pragma unroll 8
        for (int r = 0; r < 256; ++r) s += bf2f(src[(size_t)r * INW]);
        KM[idx] = s * (1.0f / 256.0f);
    }
}
static_assert(4 * 128 * 272 <= LDSCTL_OFF, "retention tiles must stay below the LDS control words");
constexpr int TROW = 272;
__device__ __forceinline__ void stage_tile128(const bf16* g, size_t ld, unsigned char* dst, int tid) {
#pragma unroll
    for (int i = 0; i < 4; ++i) { const int ch = tid + i * 512, r = ch >> 4, c = ch & 15;
        *(v4u*)(dst + r * TROW + c * 16) = *(const v4u*)(g + (size_t)r * ld + c * 8); }
}
__device__ __forceinline__ void p2_kvsum(KA A, unsigned char* lds) {
    PHASE_IDS();
    unsigned char* ws = A->ws; const bf16* PROJ = (const bf16*)(ws + WS_PROJ); bf16* ST = (bf16*)(ws + WS_KV);
    unsigned char* Kt = lds; unsigned char* Vt = lds + 128 * TROW;
    const int e = tid >> 2, dp = tid & 3;
    for (int it = vcu; it < 16 * NCH; it += G) {
        const int bh = it >> 6, c = it & 63, b = bh >> 2, h = bh & 3;
        const size_t t0 = (size_t)b * SEQ + c * 128;
        stage_tile128(PROJ + t0 * INW + C_RK + h * HD, INW, Kt, tid);
        stage_tile128(PROJ + t0 * INW + C_RV + h * HD, INW, Vt, tid);
        __syncthreads();
        float acc[32];
#pragma unroll
        for (int i = 0; i < 32; ++i) acc[i] = 0.f;
        for (int m = 0; m < 128; ++m) {
            const float v = bf2f(*(const bf16*)(Vt + m * TROW + e * 2));
#pragma unroll
            for (int q = 0; q < 4; ++q) { const v4u w = *(const v4u*)(Kt + m * TROW + dp * 64 + q * 16);
                acc[q * 8 + 0] += v * bflo(w.x); acc[q * 8 + 1] += v * bfhi(w.x); acc[q * 8 + 2] += v * bflo(w.y); acc[q * 8 + 3] += v * bfhi(w.y);
                acc[q * 8 + 4] += v * bflo(w.z); acc[q * 8 + 5] += v * bfhi(w.z); acc[q * 8 + 6] += v * bflo(w.w); acc[q * 8 + 7] += v * bfhi(w.w); }
        }
        bf16* o = ST + ((size_t)it * 128 + e) * 128 + dp * 32;
#pragma unroll
        for (int q = 0; q < 4; ++q) { v4u w; w.x = pk2(acc[q * 8 + 0], acc[q * 8 + 1]); w.y = pk2(acc[q * 8 + 2], acc[q * 8 + 3]); w.z = pk2(acc[q * 8 + 4], acc[q * 8 + 5]); w.w = pk2(acc[q * 8 + 6], acc[q * 8 + 7]);
            *(v4u*)(o + q * 8) = w; }
        __syncthreads();
    }
}

__device__ __forceinline__ void p2b_gating(KA A, unsigned char* lds) {
    PHASE_IDS();
    unsigned char* ws = A->ws; const bf16* PROJ = (const bf16*)(ws + WS_PROJ); const float* KM = (const float*)(ws + WS_KMEAN); unsigned* SEL = (unsigned*)(ws + WS_SEL);
    float* km = (float*)lds;
    const int q = tid >> 1, half = tid & 1;
    for (int it = vcu; it < 16 * NBLK; it += G) {
        const int bh = it >> 5, qb = it & 31, b = bh >> 2, h = bh & 3;
        for (int i = tid; i < qb * 32; i += NWAVES * 64) ((f32x4*)km)[i] = ((const f32x4*)(KM + (size_t)bh * NBLK * HD))[i];
        __syncthreads();
        const size_t t = (size_t)b * SEQ + qb * 256 + q;
        const bf16* qp = PROJ + t * INW + C_MQ + h * HD + half * 64;
        float qf[64];
#pragma unroll
        for (int c = 0; c < 8; ++c) { const v4u w = *(const v4u*)(qp + c * 8);
            qf[c * 8 + 0] = bflo(w.x); qf[c * 8 + 1] = bfhi(w.x); qf[c * 8 + 2] = bflo(w.y); qf[c * 8 + 3] = bfhi(w.y); qf[c * 8 + 4] = bflo(w.z); qf[c * 8 + 5] = bfhi(w.z); qf[c * 8 + 6] = bflo(w.w); qf[c * 8 + 7] = bfhi(w.w); }
        float v0 = -3e38f, v1 = -3e38f, v2 = -3e38f; int i0 = -1, i1 = -1, i2 = -1;
        for (int n = 0; n < qb; ++n) {
            const f32x4* kr = (const f32x4*)(km + n * HD + half * 64);
            float d0 = 0.f, d1 = 0.f, d2 = 0.f, d3 = 0.f;
#pragma unroll
            for (int c = 0; c < 16; ++c) { const f32x4 k4 = kr[c]; d0 += qf[c * 4 + 0] * k4[0]; d1 += qf[c * 4 + 1] * k4[1]; d2 += qf[c * 4 + 2] * k4[2]; d3 += qf[c * 4 + 3] * k4[3]; }
            float d = (d0 + d1) + (d2 + d3);
            d += __shfl_xor(d, 1);
            if (d > v0) { v2 = v1; i2 = i1; v1 = v0; i1 = i0; v0 = d; i0 = n; }
            else if (d > v1) { v2 = v1; i2 = i1; v1 = d; i1 = n; }
            else if (d > v2) { v2 = d; i2 = n; }
        }
        unsigned mask = 0u;
        if (i0 >= 0) mask |= 1u << i0; if (i1 >= 0) mask |= 1u << i1; if (i2 >= 0) mask |= 1u << i2;
        if (half == 0) SEL[t * NH + h] = mask;
        __syncthreads();
    }
}

__device__ __forceinline__ void p3_scan(KA A) {
    PHASE_IDS();
    unsigned* ST = (unsigned*)(A->ws + WS_KV);
    for (int idx = vcu * (NWAVES * 64) + tid; idx < 16 * 8192; idx += G * NWAVES * 64) {
        const int bh = idx >> 13, pr = idx & 8191, h = bh & 3;
        const float lg2 = ret_log2g(h), g1 = exp2f(lg2), g127 = exp2f(127.f * lg2), g128 = exp2f(128.f * lg2);
        unsigned* p = ST + (size_t)bh * NCH * 8192 + pr;
        float s0 = 0.f, s1 = 0.f;
#pragma unroll 8
        for (int c = 0; c < NCH; ++c) {
            const unsigned w = p[(size_t)c * 8192];
            p[(size_t)c * 8192] = pk2(g1 * s0, g1 * s1);
            s0 = s0 * g128 + g127 * bflo(w); s1 = s1 * g128 + g127 * bfhi(w);
        }
    }
}

__device__ __forceinline__ void p3_moba_naive(KA A, unsigned char* lds) {
    PHASE_IDS();
    unsigned char* ws = A->ws; bf16* PROJ = (bf16*)(ws + WS_PROJ); const unsigned* SEL = (const unsigned*)(ws + WS_SEL); const float* LUT = (const float*)(ws + WS_LUT);
    float* qs = (float*)(lds + wave * 5120);
    float* ps = qs + 128;
    const int gw = vcu * NWAVES + wave, NGW = G * NWAVES;
    for (int item = gw; item < M * NH; item += NGW) {
        const int t = item >> 2, h = item & 3, b = t >> 13, pos = t & (SEQ - 1), qb = pos >> 8;
        const unsigned mask = SEL[item];
        int blk[4]; int nsel = 0;
        { unsigned mm = mask; const int a0 = mm ? __builtin_ctz(mm) : 0; if (mm) { mm &= mm - 1; ++nsel; } const int a1 = mm ? __builtin_ctz(mm) : 0; if (mm) { mm &= mm - 1; ++nsel; } const int a2 = mm ? __builtin_ctz(mm) : 0; if (mm) { ++nsel; }
          blk[0] = a0; blk[1] = a1; blk[2] = a2; blk[3] = qb; }
        const unsigned qw = *(const unsigned*)(PROJ + (size_t)t * INW + C_MQ + h * HD + 2 * lane);
        qs[2 * lane] = bflo(qw); qs[2 * lane + 1] = bfhi(qw);
        LDS_WAIT();
        const float* lut = LUT + h * SEQ;
        float sc[16]; float mx = -1e30f;
#pragma unroll
        for (int sl = 0; sl < 4; ++sl) {
            const bool on = (sl == 3) || (sl < nsel);
#pragma unroll
            for (int kk = 0; kk < 4; ++kk) {
                float s = -1e30f;
                if (on) {
                    const int kpos = blk[sl] * 256 + kk * 64 + lane;
                    const bf16* kp = PROJ + ((size_t)b * SEQ + kpos) * INW + C_MK + h * HD;
                    float d = 0.f;
#pragma unroll
                    for (int c = 0; c < 16; ++c) { const v4u w = *(const v4u*)(kp + c * 8); const f32x4 q0 = *(const f32x4*)(qs + c * 8), q1 = *(const f32x4*)(qs + c * 8 + 4);
                        d += (bflo(w.x) * q0[0] + bfhi(w.x) * q0[1]) + (bflo(w.y) * q0[2] + bfhi(w.y) * q0[3]) + (bflo(w.z) * q1[0] + bfhi(w.z) * q1[1]) + (bflo(w.w) * q1[2] + bfhi(w.w) * q1[3]); }
                    const int dist = pos - kpos;
                    if (dist >= 0) s = d + lut[dist];
                }
                sc[sl * 4 + kk] = s; mx = fmaxf(mx, s);
            }
        }
        mx = wave_max(mx);
        float l = 0.f;
#pragma unroll
        for (int i = 0; i < 16; ++i) { const float pz = (sc[i] > -1e29f) ? __expf(sc[i] - mx) : 0.f; l += pz; ps[i * 64 + lane] = pz; }
        l = wave_sum(l);
        LDS_WAIT();
        float o0 = 0.f, o1 = 0.f;
#pragma unroll
        for (int sl = 0; sl < 4; ++sl) {
            const bool on = (sl == 3) || (sl < nsel);
            if (on) {
                const bf16* vp = PROJ + ((size_t)b * SEQ + blk[sl] * 256) * INW + C_MV + h * HD + 2 * lane;
#pragma unroll 8
                for (int k = 0; k < 256; ++k) { const float pz = ps[sl * 256 + k]; const unsigned w = *(const unsigned*)(vp + (size_t)k * INW); o0 += pz * bflo(w); o1 += pz * bfhi(w); }
            }
        }
        const float inv = 1.0f / l;
        const unsigned zw = *(const unsigned*)(PROJ + (size_t)t * INW + C_MZ + h * HD + 2 * lane);
        const float z0 = bflo(zw), z1 = bfhi(zw);
        const float r0 = o0 * inv * (z0 / (1.0f + __expf(-z0))), r1 = o1 * inv * (z1 / (1.0f + __expf(-z1)));
        *(unsigned*)(PROJ + (size_t)t * INW + C_MQ + h * HD + 2 * lane) = pk2(r0, r1);
        LDS_WAIT();
    }
}

__device__ __forceinline__ void p4_ret_naive(KA A, int L, unsigned char* lds) {
    PHASE_IDS();
    unsigned char* ws = A->ws; bf16* PROJ = (bf16*)(ws + WS_PROJ); const bf16* ST = (const bf16*)(ws + WS_KV);
    unsigned char* Qt = lds; unsigned char* Kt = lds + 128 * TROW; unsigned char* Vt = lds + 2 * 128 * TROW; unsigned char* St = lds + 3 * 128 * TROW;
    const int n = tid >> 2, part = tid & 3;
    for (int it = vcu; it < 16 * NCH; it += G) {
        const int bh = it >> 6, c = it & 63, b = bh >> 2, h = bh & 3;
        const size_t t0 = (size_t)b * SEQ + c * 128;
        stage_tile128(PROJ + t0 * INW + C_RQ + h * HD, INW, Qt, tid);
        stage_tile128(PROJ + t0 * INW + C_RK + h * HD, INW, Kt, tid);
        stage_tile128(PROJ + t0 * INW + C_RV + h * HD, INW, Vt, tid);
        stage_tile128(ST + (size_t)it * 128 * 128, 128, St, tid);
        __syncthreads();
        float qf[32];
#pragma unroll
        for (int q = 0; q < 4; ++q) { const v4u w = *(const v4u*)(Qt + n * TROW + part * 64 + q * 16);
            qf[q * 8 + 0] = bflo(w.x); qf[q * 8 + 1] = bfhi(w.x); qf[q * 8 + 2] = bflo(w.y); qf[q * 8 + 3] = bfhi(w.y); qf[q * 8 + 4] = bflo(w.z); qf[q * 8 + 5] = bfhi(w.z); qf[q * 8 + 6] = bflo(w.w); qf[q * 8 + 7] = bfhi(w.w); }
        float o[32];
#pragma unroll
        for (int i = 0; i < 32; ++i) o[i] = 0.f;
        const int mend = (n | 15) + 1;
        for (int m = 0; m < mend; ++m) {
            float s = 0.f;
#pragma unroll
            for (int q = 0; q < 4; ++q) { const v4u w = *(const v4u*)(Kt + m * TROW + part * 64 + q * 16);
                s += (qf[q * 8 + 0] * bflo(w.x) + qf[q * 8 + 1] * bfhi(w.x)) + (qf[q * 8 + 2] * bflo(w.y) + qf[q * 8 + 3] * bfhi(w.y)) + (qf[q * 8 + 4] * bflo(w.z) + qf[q * 8 + 5] * bfhi(w.z)) + (qf[q * 8 + 6] * bflo(w.w) + qf[q * 8 + 7] * bfhi(w.w)); }
            s += __shfl_xor(s, 1); s += __shfl_xor(s, 2);
            if (m > n) s = 0.f;
#pragma unroll
            for (int q = 0; q < 4; ++q) { const v4u w = *(const v4u*)(Vt + m * TROW + part * 64 + q * 16);
                o[q * 8 + 0] += s * bflo(w.x); o[q * 8 + 1] += s * bfhi(w.x); o[q * 8 + 2] += s * bflo(w.y); o[q * 8 + 3] += s * bfhi(w.y); o[q * 8 + 4] += s * bflo(w.z); o[q * 8 + 5] += s * bfhi(w.z); o[q * 8 + 6] += s * bflo(w.w); o[q * 8 + 7] += s * bfhi(w.w); }
        }
        for (int d8 = 0; d8 < 16; ++d8) {
            const v4u qw = *(const v4u*)(Qt + n * TROW + d8 * 16);
            const float q0 = bflo(qw.x), q1 = bfhi(qw.x), q2 = bflo(qw.y), q3 = bfhi(qw.y), q4 = bflo(qw.z), q5 = bfhi(qw.z), q6 = bflo(qw.w), q7 = bfhi(qw.w);
#pragma unroll
            for (int ee = 0; ee < 32; ++ee) { const v4u w = *(const v4u*)(St + (part * 32 + ee) * TROW + d8 * 16);
                o[ee] += (q0 * bflo(w.x) + q1 * bfhi(w.x)) + (q2 * bflo(w.y) + q3 * bfhi(w.y)) + (q4 * bflo(w.z) + q5 * bfhi(w.z)) + (q6 * bflo(w.w) + q7 * bfhi(w.w)); }
        }
        float sm = 0.f;
#pragma unroll
        for (int i = 0; i < 32; ++i) sm += o[i];
        sm += __shfl_xor(sm, 1); sm += __shfl_xor(sm, 2);
        const float mean = sm * (1.0f / 128.0f);
        float vr = 0.f;
#pragma unroll
        for (int i = 0; i < 32; ++i) { const float dlt = o[i] - mean; vr += dlt * dlt; }
        vr += __shfl_xor(vr, 1); vr += __shfl_xor(vr, 2);
        const float rstd = 1.0f / sqrtf(vr * (1.0f / 128.0f) + pg8::EPS);
        const float* gn = A->ret_norm_g + L * 512 + h * HD + part * 32;
        bf16* zrow = PROJ + (t0 + n) * INW + C_RZ + h * HD + part * 32;
        bf16* orow = PROJ + (t0 + n) * INW + C_RQ + h * HD + part * 32;
#pragma unroll
        for (int q = 0; q < 4; ++q) { const v4u zw = *(const v4u*)(zrow + q * 8); const f32x4 g0 = *(const f32x4*)(gn + q * 8), g1 = *(const f32x4*)(gn + q * 8 + 4);
            float z[8] = {bflo(zw.x), bfhi(zw.x), bflo(zw.y), bfhi(zw.y), bflo(zw.z), bfhi(zw.z), bflo(zw.w), bfhi(zw.w)};
            float r[8];
#pragma unroll
            for (int e = 0; e < 8; ++e) { const float gg = (e < 4) ? g0[e & 3] : g1[e & 3]; r[e] = (o[q * 8 + e] - mean) * rstd * gg * (z[e] / (1.0f + __expf(-z[e]))); }
            v4u w; w.x = pk2(r[0], r[1]); w.y = pk2(r[2], r[3]); w.z = pk2(r[4], r[5]); w.w = pk2(r[6], r[7]);
            *(v4u*)(orow + q * 8) = w; }
        __syncthreads();
    }
}

constexpr size_t WS_PARTO = WS_XB;
constexpr size_t WS_PARTML = 501 * MiB;
constexpr size_t WS_LIST = 504 * MiB;
constexpr size_t WS_CNT = 508 * MiB;
constexpr int CW_TOT = 8192;
static_assert(WS_PARTO + (size_t)M * NH * 3 * 128 * 2 <= WS_PROJ && WS_CNT + 16 * 32 * 32 * 4 <= 512 * MiB, "MoBA workspace");

namespace mb {
using bf16x8 = __attribute__((ext_vector_type(8))) short;
using s16x4  = __attribute__((ext_vector_type(4))) short;
using f32x16 = __attribute__((ext_vector_type(16))) float;
using u32x4  = __attribute__((ext_vector_type(4))) unsigned;
constexpr int KVBLK = 64, QBLK = 32;
constexpr int SHM_V = KVBLK * 128 * 2, SHM_K = KVBLK * 128 * 2;
constexpr int L_V = 0, L_K = 2 * SHM_V, L_WS = 2 * SHM_V + 2 * SHM_K  , L_LUT = L_WS + 2048  , L_QPOS = L_LUT + 32768  ,
              L_TAB = L_QPOS + 1024  , L_SEG = L_TAB + 2048  , L_COEF = L_SEG + 256  , L_END = L_COEF + 4096;
static_assert(L_END <= LDSCTL_OFF, "MoBA LDS map");
#define MB_KSWZ(row, colB) ((row) * 256 + ((colB) ^ (((row) & 7) << 4)))
#define MB_SBAR() __builtin_amdgcn_sched_barrier(0)
__device__ __forceinline__ int crow(int r, int hi) { return (r & 3) + 8 * (r >> 2) + 4 * hi; }
__device__ __forceinline__ unsigned cvtpk(float lo, float hi) { unsigned r; asm volatile("v_cvt_pk_bf16_f32 %0, %1, %2" : "=v"(r) : "v"(lo), "v"(hi)); return r; }
constexpr float LOG2E = 1.4426950408889634f;
constexpr float THR = 0.f;

__device__ __forceinline__ void partialSM(f32x16& p0, f32x16& p1, float& m_reg, float& mn, float& alpha) {
  float pmax = p0[0];
#pragma unroll
  for (int r = 1; r < 16; ++r) pmax = fmaxf(pmax, p0[r]);
#pragma unroll
  for (int r = 0; r < 16; ++r) pmax = fmaxf(pmax, p1[r]);
  { auto rr = __builtin_amdgcn_permlane32_swap(__float_as_uint(pmax), __float_as_uint(pmax), false, false);
    pmax = fmaxf(__uint_as_float(rr[0]), __uint_as_float(rr[1])); }
  if (__builtin_expect(__all(pmax - m_reg <= THR), 1)) { mn = m_reg; alpha = 1.f; }
  else { mn = fmaxf(m_reg, pmax); alpha = __builtin_amdgcn_exp2f((m_reg - mn) * LOG2E); m_reg = mn; }
  const float mnC = -mn * LOG2E;
#pragma unroll
  for (int r = 0; r < 16; ++r) p0[r] = fmaf(p0[r], LOG2E, mnC);
#pragma unroll
  for (int r = 0; r < 16; ++r) p1[r] = fmaf(p1[r], LOG2E, mnC);
#pragma unroll
  for (int r = 0; r < 16; ++r) p0[r] = __builtin_amdgcn_exp2f(p0[r]);
}
__device__ __forceinline__ void finishSM(f32x16& p0, f32x16& p1, float alpha, float& l_reg, bf16x8& pa0, bf16x8& pa1, bf16x8& pa2, bf16x8& pa3) {
#pragma unroll
  for (int r = 0; r < 16; ++r) p1[r] = __builtin_amdgcn_exp2f(p1[r]);
  float ps = 0;
#pragma unroll
  for (int r = 0; r < 16; ++r) ps += p0[r];
#pragma unroll
  for (int r = 0; r < 16; ++r) ps += p1[r];
  { auto rr = __builtin_amdgcn_permlane32_swap(__float_as_uint(ps), __float_as_uint(ps), false, false);
    ps = __uint_as_float(rr[0]) + __uint_as_float(rr[1]); }
  l_reg = l_reg * alpha + ps;
#define MB_PK4(P, BASE, OUT) do { unsigned a0 = cvtpk(P[BASE + 0], P[BASE + 1]), a1 = cvtpk(P[BASE + 2], P[BASE + 3]);   \
    unsigned b0 = cvtpk(P[BASE + 4], P[BASE + 5]), b1 = cvtpk(P[BASE + 6], P[BASE + 7]);                              \
    auto r0 = __builtin_amdgcn_permlane32_swap(a0, b0, false, false); auto r1 = __builtin_amdgcn_permlane32_swap(a1, b1, false, false); \
    u32x4 w = {r0[0], r1[0], r0[1], r1[1]}; OUT = *reinterpret_cast<bf16x8*>(&w); } while (0)
  MB_PK4(p0, 0, pa0); MB_PK4(p0, 8, pa1); MB_PK4(p1, 0, pa2); MB_PK4(p1, 8, pa3);
#undef MB_PK4
}
template <bool OWN>
__device__ __forceinline__ void qkt(f32x16& p0, f32x16& p1, const char* Ks, const bf16x8* qr, int r32, int hi, int dq, const float* lut) {
#pragma unroll
  for (int r = 0; r < 16; ++r) {
    const int i0 = dq - crow(r, hi), i1 = i0 - 32;
    if (OWN) { p0[r] = (i0 >= 0) ? lut[i0 < 0 ? 0 : i0] : -1e30f; p1[r] = (i1 >= 0) ? lut[i1 < 0 ? 0 : i1] : -1e30f; }
    else { p0[r] = lut[i0]; p1[r] = lut[i1]; }
  }
#pragma unroll
  for (int d0 = 0; d0 < 8; ++d0) { const int cb = (d0 * 16 + hi * 8) * 2;
    const bf16x8 b0 = *reinterpret_cast<const bf16x8*>(Ks + MB_KSWZ(r32, cb));
    const bf16x8 b1 = *reinterpret_cast<const bf16x8*>(Ks + MB_KSWZ(32 + r32, cb));
    p0 = __builtin_amdgcn_mfma_f32_32x32x16_bf16(b0, qr[d0], p0, 0, 0, 0);
    p1 = __builtin_amdgcn_mfma_f32_32x32x16_bf16(b1, qr[d0], p1, 0, 0, 0); }
}
__device__ __forceinline__ int v_st(int k, int c) { const int kk = (k & ~0xC) | ((k & 4) << 1) | ((k & 8) >> 1); return ((kk >> 3) * 4 + (c >> 5)) * 512 + ((kk & 7) * 32 + (c & 31)) * 2; }
__device__ __forceinline__ int v_rd_base(int lane) { return ((lane & 3) << 3) | (((lane >> 2) & 3) << 6) | (((lane >> 4) & 1) << 5) | (((lane >> 5) & 1) << 8); }
constexpr int v_rd_off(int d0, int ks, int half) { return d0 * 512 + ks * 4096 + half * 2048; }
template <int OFF> __device__ __forceinline__ s16x4 tr_read(int vb) { s16x4 r; asm volatile("ds_read_b64_tr_b16 %0, %1 offset:%2" : "=&v"(r) : "v"(vb), "i"(OFF) : "memory"); return r; }
template <int D0> __device__ __forceinline__ void pv_one(f32x16& od, int vb, bf16x8 pa0, bf16x8 pa1, bf16x8 pa2, bf16x8 pa3) {
  const s16x4 l0 = tr_read<v_rd_off(D0, 0, 0)>(vb), h0 = tr_read<v_rd_off(D0, 0, 1)>(vb), l1 = tr_read<v_rd_off(D0, 1, 0)>(vb), h1 = tr_read<v_rd_off(D0, 1, 1)>(vb);
  const s16x4 l2 = tr_read<v_rd_off(D0, 2, 0)>(vb), h2 = tr_read<v_rd_off(D0, 2, 1)>(vb), l3 = tr_read<v_rd_off(D0, 3, 0)>(vb), h3 = tr_read<v_rd_off(D0, 3, 1)>(vb);
  asm volatile("s_waitcnt lgkmcnt(0)" ::: "memory"); MB_SBAR();
#define MB_PK(L, H) (bf16x8){L[0], L[1], L[2], L[3], H[0], H[1], H[2], H[3]}
  od = __builtin_amdgcn_mfma_f32_32x32x16_bf16(pa0, MB_PK(l0, h0), od, 0, 0, 0);
  od = __builtin_amdgcn_mfma_f32_32x32x16_bf16(pa1, MB_PK(l1, h1), od, 0, 0, 0);
  od = __builtin_amdgcn_mfma_f32_32x32x16_bf16(pa2, MB_PK(l2, h2), od, 0, 0, 0);
  od = __builtin_amdgcn_mfma_f32_32x32x16_bf16(pa3, MB_PK(l3, h3), od, 0, 0, 0);
#undef MB_PK
}
__device__ __forceinline__ void pv_d0(f32x16* o, int vb, bf16x8 pa0, bf16x8 pa1, bf16x8 pa2, bf16x8 pa3) {
  pv_one<0>(o[0], vb, pa0, pa1, pa2, pa3); pv_one<1>(o[1], vb, pa0, pa1, pa2, pa3); pv_one<2>(o[2], vb, pa0, pa1, pa2, pa3); pv_one<3>(o[3], vb, pa0, pa1, pa2, pa3);
}

template <bool OWN>
__device__ __forceinline__ void attend_block(const bf16* __restrict__ Qseq, const bf16* __restrict__ Kh, const bf16* __restrict__ Vh, int kpos0, char* lds, f32x16 (&o)[4], float& m_out, float& l_out, int tid) {
  const int wid = tid >> 6, lane = tid & 63, r32 = lane & 31, hi = lane >> 5;
  char* V_lds = lds + L_V; char* K_lds = lds + L_K;
  float* wsf = (float*)(lds + L_WS) + wid * 64; float* al_l = wsf + 32;
  const float* lut = (const float*)(lds + L_LUT);
  const int qp = ((const int*)(lds + L_QPOS))[wid * QBLK + r32];
  float m_reg = -1e30f, l_reg = 0; bf16x8 qr[8];
  const bf16* Qw = Qseq + (size_t)qp * INW + hi * 8;
#pragma unroll
  for (int d0 = 0; d0 < 8; ++d0) qr[d0] = *reinterpret_cast<const bf16x8*>(Qw + d0 * 16);
#pragma unroll
  for (int d = 0; d < 4; ++d) o[d] = f32x16{};
  const int sr = tid >> 4, sc = (tid & 15) * 8, vst0 = v_st(sr, sc), vst1 = v_st(32 + sr, sc);
  const int vb0 = (int)(uintptr_t)V_lds + v_rd_base(lane);
  const int dq0 = qp - kpos0;
  struct { bf16x8 vs0, vs1, ks0, ks1; } sr_;
#define MB_SLOAD(k0) do { sr_.vs0 = *reinterpret_cast<const bf16x8*>(&Vh[(size_t)((k0) + sr) * INW + sc]); sr_.vs1 = *reinterpret_cast<const bf16x8*>(&Vh[(size_t)((k0) + 32 + sr) * INW + sc]); \
    sr_.ks0 = *reinterpret_cast<const bf16x8*>(&Kh[(size_t)((k0) + sr) * INW + sc]); sr_.ks1 = *reinterpret_cast<const bf16x8*>(&Kh[(size_t)((k0) + 32 + sr) * INW + sc]); } while (0)
#define MB_SWRITE(b) do { asm volatile("s_waitcnt vmcnt(0)" ::: "memory"); *(bf16x8*)(V_lds + (b) * SHM_V + vst0) = sr_.vs0; *(bf16x8*)(V_lds + (b) * SHM_V + vst1) = sr_.vs1; const int kc = sc * 2; \
    *(bf16x8*)(K_lds + (b) * SHM_K + MB_KSWZ(sr, kc)) = sr_.ks0; *(bf16x8*)(K_lds + (b) * SHM_K + MB_KSWZ(32 + sr, kc)) = sr_.ks1; } while (0)
#define MB_RESC(a) do { if (__any((a) < 1.f)) { if (hi == 0) al_l[r32] = (a); asm volatile("s_waitcnt lgkmcnt(0)" ::: "memory"); \
    _Pragma("unroll") for (int d = 0; d < 4; ++d) _Pragma("unroll") for (int r = 0; r < 16; ++r) o[d][r] *= al_l[crow(r, hi)]; } } while (0)
  f32x16 pA0, pA1, pB0, pB1; float mnA, mnB, alA, alB; bf16x8 pa0, pa1, pa2, pa3;
  MB_SLOAD(0); MB_SWRITE(0); __syncthreads();
  qkt<OWN>(pA0, pA1, K_lds, qr, r32, hi, dq0, lut); partialSM(pA0, pA1, m_reg, mnA, alA);
  MB_SLOAD(KVBLK); MB_SWRITE(1); __syncthreads();
  MB_SBAR(); qkt<OWN>(pB0, pB1, K_lds + SHM_K, qr, r32, hi, dq0 - KVBLK, lut);
  finishSM(pA0, pA1, alA, l_reg, pa0, pa1, pa2, pa3); MB_SBAR();
  MB_SLOAD(2 * KVBLK); MB_SBAR();
  pv_d0(o, vb0, pa0, pa1, pa2, pa3); partialSM(pB0, pB1, m_reg, mnB, alB);
  __syncthreads(); MB_SWRITE(0);
  MB_RESC(alB); __syncthreads();
  MB_SBAR(); qkt<OWN>(pA0, pA1, K_lds, qr, r32, hi, dq0 - 2 * KVBLK, lut);
  finishSM(pB0, pB1, alB, l_reg, pa0, pa1, pa2, pa3); MB_SBAR();
  MB_SLOAD(3 * KVBLK); MB_SBAR();
  pv_d0(o, vb0 + SHM_V, pa0, pa1, pa2, pa3); partialSM(pA0, pA1, m_reg, mnA, alA);
  __syncthreads(); MB_SWRITE(1);
  MB_RESC(alA); __syncthreads();
  MB_SBAR(); qkt<OWN>(pB0, pB1, K_lds + SHM_K, qr, r32, hi, dq0 - 3 * KVBLK, lut);
  finishSM(pA0, pA1, alA, l_reg, pa0, pa1, pa2, pa3); MB_SBAR();
  pv_d0(o, vb0, pa0, pa1, pa2, pa3); partialSM(pB0, pB1, m_reg, mnB, alB);
  MB_RESC(alB);
  finishSM(pB0, pB1, alB, l_reg, pa0, pa1, pa2, pa3); MB_SBAR();
  pv_d0(o, vb0 + SHM_V, pa0, pa1, pa2, pa3);
  m_out = m_reg; l_out = l_reg;
  __syncthreads();
#undef MB_SLOAD
#undef MB_SWRITE
#undef MB_RESC
}
__device__ __forceinline__ void stage_rows_bf16(const f32x16 (&o)[4], const float* rowscale, char* stg, int r32, int hi) {
#pragma unroll
  for (int r = 0; r < 16; ++r) { const int row = crow(r, hi); const float s = rowscale[row];
#pragma unroll
    for (int d0 = 0; d0 < 4; ++d0) *(unsigned short*)(stg + row * 256 + (d0 * 32 + r32) * 2) = (unsigned short)(cvtpk(o[d0][r] * s, 0.f) & 0xffffu); }
}
}

__device__ __forceinline__ void p2b_gating_lists(KA A, unsigned char* lds) {
    PHASE_IDS();
    unsigned char* ws = A->ws; const bf16* PROJ = (const bf16*)(ws + WS_PROJ); const float* KM = (const float*)(ws + WS_KMEAN); unsigned* SEL = (unsigned*)(ws + WS_SEL);
    unsigned char* LIST = ws + WS_LIST; unsigned* CNT = (unsigned*)(ws + WS_CNT); unsigned* TOT = (unsigned*)(ws + WS_CTL) + CW_TOT;
    float* km = (float*)lds; int* wc = (int*)(lds + 16384);
    const int q = tid >> 1, half = tid & 1;
    for (int it = vcu; it < 16 * NBLK; it += G) {
        const int bh = it >> 5, qb = it & 31, b = bh >> 2, h = bh & 3;
        for (int i = tid; i < qb * 32; i += NWAVES * 64) ((f32x4*)km)[i] = ((const f32x4*)(KM + (size_t)bh * NBLK * HD))[i];
        __syncthreads();
        const size_t t = (size_t)b * SEQ + qb * 256 + q;
        const bf16* qp = PROJ + t * INW + C_MQ + h * HD + half * 64;
        float qf[64];
#pragma unroll
        for (int c = 0; c < 8; ++c) { const v4u w = *(const v4u*)(qp + c * 8);
            qf[c * 8 + 0] = bflo(w.x); qf[c * 8 + 1] = bfhi(w.x); qf[c * 8 + 2] = bflo(w.y); qf[c * 8 + 3] = bfhi(w.y); qf[c * 8 + 4] = bflo(w.z); qf[c * 8 + 5] = bfhi(w.z); qf[c * 8 + 6] = bflo(w.w); qf[c * 8 + 7] = bfhi(w.w); }
        float v0 = -3e38f, v1 = -3e38f, v2 = -3e38f; int i0 = -1, i1 = -1, i2 = -1;
        for (int n = 0; n < qb; ++n) {
            const f32x4* kr = (const f32x4*)(km + n * HD + half * 64);
            float d0 = 0.f, d1 = 0.f, d2 = 0.f, d3 = 0.f;
#pragma unroll
            for (int c = 0; c < 16; ++c) { const f32x4 k4 = kr[c]; d0 += qf[c * 4 + 0] * k4[0]; d1 += qf[c * 4 + 1] * k4[1]; d2 += qf[c * 4 + 2] * k4[2]; d3 += qf[c * 4 + 3] * k4[3]; }
            float d = (d0 + d1) + (d2 + d3);
            d += __shfl_xor(d, 1);
            if (d > v0) { v2 = v1; i2 = i1; v1 = v0; i1 = i0; v0 = d; i0 = n; }
            else if (d > v1) { v2 = v1; i2 = i1; v1 = d; i1 = n; }
            else if (d > v2) { v2 = d; i2 = n; }
        }
        unsigned mask = 0u;
        if (i0 >= 0) mask |= 1u << i0; if (i1 >= 0) mask |= 1u << i1; if (i2 >= 0) mask |= 1u << i2;
        if (half == 0) SEL[t * NH + h] = mask;
        for (int j = 0; j < qb; ++j) { const unsigned long long bal = __ballot(half == 0 && ((mask >> j) & 1u)); if (lane == 0) wc[j * 8 + wave] = __popcll(bal); }
        __syncthreads();
        for (int j = 0; j < qb; ++j) {
            const bool f = (half == 0) && ((mask >> j) & 1u);
            const unsigned long long bal = __ballot(f);
            int off = __popcll(bal & ((1ull << lane) - 1ull));
            int tot = 0;
#pragma unroll
            for (int w = 0; w < 8; ++w) { const int c = wc[j * 8 + w]; off += (w < wave) ? c : 0; tot += c; }
            const size_t seg = ((size_t)(bh * 32 + j) * 32 + qb);
            if (f) LIST[seg * 256 + off] = (unsigned char)q;
            if (tid == 0) { CNT[seg] = (unsigned)tot; atomicAdd(&TOT[bh * 32 + j], (unsigned)tot); }
        }
        __syncthreads();
    }
}

__device__ __forceinline__ void p3_moba_sel(KA A, unsigned char* ldsu) {
    PHASE_IDS();
    char* lds = (char*)ldsu;
    unsigned char* ws = A->ws; const bf16* PROJ = (const bf16*)(ws + WS_PROJ); const unsigned* SEL = (const unsigned*)(ws + WS_SEL);
    const unsigned char* LIST = ws + WS_LIST; const unsigned* CNT = (const unsigned*)(ws + WS_CNT); unsigned* TOT = (unsigned*)(ws + WS_CTL) + CW_TOT;
    bf16* PARTO = (bf16*)(ws + WS_PARTO); float* PARTML = (float*)(ws + WS_PARTML);
    int* tab = (int*)(lds + mb::L_TAB);
    int* seg = (int*)(lds + mb::L_SEG);
    int* qpos = (int*)(lds + mb::L_QPOS);
    if (wave == 0) {
        int c[8]; int s = 0;
#pragma unroll
        for (int k = 0; k < 8; ++k) { const int e = lane * 8 + k; int n = 0; if (e < 496) { const int bh = e / 31, j = e % 31; n = (int)((__hip_atomic_load(&TOT[bh * 32 + j], __ATOMIC_RELAXED, __HIP_MEMORY_SCOPE_AGENT) + 255u) >> 8); } c[k] = s; s += n; }
        int incl = s;
#pragma unroll
        for (int o = 1; o < 64; o <<= 1) { const int v = __shfl_up(incl, o); if (lane >= o) incl += v; }
        const int excl = incl - s;
#pragma unroll
        for (int k = 0; k < 8; ++k) { const int e = lane * 8 + k; if (e <= 496) tab[e] = excl + c[k]; }
    }
    __syncthreads();
    const int T = tab[496];
    const int t_lo = (int)(((long)vcu * T) / G), t_hi = (int)(((long)(vcu + 1) * T) / G);
    int cur_h = -1;
    for (int tile = t_lo; tile < t_hi; ++tile) {
        int lo = 0, hi_ = 495;
        while (lo < hi_) { const int mid = (lo + hi_ + 1) >> 1; if (tab[mid] <= tile) lo = mid; else hi_ = mid - 1; }
        const int e = lo, bh = e / 31, j = e % 31, b = bh >> 2, h = bh & 3, ti = tile - tab[e];
        if (wave == 0) {
            int n = 0; if (lane > j && lane < 32) n = (int)CNT[(size_t)(bh * 32 + j) * 32 + lane];
            int incl = n;
#pragma unroll
            for (int o = 1; o < 32; o <<= 1) { const int v = __shfl_up(incl, o); if (lane >= o) incl += v; }
            if (lane < 32) seg[lane] = incl - n; if (lane == 31) seg[32] = incl;
        }
        if (cur_h != h) { cur_h = h; const f32x4* src = (const f32x4*)((const float*)(ws + WS_LUT) + h * SEQ); f32x4* dst = (f32x4*)(lds + mb::L_LUT);
#pragma unroll
            for (int i = 0; i < 4; ++i) dst[tid + i * 512] = src[tid + i * 512]; }
        __syncthreads();
        const int total = seg[32];
        if (tid < 256) {
            const int s = ti * 256 + tid; int pos = (j + 1) * 256;
            if (s < total) { int qb = j + 1; while (qb < 31 && seg[qb + 1] <= s) ++qb; pos = qb * 256 + (int)LIST[((size_t)(bh * 32 + j) * 32 + qb) * 256 + (s - seg[qb])]; }
            qpos[tid] = pos;
        }
        __syncthreads();
        const bf16* Qseq = PROJ + (size_t)b * SEQ * INW + C_MQ + h * HD;
        const bf16* Kh = PROJ + ((size_t)b * SEQ + j * 256) * INW + C_MK + h * HD;
        const bf16* Vh = PROJ + ((size_t)b * SEQ + j * 256) * INW + C_MV + h * HD;
        mb::f32x16 o[4]; float m_reg, l_reg;
        mb::attend_block<false>(Qseq, Kh, Vh, j * 256, lds, o, m_reg, l_reg, tid);
        int lane_e = lane; asm volatile("" : "+v"(lane_e));
#define lane lane_e
        const int r32 = lane & 31, hi = lane >> 5, pos = qpos[wave * 32 + r32];
        const bool valid = (ti * 256 + wave * 32 + r32) < total;
        const size_t trow = (size_t)b * SEQ + pos;
        const unsigned msk = SEL[trow * NH + h];
        const int slot = __popc(msk & ((1u << j) - 1u));
        float* wsf = (float*)(lds + mb::L_WS) + wave * 64;
        if (hi == 0) { wsf[r32] = 1.0f / l_reg; if (valid) { float* ml = PARTML + ((trow * NH + h) * 3 + slot) * 2; ml[0] = m_reg; ml[1] = l_reg; } }
        asm volatile("s_waitcnt lgkmcnt(0)" ::: "memory");
        char* stg = lds + wave * 8192;
        mb::stage_rows_bf16(o, wsf, stg, r32, hi);
        asm volatile("s_waitcnt lgkmcnt(0)" ::: "memory");
#pragma unroll
        for (int i = 0; i < 8; ++i) { const int row = (lane >> 4) + 4 * i, ch = lane & 15;
            const int rq = qpos[wave * 32 + row];
            const v4u val = *(const v4u*)(stg + row * 256 + ch * 16);
            const int s = ti * 256 + wave * 32 + row;
            if (s < total) { const size_t tr = (size_t)b * SEQ + rq; const unsigned mk = SEL[tr * NH + h]; const int sl = __popc(mk & ((1u << j) - 1u));
                *(v4u*)(PARTO + ((tr * NH + h) * 3 + sl) * 128 + ch * 8) = val; } }
#undef lane
        __syncthreads();
    }
}

__device__ __forceinline__ void p4_moba_own(KA A, unsigned char* ldsu) {
    PHASE_IDS();
    char* lds = (char*)ldsu;
    unsigned char* ws = A->ws; bf16* PROJ = (bf16*)(ws + WS_PROJ); const unsigned* SEL = (const unsigned*)(ws + WS_SEL);
    const bf16* PARTO = (const bf16*)(ws + WS_PARTO); const float* PARTML = (const float*)(ws + WS_PARTML);
    int* qpos = (int*)(lds + mb::L_QPOS);
    int cur_h = -1;
    for (int it = vcu; it < 16 * NBLK; it += G) {
        const int bh = it >> 5, qb = it & 31, b = bh >> 2, h = bh & 3;
        if (cur_h != h) { cur_h = h; const f32x4* src = (const f32x4*)((const float*)(ws + WS_LUT) + h * SEQ); f32x4* dst = (f32x4*)(lds + mb::L_LUT);
#pragma unroll
            for (int i = 0; i < 4; ++i) dst[tid + i * 512] = src[tid + i * 512]; }
        if (tid < 256) qpos[tid] = qb * 256 + tid;
        __syncthreads();
        const bf16* Qseq = PROJ + (size_t)b * SEQ * INW + C_MQ + h * HD;
        const bf16* Kh = PROJ + ((size_t)b * SEQ + qb * 256) * INW + C_MK + h * HD;
        const bf16* Vh = PROJ + ((size_t)b * SEQ + qb * 256) * INW + C_MV + h * HD;
        mb::f32x16 o[4]; float m_reg, l_reg;
        mb::attend_block<true>(Qseq, Kh, Vh, qb * 256, lds, o, m_reg, l_reg, tid);
        int lane_e = lane; asm volatile("" : "+v"(lane_e));
#define lane lane_e
        const int r32 = lane & 31, hi = lane >> 5;
        const size_t trow0 = (size_t)b * SEQ + qb * 256 + wave * 32;
        float* coef = (float*)(lds + mb::L_COEF) + wave * 128;
        if (hi == 0) {
            const size_t tr = trow0 + r32; const unsigned msk = SEL[tr * NH + h]; const int ns = __popc(msk);
            const float* ml = PARTML + (tr * NH + h) * 6;
            float pm[3], pl[3]; float mx = m_reg;
#pragma unroll
            for (int i = 0; i < 3; ++i) { pm[i] = (i < ns) ? ml[2 * i] : -1e30f; pl[i] = (i < ns) ? ml[2 * i + 1] : 0.f; mx = fmaxf(mx, pm[i]); }
            const float wo = __expf(m_reg - mx); float den = wo * l_reg; float w[3];
#pragma unroll
            for (int i = 0; i < 3; ++i) { w[i] = (i < ns) ? pl[i] * __expf(pm[i] - mx) : 0.f; den += w[i]; }
            const float inv = 1.0f / den;
            coef[r32] = wo * inv; coef[32 + r32] = w[0] * inv; coef[64 + r32] = w[1] * inv; coef[96 + r32] = w[2] * inv;
        }
        asm volatile("s_waitcnt lgkmcnt(0)" ::: "memory");
        char* stg = lds + wave * 8192;
        mb::stage_rows_bf16(o, coef, stg, r32, hi);
        asm volatile("s_waitcnt lgkmcnt(0)" ::: "memory");
#pragma unroll
        for (int i = 0; i < 8; ++i) { const int row = (lane >> 4) + 4 * i, ch = lane & 15;
            const size_t tr = trow0 + row;
            const v4u ow = *(const v4u*)(stg + row * 256 + ch * 16);
            float acc[8] = {bflo(ow.x), bfhi(ow.x), bflo(ow.y), bfhi(ow.y), bflo(ow.z), bfhi(ow.z), bflo(ow.w), bfhi(ow.w)};
#pragma unroll
            for (int k = 0; k < 3; ++k) { const float c = coef[32 * (k + 1) + row];
                if (c != 0.f) { const v4u pw = *(const v4u*)(PARTO + ((tr * NH + h) * 3 + k) * 128 + ch * 8);
                    acc[0] += c * bflo(pw.x); acc[1] += c * bfhi(pw.x); acc[2] += c * bflo(pw.y); acc[3] += c * bfhi(pw.y); acc[4] += c * bflo(pw.z); acc[5] += c * bfhi(pw.z); acc[6] += c * bflo(pw.w); acc[7] += c * bfhi(pw.w); } }
            const v4u zw = *(const v4u*)(PROJ + tr * INW + C_MZ + h * HD + ch * 8);
            const float z[8] = {bflo(zw.x), bfhi(zw.x), bflo(zw.y), bfhi(zw.y), bflo(zw.z), bfhi(zw.z), bflo(zw.w), bfhi(zw.w)};
#pragma unroll
            for (int e2 = 0; e2 < 8; ++e2) acc[e2] *= z[e2] / (1.0f + __expf(-z[e2]));
            v4u w; w.x = pk2(acc[0], acc[1]); w.y = pk2(acc[2], acc[3]); w.z = pk2(acc[4], acc[5]); w.w = pk2(acc[6], acc[7]);
            *(v4u*)(PROJ + tr * INW + C_MQ + h * HD + ch * 8) = w; }
#undef lane
        __syncthreads();
    }
}

__global__ void __launch_bounds__(NWAVES * 64, 2) hymba_fwd(Args args_unused) {
    extern __shared__ __attribute__((aligned(16))) unsigned char lds[];
    LAS unsigned char* ldsl = (LAS unsigned char*)lds;
    volatile LAS unsigned* MISC = (volatile LAS unsigned*)(ldsl + MISC_OFF);
    { const int tid = threadIdx.x; for (int u = tid; u < (LDS_BYTES - LDSCTL_OFF) / 4; u += NWAVES * 64) ((LAS unsigned*)(ldsl + LDSCTL_OFF))[u] = 0u; }
    __syncthreads();
    (void)xcd_barrier_post((unsigned*)(get_ka()->ws + WS_CTL) + CW_BAR, MISC + 8);
#define GRID_BAR() do { XcdBarrier b_; b_.bar = (unsigned*)(get_ka()->ws + WS_CTL) + CW_BAR; b_.x = xb_xcc_id(); b_.st = (volatile LAS unsigned*)((LAS unsigned char*)lds + MISC_OFF) + 8; xcd_barrier(b_); } while (0)
#define WSP(T, off) ((T*)(ka->ws + (off)))

    p0_prologue(get_ka(), ldsl);
    GRID_BAR();

    for (int L = 0; L < DEPTH; ++L) {
        {   KA ka = get_ka(); int bx = blockIdx.x; asm volatile("" : "+s"(bx)); const int G = gridDim.x;
            pg8::Gemm g{WSP(bf16, WS_XB), WSP(const bf16, WS_WIN) + (size_t)L * INW * DM, M, INW, DM, DM}; pg8::StaticOrder S; S.init(M, INW, G, bx);
            pg8::EpiProj E{WSP(bf16, WS_PROJ), INW, WSP(float, WS_RSX)};
            pg8::gemm_phase<pg8::EpiProj, pg8::StaticOrder, true, true>(ldsl + RING_OFF, g, S, E); }
        {   KA ka = get_ka(); int bx = blockIdx.x; asm volatile("" : "+s"(bx)); const int G = gridDim.x;
            pg8::Gemm g{WSP(bf16, WS_PE), WSP(const bf16, WS_WPLE) + (size_t)L * DM * PLE, M, DM, PLE, PLE}; pg8::StaticOrder S; S.init(M, DM, G, bx);
            pg8::EpiE E{WSP(bf16, WS_EPRE), DM, WSP(float, WS_RSE)};
            pg8::gemm_phase<pg8::EpiE, pg8::StaticOrder, true, true>(ldsl + RING_OFF, g, S, E); }
        GRID_BAR();
        p1b_rowops(get_ka(), L);
        GRID_BAR();
        p2_kmean(get_ka());
        p2_kvsum(get_ka(), lds);
        GRID_BAR();
        p2b_gating_lists(get_ka(), lds);
        GRID_BAR();
        p3_scan(get_ka());
        p3_moba_sel(get_ka(), lds);
        GRID_BAR();
        p4_ret_naive(get_ka(), L, lds);
        p4_moba_own(get_ka(), lds);
        GRID_BAR();
        {   KA ka = get_ka(); int bx = blockIdx.x; asm volatile("" : "+s"(bx)); const int G = gridDim.x;
            pg8::Gemm g{WSP(bf16, WS_PROJ), WSP(const bf16, WS_WOUT) + (size_t)L * DM * DM, M, DM, DM, INW}; pg8::StaticOrder S; S.init(M, DM, G, bx);
            pg8::EpiRes E{(L == 0) ? ka->x : (const float*)ka->out, ka->out, WSP(bf16, WS_PROJ) + C_X1B, WSP(float, WS_RSX1), DM, INW};
            pg8::gemm_phase<pg8::EpiRes, pg8::StaticOrder, true, true>(ldsl + RING_OFF, g, S, E); }
        GRID_BAR();
        {   KA ka = get_ka(); int bx = blockIdx.x; asm volatile("" : "+s"(bx)); const int G = gridDim.x;
            pg8::Gemm g{WSP(bf16, WS_PROJ) + C_X1B, WSP(const bf16, WS_WG) + (size_t)L * DM * DM, M, DM, DM, INW}; pg8::StaticOrder S; S.init(M, DM, G, bx);
            pg8::EpiGate E{ka->out, WSP(const bf16, WS_EPRE), WSP(const float, WS_RSX1), WSP(const float, WS_RSE), ka->ple_norm_g + L * DM, WSP(bf16, WS_XB), WSP(float, WS_RSX), DM};
            pg8::gemm_phase<pg8::EpiGate, pg8::StaticOrder, true, true>(ldsl + RING_OFF, g, S, E); }
        if (L + 1 < DEPTH) {
            {   KA ka = get_ka(); PHASE_IDS();
                const long gtid = (long)vcu * (NWAVES * 64) + tid, gthreads = (long)G * NWAVES * 64;
                cvt_f32_bf16(ka->p + (size_t)(L + 1) * M * PLE, WSP(bf16, WS_PE), (long)M * PLE / 8, gtid, gthreads); }
            GRID_BAR();
        }
    }
}

extern "C" void kernel_launch(void* const* d_in, const int* in_sizes, int n_in, void* d_out, int out_size, void* d_ws, size_t ws_size, hipStream_t stream) {
    static int grid = 0;
    if (grid == 0) {
        if (n_in != 12 || in_sizes[0] != M * DM || out_size != M * DM || ws_size < 512 * MiB) {
            fprintf(stderr, "kernel_launch: shape mismatch: n_in %d in0 %d out %d ws %zu (need >= %zu)\n", n_in, n_in > 0 ? in_sizes[0] : -1, out_size, ws_size, (size_t)(512 * MiB)); grid = -1; return; }
        int dev = 0, cus = 0, per_cu = 0;
        if (hipGetDevice(&dev) != hipSuccess || hipDeviceGetAttribute(&cus, hipDeviceAttributeMultiprocessorCount, dev) != hipSuccess) { fprintf(stderr, "kernel_launch: device query failed\n"); grid = -1; return; }
        if (hipFuncSetAttribute((const void*)hymba_fwd, hipFuncAttributeMaxDynamicSharedMemorySize, LDS_BYTES) != hipSuccess) { fprintf(stderr, "kernel_launch: hipFuncSetAttribute failed\n"); grid = -1; return; }
        if (hipOccupancyMaxActiveBlocksPerMultiprocessor(&per_cu, (const void*)hymba_fwd, NWAVES * 64, LDS_BYTES) != hipSuccess || per_cu < 1)
            fprintf(stderr, "kernel_launch: note: occupancy query reports %d workgroups per CU\n", per_cu);
        (void)hipGetLastError();
        grid = cus;
        fprintf(stderr, "kernel_launch: grid %d, ws %zu bytes\n", grid, ws_size);
    }
    if (grid < 0) return;
    if (hipMemsetAsync((char*)d_ws + WS_CTL, 0, CTL_ZERO_BYTES, stream) != hipSuccess) { fprintf(stderr, "kernel_launch: memset failed\n"); return; }
    Args a{};
    a.x = (const float*)d_in[0]; a.p = (const float*)d_in[1]; a.norm_g = (const float*)d_in[2]; a.w_in = (const float*)d_in[3]; a.ret_norm_g = (const float*)d_in[4];
    a.q_norm_g = (const float*)d_in[5]; a.k_norm_g = (const float*)d_in[6]; a.rel_bias = (const float*)d_in[7]; a.w_out = (const float*)d_in[8]; a.w_ple = (const float*)d_in[9];
    a.ple_norm_g = (const float*)d_in[10]; a.w_ple_gate = (const float*)d_in[11]; a.out = (float*)d_out; a.ws = (unsigned char*)d_ws;
    hipLaunchKernelGGL(hymba_fwd, dim3(grid), dim3(NWAVES * 64), LDS_BYTES, stream, a);
    const hipError_t le = hipPeekAtLastError();
    if (le != hipSuccess) fprintf(stderr, "kernel_launch: launch failed: %s\n", hipGetErrorName(le));
}
```

```cpp
#include <hip/hip_runtime.h>
#include <cstdio>
#include <cstdint>

namespace pg8 {
#define PG8_LAS __attribute__((address_space(3)))
typedef unsigned short bf16_t;
typedef short bf16x8 __attribute__((ext_vector_type(8)));
typedef float f32x4 __attribute__((ext_vector_type(4)));
typedef unsigned u32x4 __attribute__((ext_vector_type(4)));
typedef unsigned u32x2 __attribute__((ext_vector_type(2)));
constexpr int BM = 256, BK = 64, HALF = 128, HTB = HALF * BK * 2  , STAGE_BYTES = 8 * HTB, NXCD = 8, WGM = 8;

__host__ __device__ __forceinline__ int lds_byte(int r, int c) { const int st = (r >> 4) * 2 + (c >> 5), rr = r & 15, cc = c & 31, ob = rr * 64 + cc * 2; return st * 1024 + (ob ^ (((ob >> 9) & 1) << 5)); }
__host__ __device__ __forceinline__ void stage_rc(int b, int& R, int& C) { const int st = b / 1024, sb = b % 1024, swz = sb ^ (((sb >> 9) & 1) << 5); R = (st >> 1) * 16 + swz / 64; C = (st & 1) * 32 + (swz % 64) / 2; }
__host__ __device__ __forceinline__ int perm32(int rho) { const int n = rho >> 4, i = rho & 15; return 8 * (i >> 2) + 4 * n + (i & 3); }

struct Unit { int pm, pn; };
struct Gemm { const bf16_t* A; const bf16_t* Bt; int M, N, K, lda; };

struct StaticOrder {
    int nM, nN, nwg, G, c;
    __host__ __device__ void init(int M, int N, int G_, int c_) { nM = M / BM; nN = N / BM; nwg = nM * nN; G = G_; c = c_; }
    __host__ __device__ bool next(int i, Unit& u) const {
        const long L = (long)i * G + c; if (L >= nwg) return false;
        int wgid = (int)L; { const int q = nwg / NXCD, r = nwg % NXCD, xcd = wgid % NXCD, off = wgid / NXCD; wgid = (xcd < r ? xcd * (q + 1) : r * (q + 1) + (xcd - r) * q) + off; }
        const int nig = WGM * nN, gid = wgid / nig, fm = gid * WGM, gsz = (nM - fm) < WGM ? (nM - fm) : WGM;
        u.pm = fm + ((wgid % nig) % gsz); u.pn = (wgid % nig) / gsz; return true;
    }
    __device__ __forceinline__ void a_ready(const Unit&) const {}
    __device__ __forceinline__ void done(const Unit&) const {}
};

typedef float f32x2 __attribute__((ext_vector_type(2)));
typedef __bf16 bf16x2_t __attribute__((ext_vector_type(2)));
__device__ __forceinline__ unsigned pk2(float lo, float hi) { f32x2 v = {lo, hi}; bf16x2_t b = __builtin_convertvector(v, bf16x2_t); return __builtin_bit_cast(unsigned, b); }
__device__ __forceinline__ float bflo(unsigned w) { return __uint_as_float(w << 16); }
__device__ __forceinline__ float bfhi(unsigned w) { return __uint_as_float(w & 0xffff0000u); }
__device__ __forceinline__ float sum16(const float* p) {
    const f32x4 a = *(const f32x4*)p, b = *(const f32x4*)(p + 4), c = *(const f32x4*)(p + 8), d = *(const f32x4*)(p + 12);
    return (((a[0] + a[1]) + (a[2] + a[3])) + ((b[0] + b[1]) + (b[2] + b[3]))) + (((c[0] + c[1]) + (c[2] + c[3])) + ((d[0] + d[1]) + (d[2] + d[3])));
}
constexpr float EPS = 1e-6f;

struct EpiProj {
    static constexpr bool PERM = true, AFTER_DRAIN = false;
    bf16_t* O; int ldc; const float* rss;
    __device__ __forceinline__ void operator()(const f32x4 (&acc)[2][2][4][2], const Unit& u, int wr, int wc, int fr, int fq) const {
        const int row0 = u.pm * BM + wr * 64 + fr, col0 = u.pn * BM + wc * 32 + 8 * fq;
#pragma unroll
        for (int ai = 0; ai < 2; ++ai)
#pragma unroll
            for (int m = 0; m < 4; ++m) { const int row = row0 + ai * HALF + m * 16;
                const float rstd = 1.0f / sqrtf(sum16(rss + (size_t)row * 16) * (1.0f / 1024.0f) + EPS);
                bf16_t* rowp = O + (size_t)row * ldc + col0;
#pragma unroll
                for (int bj = 0; bj < 2; ++bj) { const f32x4 v0 = acc[ai][bj][m][0] * rstd, v1 = acc[ai][bj][m][1] * rstd;
                    u32x4 w; w.x = pk2(v0[0], v0[1]); w.y = pk2(v0[2], v0[3]); w.z = pk2(v1[0], v1[1]); w.w = pk2(v1[2], v1[3]);
                    *(u32x4*)(rowp + bj * HALF) = w; } }
    }
};
struct EpiE {
    static constexpr bool PERM = true, AFTER_DRAIN = false;
    bf16_t* O; int ldc; float* rs;
    __device__ __forceinline__ void operator()(const f32x4 (&acc)[2][2][4][2], const Unit& u, int wr, int wc, int fr, int fq) const {
        const int row0 = u.pm * BM + wr * 64 + fr, col0 = u.pn * BM + wc * 32 + 8 * fq;
#pragma unroll
        for (int ai = 0; ai < 2; ++ai)
#pragma unroll
            for (int m = 0; m < 4; ++m) { const int row = row0 + ai * HALF + m * 16; float s = 0.f;
                bf16_t* rowp = O + (size_t)row * ldc + col0;
#pragma unroll
                for (int bj = 0; bj < 2; ++bj) { const f32x4 v0 = acc[ai][bj][m][0], v1 = acc[ai][bj][m][1];
                    s += (v0[0] * v0[0] + v0[1] * v0[1]) + (v0[2] * v0[2] + v0[3] * v0[3]); s += (v1[0] * v1[0] + v1[1] * v1[1]) + (v1[2] * v1[2] + v1[3] * v1[3]);
                    u32x4 w; w.x = pk2(v0[0], v0[1]); w.y = pk2(v0[2], v0[3]); w.z = pk2(v1[0], v1[1]); w.w = pk2(v1[2], v1[3]);
                    *(u32x4*)(rowp + bj * HALF) = w; }
                s += __shfl_xor(s, 16); s += __shfl_xor(s, 32);
                if (fq == 0) rs[(size_t)row * 16 + u.pn * 4 + wc] = s; }
    }
};
struct EpiRes {
    static constexpr bool PERM = false, AFTER_DRAIN = false;
    const float* base; float* out; bf16_t* xb; float* rs; int ldc; int ldxb;
    __device__ __forceinline__ void operator()(const f32x4 (&acc)[2][2][4][2], const Unit& u, int wr, int wc, int fr, int fq) const {
        const int row0 = u.pm * BM + wr * 64 + fr, col0 = u.pn * BM + wc * 32 + 4 * fq;
#pragma unroll
        for (int ai = 0; ai < 2; ++ai)
#pragma unroll
            for (int m = 0; m < 4; ++m) { const int row = row0 + ai * HALF + m * 16; float s = 0.f; const size_t off = (size_t)row * ldc + col0, offb = (size_t)row * ldxb + col0;
#pragma unroll
                for (int bj = 0; bj < 2; ++bj)
#pragma unroll
                    for (int n = 0; n < 2; ++n) { const size_t o = off + bj * HALF + n * 16;
                        const f32x4 x = *(const f32x4*)(base + o) + acc[ai][bj][m][n];
                        *(f32x4*)(out + o) = x; s += (x[0] * x[0] + x[1] * x[1]) + (x[2] * x[2] + x[3] * x[3]);
                        u32x2 w; w.x = pk2(x[0], x[1]); w.y = pk2(x[2], x[3]); *(u32x2*)(xb + offb + bj * HALF + n * 16) = w; }
                s += __shfl_xor(s, 16); s += __shfl_xor(s, 32);
                if (fq == 0) rs[(size_t)row * 16 + u.pn * 4 + wc] = s; }
    }
};
struct EpiGate {
    static constexpr bool PERM = false, AFTER_DRAIN = false;
    float* xio; const bf16_t* epre; const float* rs1; const float* rse; const float* pg; bf16_t* xb; float* rso; int ldc;
    __device__ __forceinline__ void operator()(const f32x4 (&acc)[2][2][4][2], const Unit& u, int wr, int wc, int fr, int fq) const {
        const int row0 = u.pm * BM + wr * 64 + fr, col0 = u.pn * BM + wc * 32 + 4 * fq;
#pragma unroll
        for (int ai = 0; ai < 2; ++ai)
#pragma unroll
            for (int m = 0; m < 4; ++m) { const int row = row0 + ai * HALF + m * 16; float s = 0.f; const size_t off = (size_t)row * ldc + col0;
                const float r1 = 1.0f / sqrtf(sum16(rs1 + (size_t)row * 16) * (1.0f / 1024.0f) + EPS);
                const float re = 1.0f / sqrtf(sum16(rse + (size_t)row * 16) * (1.0f / 1024.0f) + EPS);
#pragma unroll
                for (int bj = 0; bj < 2; ++bj)
#pragma unroll
                    for (int n = 0; n < 2; ++n) { const size_t o = off + bj * HALF + n * 16; const int c = col0 + bj * HALF + n * 16;
                        const f32x4 a = acc[ai][bj][m][n] * r1; const u32x2 ew = *(const u32x2*)(epre + o); const f32x4 g = *(const f32x4*)(pg + c);
                        f32x4 e; e[0] = bflo(ew.x); e[1] = bfhi(ew.x); e[2] = bflo(ew.y); e[3] = bfhi(ew.y); e = e * re * g;
                        f32x4 sg; sg[0] = 1.0f / (1.0f + __expf(-a[0])); sg[1] = 1.0f / (1.0f + __expf(-a[1])); sg[2] = 1.0f / (1.0f + __expf(-a[2])); sg[3] = 1.0f / (1.0f + __expf(-a[3]));
                        const f32x4 x = *(const f32x4*)(xio + o) + sg * e;
                        *(f32x4*)(xio + o) = x; s += (x[0] * x[0] + x[1] * x[1]) + (x[2] * x[2] + x[3] * x[3]);
                        u32x2 w; w.x = pk2(x[0], x[1]); w.y = pk2(x[2], x[3]); *(u32x2*)(xb + o) = w; }
                s += __shfl_xor(s, 16); s += __shfl_xor(s, 32);
                if (fq == 0) rso[(size_t)row * 16 + u.pn * 4 + wc] = s; }
    }
};

template <class Epi, class Sched, bool ALIGN_EPI = false, bool SP2 = false>
__device__ __forceinline__ void gemm_phase(PG8_LAS unsigned char* lds, const Gemm g, const Sched& S, const Epi& E) {
    int tid = threadIdx.x; asm volatile("" : "+v"(tid));
    const int wid = __builtin_amdgcn_readfirstlane(tid >> 6), lane = tid & 63, wr = wid >> 2, wc = wid & 3, fr = lane & 15, fq = lane >> 4;
    const int K = g.K, lda = g.lda, nt = K / BK;
    unsigned voffA[2], voffB[2];
#pragma unroll
    for (int i = 0; i < 2; ++i) { int R, C; stage_rc(tid * 16 + i * 8192, R, C); const int Rb = Epi::PERM ? ((R & ~31) + perm32(R & 31)) : R;
        voffA[i] = (unsigned)(R * lda + C) * 2u; voffB[i] = (unsigned)(Rb * K + C) * 2u; }
    const size_t kstep = (size_t)(BK * 2);
    const size_t hstepB = (size_t)HALF * K * 2, hstepA = (size_t)HALF * lda * 2;
    const size_t tstepB = 2 * hstepB, tstepA = 2 * hstepA;
    const unsigned ldsw = (unsigned)wid * 1024u;
    const int aoff = lds_byte(wr * 64 + fr, fq * 8), boff = lds_byte(wc * 32 + fr, fq * 8);
#define PG8_SA(b, h) (((b) * 2 + (h)) * HTB)
#define PG8_SB(b, h) ((4 + (b) * 2 + (h)) * HTB)
#define PG8_STAGE(bufoff, gbase, voff) do { _Pragma("unroll") for (int _i = 0; _i < 2; ++_i) \
        __builtin_amdgcn_global_load_lds((const unsigned*)((const char*)(gbase) + (voff)[_i]), (PG8_LAS unsigned*)(lds + (bufoff) + ldsw + _i * 8192), 16, 0, 0); } while (0)
#define PG8_LDA(dst, b, h) do { _Pragma("unroll") for (int m = 0; m < 4; ++m) _Pragma("unroll") for (int k = 0; k < 2; ++k) dst[m][k] = *(const PG8_LAS bf16x8*)(lds + PG8_SA(b, h) + aoff + m * 2048 + k * 1024); } while (0)
#define PG8_LDB(dst, b, h) do { _Pragma("unroll") for (int n = 0; n < 2; ++n) _Pragma("unroll") for (int k = 0; k < 2; ++k) dst[n][k] = *(const PG8_LAS bf16x8*)(lds + PG8_SB(b, h) + boff + n * 2048 + k * 1024); } while (0)
#define PG8_MMA(ai, bj, At, Bt) do { __builtin_amdgcn_s_setprio(1); _Pragma("unroll") for (int m = 0; m < 4; ++m) _Pragma("unroll") for (int n = 0; n < 2; ++n) _Pragma("unroll") for (int k = 0; k < 2; ++k) \
        acc[ai][bj][m][n] = __builtin_amdgcn_mfma_f32_16x16x32_bf16(Bt[n][k], At[m][k], acc[ai][bj][m][n], 0, 0, 0); __builtin_amdgcn_s_setprio(0); } while (0)
#define PG8_WAIT_V(n) asm volatile("s_waitcnt vmcnt(" #n ")" ::: "memory")
#define PG8_WAIT_L(n) asm volatile("s_waitcnt lgkmcnt(" #n ")" ::: "memory")
#define PG8_BAR __builtin_amdgcn_s_barrier()
#define PG8_SCHED __builtin_amdgcn_sched_barrier(0)
    Unit cur, nxt; int ui = 0;
    if (!S.next(0, cur)) return;
    f32x4 acc[2][2][4][2];
#pragma unroll
    for (int a = 0; a < 2; ++a)
#pragma unroll
        for (int b = 0; b < 2; ++b)
#pragma unroll
            for (int m = 0; m < 4; ++m)
#pragma unroll
                for (int n = 0; n < 2; ++n) acc[a][b][m][n] = (f32x4){0.f, 0.f, 0.f, 0.f};
    bf16x8 At[4][2], B0[2][2], B1[2][2];
    const char* cA = (const char*)g.A + (size_t)cur.pm * tstepA; const char* cB = (const char*)g.Bt + (size_t)cur.pn * tstepB;
    S.a_ready(cur);
    if constexpr (SP2) {
        PG8_STAGE(PG8_SB(0, 0), cB, voffB); PG8_STAGE(PG8_SB(0, 1), cB + hstepB, voffB); PG8_STAGE(PG8_SA(0, 0), cA, voffA); PG8_STAGE(PG8_SA(0, 1), cA + hstepA, voffA);
        if (wr == 1) PG8_BAR;
        PG8_WAIT_V(2); PG8_BAR;
        PG8_STAGE(PG8_SB(1, 0), cB + kstep, voffB); PG8_STAGE(PG8_SA(1, 0), cA + kstep, voffA); PG8_STAGE(PG8_SB(1, 1), cB + hstepB + kstep, voffB);
        PG8_WAIT_V(6); PG8_BAR;
    } else {
        PG8_STAGE(PG8_SB(0, 0), cB, voffB); PG8_STAGE(PG8_SA(0, 0), cA, voffA); PG8_STAGE(PG8_SB(0, 1), cB + hstepB, voffB); PG8_STAGE(PG8_SA(0, 1), cA + hstepA, voffA);
        if (wr == 1) PG8_BAR;
        PG8_WAIT_V(4); PG8_BAR;
        PG8_STAGE(PG8_SB(1, 0), cB + kstep, voffB); PG8_STAGE(PG8_SA(1, 0), cA + kstep, voffA); PG8_STAGE(PG8_SB(1, 1), cB + hstepB + kstep, voffB);
        PG8_WAIT_V(6); PG8_BAR;
    }
    for (;;) {
        const bool has_next = S.next(ui + 1, nxt);
        const char* nA = has_next ? (const char*)g.A + (size_t)nxt.pm * tstepA : cA; const char* nB = has_next ? (const char*)g.Bt + (size_t)nxt.pn * tstepB : cB;
#pragma nounroll
        for (int t = 0; t < nt; t += 2) {
            const bool last = (t == nt - 2);
            const char* a1 = cA + (size_t)(t + 1) * kstep;
            const char* a2 = last ? nA : cA + (size_t)(t + 2) * kstep; const char* b2 = last ? nB : cB + (size_t)(t + 2) * kstep;
            const char* a3 = a2 + kstep; const char* b3 = b2 + kstep;
            if (last && has_next) S.a_ready(nxt);
            if constexpr (SP2) {
            PG8_LDB(B0, 0, 0); PG8_LDB(B1, 0, 1); PG8_SCHED; PG8_LDA(At, 0, 0); PG8_STAGE(PG8_SA(1, 1), a1 + hstepA, voffA);
            PG8_WAIT_V(8); PG8_WAIT_L(0); PG8_BAR; PG8_MMA(0, 0, At, B0); PG8_MMA(0, 1, At, B1); PG8_BAR; PG8_SCHED;
            PG8_LDA(At, 0, 1); PG8_STAGE(PG8_SB(0, 0), b2, voffB); PG8_STAGE(PG8_SB(0, 1), b2 + hstepB, voffB); PG8_STAGE(PG8_SA(0, 0), a2, voffA);
            PG8_WAIT_V(8); PG8_WAIT_L(0); PG8_BAR; PG8_MMA(1, 0, At, B0); PG8_MMA(1, 1, At, B1); PG8_BAR; PG8_SCHED;
            PG8_LDB(B0, 1, 0); PG8_LDB(B1, 1, 1); PG8_SCHED; PG8_LDA(At, 1, 0); PG8_STAGE(PG8_SA(0, 1), a2 + hstepA, voffA);
            PG8_WAIT_V(8); PG8_WAIT_L(0); PG8_BAR; PG8_MMA(0, 0, At, B0); PG8_MMA(0, 1, At, B1); PG8_BAR; PG8_SCHED;
            PG8_LDA(At, 1, 1); PG8_STAGE(PG8_SB(1, 0), b3, voffB); PG8_STAGE(PG8_SB(1, 1), b3 + hstepB, voffB); PG8_STAGE(PG8_SA(1, 0), a3, voffA);
            PG8_WAIT_V(8); PG8_WAIT_L(0); PG8_BAR; PG8_MMA(1, 0, At, B0); PG8_MMA(1, 1, At, B1); PG8_BAR; PG8_SCHED;
            } else {
            PG8_LDB(B0, 0, 0); PG8_SCHED; PG8_LDA(At, 0, 0); PG8_STAGE(PG8_SA(1, 1), a1 + hstepA, voffA);
            PG8_WAIT_L(8); PG8_BAR; PG8_WAIT_L(0); PG8_MMA(0, 0, At, B0); PG8_BAR; PG8_SCHED;
            PG8_LDB(B1, 0, 1); PG8_STAGE(PG8_SB(0, 0), b2, voffB);
            PG8_BAR; PG8_WAIT_L(0); PG8_MMA(0, 1, At, B1); PG8_BAR;
            PG8_LDA(At, 0, 1); PG8_STAGE(PG8_SA(0, 0), a2, voffA);
            PG8_BAR; PG8_WAIT_L(0); PG8_MMA(1, 0, At, B0); PG8_BAR; PG8_SCHED;
            PG8_STAGE(PG8_SB(0, 1), b2 + hstepB, voffB);
            PG8_WAIT_V(6); PG8_BAR; PG8_MMA(1, 1, At, B1); PG8_BAR;
            PG8_LDB(B0, 1, 0); PG8_SCHED; PG8_LDA(At, 1, 0); PG8_STAGE(PG8_SA(0, 1), a2 + hstepA, voffA);
            PG8_WAIT_L(8); PG8_BAR; PG8_WAIT_L(0); PG8_MMA(0, 0, At, B0); PG8_BAR; PG8_SCHED;
            PG8_LDB(B1, 1, 1); PG8_STAGE(PG8_SB(1, 0), b3, voffB);
            PG8_BAR; PG8_WAIT_L(0); PG8_MMA(0, 1, At, B1); PG8_BAR;
            PG8_LDA(At, 1, 1); PG8_STAGE(PG8_SA(1, 0), a3, voffA);
            PG8_BAR; PG8_WAIT_L(0); PG8_MMA(1, 0, At, B0); PG8_BAR; PG8_SCHED;
            PG8_STAGE(PG8_SB(1, 1), b3 + hstepB, voffB);
            PG8_WAIT_V(6); PG8_BAR; PG8_MMA(1, 1, At, B1); PG8_BAR;
            }
        }
        if constexpr (ALIGN_EPI) { if (wr == 0) PG8_BAR; }
        if constexpr (!Epi::AFTER_DRAIN) { E(acc, cur, wr, wc, fr, fq); S.done(cur); }
        if (!has_next) break;
#pragma unroll
        for (int a = 0; a < 2; ++a)
#pragma unroll
            for (int b = 0; b < 2; ++b)
#pragma unroll
                for (int m = 0; m < 4; ++m)
#pragma unroll
                    for (int n = 0; n < 2; ++n) acc[a][b][m][n] = (f32x4){0.f, 0.f, 0.f, 0.f};
        cur = nxt; cA = nA; cB = nB; ++ui;
        if constexpr (ALIGN_EPI) { if (wr == 1) PG8_BAR; }
    }
    PG8_WAIT_V(0);
    if constexpr (!ALIGN_EPI) { if (wr == 0) PG8_BAR; }
    PG8_BAR;
    if constexpr (Epi::AFTER_DRAIN) { E.fused(acc, cur, wr, wc, fr, fq, lds, wid, lane); S.done(cur); }
#undef PG8_SA
#undef PG8_SB
#undef PG8_STAGE
#undef PG8_LDA
#undef PG8_LDB
#undef PG8_MMA
#undef PG8_WAIT_V
#undef PG8_WAIT_L
#undef PG8_BAR
#undef PG8_SCHED
}
}

constexpr int NWAVES = 8;
constexpr int DM = 1024, SEQ = 8192, NBATCH = 4, M = NBATCH * SEQ, INW = 4096, PLE = 256, DEPTH = 2, HD = 128, NH = 4, NBLK = 32  , NCH = 64  ;
constexpr int C_RQ = 0, C_MQ = 512, C_RK = 1024, C_RV = 1536, C_RZ = 2048, C_MK = 2560, C_MV = 3072, C_MZ = 3584;
constexpr int C_X1B = 1024;
constexpr float RSQRT_HD = 0.08838834764831845f;

constexpr size_t MiB = 1u << 20;
constexpr size_t WS_CTL = 0, CTL_ZERO_BYTES = 1 * MiB;
constexpr size_t WS_WIN = 1 * MiB;
constexpr size_t WS_WOUT = 17 * MiB;
constexpr size_t WS_WG = 21 * MiB;
constexpr size_t WS_WPLE = 25 * MiB;
constexpr size_t WS_TAB = 26 * MiB;
constexpr size_t WS_LUT = 30 * MiB;
constexpr size_t WS_KMEAN = 30 * MiB + 128 * 1024;
constexpr size_t WS_SEL = 30 * MiB + 512 * 1024;
constexpr size_t WS_RSX = 31 * MiB;
constexpr size_t WS_RSX1 = 33 * MiB;
constexpr size_t WS_RSE = 35 * MiB;
constexpr size_t WS_PE = 37 * MiB;
constexpr size_t WS_KV = 53 * MiB;
constexpr size_t WS_EPRE = 85 * MiB;
constexpr size_t WS_XB = 149 * MiB;
constexpr size_t WS_PROJ = 245 * MiB;
constexpr size_t WS_END = 501 * MiB;
constexpr int CW_BAR = 4096;

constexpr int RING_OFF = 0, RING_BYTES = 131072;
constexpr int LDSCTL_OFF = 143360, MISC_OFF = LDSCTL_OFF + 320;
constexpr int LDS_BYTES = 147456;

#define GAS __attribute__((address_space(1)))
#define LAS __attribute__((address_space(3)))
typedef unsigned short bf16;
typedef unsigned v4u __attribute__((ext_vector_type(4)));
typedef unsigned v2u __attribute__((ext_vector_type(2)));
typedef float f32x4 __attribute__((ext_vector_type(4)));
typedef float f32x2v __attribute__((ext_vector_type(2)));
typedef GAS unsigned gu32;
#define RLX_AGENT __ATOMIC_RELAXED, __HIP_MEMORY_SCOPE_AGENT
#define LDS_WAIT() asm volatile("s_waitcnt lgkmcnt(0)" ::: "memory")
#define VM_WAIT() asm volatile("s_waitcnt vmcnt(0)" ::: "memory")
using pg8::pk2; using pg8::bflo; using pg8::bfhi;
__device__ __forceinline__ float bf2f(unsigned short u) { return __uint_as_float(((unsigned)u) << 16); }
#define XB_TMO      128
#define XB_XCNT(j)  (256  + 64 * (j))
#define XB_XSUB(j)  (1280 + 64 * (j))
#define XB_XGEN(j)  (2304 + 64 * (j))
#define XB_TOP      3328
#define XB_TOPGEN   3392
#define XCD_BAR_WORDS 3456
#define XB_SPIN_CAP (1u << 18)

__device__ __forceinline__ unsigned xb_ld(unsigned* p)              { return __hip_atomic_load(p, __ATOMIC_RELAXED, __HIP_MEMORY_SCOPE_AGENT); }
__device__ __forceinline__ unsigned xb_add(unsigned* p, unsigned v) { return __hip_atomic_fetch_add(p, v, __ATOMIC_RELAXED, __HIP_MEMORY_SCOPE_AGENT); }
__device__ __forceinline__ unsigned xb_xcc_id() { return (unsigned)__builtin_amdgcn_s_getreg((3 << 11) | 20) & 0xFu; }
#define XB_SPIN(cond, bar) do { unsigned _sp = 0; while (cond) { __builtin_amdgcn_s_sleep(1); \
    if ((++_sp & 255u) == 0u) { if (xb_ld(&(bar)[XB_TMO])) break; if (_sp > XB_SPIN_CAP) { atomicAdd(&(bar)[XB_TMO], 1u); break; } } } } while (0)

struct XcdBarrier {
    unsigned* bar; unsigned x;
    volatile LAS unsigned* st;
};

__device__ __forceinline__ XcdBarrier xcd_barrier_post(unsigned* bar, volatile LAS unsigned* st) {
    XcdBarrier b; b.bar = bar; b.x = xb_xcc_id(); b.st = st;
    if (threadIdx.x == 0) (void)xb_add(&bar[XB_XCNT(b.x)], 1u);
    return b;
}
__device__ __forceinline__ void xcd_barrier_complete(unsigned* bar, unsigned x, unsigned& nloc, unsigned& nx) {
    const unsigned G = gridDim.x * gridDim.y * gridDim.z;
    unsigned sum, cnt, mine, sp = 0u;
    for (;;) {
        sum = 0u; cnt = 0u; mine = 0u;
#pragma nounroll
        for (unsigned j = 0; j < 16; ++j) { const unsigned c = xb_ld(&bar[XB_XCNT(j)]); sum += c; cnt += (c > 0u) ? 1u : 0u; mine = (j == x) ? c : mine; }
        if (sum == G) break;
        __builtin_amdgcn_s_sleep(1);
        if ((++sp & 255u) == 0u) { if (xb_ld(&bar[XB_TMO])) break; if (sp > XB_SPIN_CAP) { atomicAdd(&bar[XB_TMO], 1u); break; } }
    }
    nloc = mine > 0u ? mine : 1u; nx = cnt > 0u ? cnt : 1u;
}

__device__ __forceinline__ void xcd_barrier(const XcdBarrier& b) {
    asm volatile("s_waitcnt vmcnt(0)" ::: "memory");
    __syncthreads();
    if (threadIdx.x == 0) {
        unsigned* bar = b.bar;
        __builtin_amdgcn_s_waitcnt(0);
        unsigned nloc = b.st[0], nx = b.st[1];
        if (nloc == 0u) { xcd_barrier_complete(bar, b.x, nloc, nx); b.st[0] = nloc; b.st[1] = nx; }
        const unsigned old = xb_add(&bar[XB_XSUB(b.x)], 1u);
        const unsigned gen = old / nloc;
        if (old + 1u == (gen + 1u) * nloc) {
            __builtin_amdgcn_fence(__ATOMIC_RELEASE, "agent");
            asm volatile("s_waitcnt vmcnt(0)" ::: "memory");
            const unsigned og = xb_add(&bar[XB_TOP], 1u);
            const unsigned tg = og / nx;
            if (og + 1u == (tg + 1u) * nx) xb_add(&bar[XB_TOPGEN], 1u);
            else XB_SPIN(xb_ld(&bar[XB_TOPGEN]) == tg, bar);
            __builtin_amdgcn_fence(__ATOMIC_ACQUIRE, "agent");
            xb_add(&bar[XB_XGEN(b.x)], 1u);
            asm volatile("s_waitcnt vmcnt(0)" ::: "memory");
        } else {
            XB_SPIN(xb_ld(&bar[XB_XGEN(b.x)]) == gen, bar);
            __builtin_amdgcn_fence(__ATOMIC_ACQUIRE, "agent");
            asm volatile("s_waitcnt vmcnt(0)" ::: "memory");
        }
    }
    __syncthreads();
}

__device__ __forceinline__ float wave_sum(float v) {
#pragma unroll
    for (int o = 1; o < 64; o <<= 1) v += __shfl_xor(v, o);
    return v;
}
__device__ __forceinline__ float wave_max(float v) {
#pragma unroll
    for (int o = 1; o < 64; o <<= 1) v = fmaxf(v, __shfl_xor(v, o));
    return v;
}
__device__ __forceinline__ float ret_log2g(int h) { return log2f(1.0f - exp2f(-5.0f - (float)h)); }

__device__ __forceinline__ int win_dst(int c) {
    const int g = c >> 9, w = c & 511, hd = w >> 7, i = w & 127;
    const int base = (g == 0) ? C_RQ : (g == 1) ? C_RK : (g == 2) ? C_RV : (g == 3) ? C_RZ : (g == 4) ? C_MQ : (g == 5) ? C_MK : (g == 6) ? C_MV : C_MZ;
    const int pos = (g <= 1) ? ((i < 64) ? 2 * i : 2 * (i - 64) + 1) : i;
    return base + hd * 128 + pos;
}
template <int MODE>
__device__ __forceinline__ void p0_transpose_item(const float* W, int K, int N, bf16* WT, const float* gk, LAS float* scr, int item, int lane) {
    const int nblk = N / 32, kb = item / nblk, nb = item % nblk, k0 = 64 * kb, n0 = 32 * nb;
#pragma unroll 8
    for (int i = 0; i < 32; ++i) { const int kk = 2 * i + (lane >> 5); float v = W[(size_t)(k0 + kk) * N + n0 + (lane & 31)]; if (MODE == 1) v *= gk[k0 + kk]; scr[kk * 33 + (lane & 31)] = v; }
    LDS_WAIT(); asm volatile("" ::: "memory");
    const int c = lane & 7;
#pragma unroll
    for (int j = 0; j < 4; ++j) { const int n = (lane >> 3) + 8 * j; const LAS float* s = scr + (8 * c) * 33 + n;
        v4u o; o.x = pk2(s[0 * 33], s[1 * 33]); o.y = pk2(s[2 * 33], s[3 * 33]); o.z = pk2(s[4 * 33], s[5 * 33]); o.w = pk2(s[6 * 33], s[7 * 33]);
        const int dst = (MODE == 1) ? win_dst(n0 + n) : (n0 + n);
        *(v4u*)(WT + (size_t)dst * K + k0 + 8 * c) = o; }
    LDS_WAIT(); asm volatile("" ::: "memory");
}
__device__ __forceinline__ void x_row_to_bf16(const float* xrow, bf16* orow, float* rs16, int lane) {
    const f32x4* xr = (const f32x4*)xrow + lane;
    f32x4 v[4]; float s = 0.f;
#pragma unroll
    for (int j = 0; j < 4; ++j) { v[j] = xr[64 * j]; s += (v[j][0] * v[j][0] + v[j][1] * v[j][1]) + (v[j][2] * v[j][2] + v[j][3] * v[j][3]); }
    s = wave_sum(s);
    v2u* o8 = (v2u*)orow + lane;
#pragma unroll
    for (int j = 0; j < 4; ++j) { v2u w; w.x = pk2(v[j][0], v[j][1]); w.y = pk2(v[j][2], v[j][3]); o8[64 * j] = w; }
    if (lane < 16) rs16[lane] = (lane == 0) ? s : 0.f;
}
__device__ __forceinline__ void cvt_f32_bf16(const float* src, bf16* dst, long n8, long gtid, long gthreads) {
    for (long i = gtid; i < n8; i += gthreads) {
        const f32x4 a = *(const f32x4*)(src + i * 8), b = *(const f32x4*)(src + i * 8 + 4);
        v4u w; w.x = pk2(a[0], a[1]); w.y = pk2(a[2], a[3]); w.z = pk2(b[0], b[1]); w.w = pk2(b[2], b[3]);
        *(v4u*)(dst + i * 8) = w; }
}
__device__ __forceinline__ void sincos_d(double a, double& s, double& c) {
    const double k = rint(a * 0.63661977236758134308);
    double r = fma(-k, 1.57079632679489655800e+00, a); r = fma(-k, 6.12323399573676603587e-17, r);
    const double r2 = r * r;
    double sp = 1.0 / 6227020800.0; sp = fma(sp, r2, -1.0 / 39916800.0); sp = fma(sp, r2, 1.0 / 362880.0); sp = fma(sp, r2, -1.0 / 5040.0); sp = fma(sp, r2, 1.0 / 120.0); sp = fma(sp, r2, -1.0 / 6.0); sp = fma(sp * r2, r, r);
    double cp = 1.0 / 87178291200.0; cp = fma(cp, r2, -1.0 / 479001600.0); cp = fma(cp, r2, 1.0 / 3628800.0); cp = fma(cp, r2, -1.0 / 40320.0); cp = fma(cp, r2, 1.0 / 720.0); cp = fma(cp, r2, -1.0 / 24.0); cp = fma(cp, r2, 0.5); cp = fma(-cp, r2, 1.0);
    const int q = ((int)k) & 3;
    s = (q == 0) ? sp : (q == 1) ? cp : (q == 2) ? -sp : -cp;
    c = (q == 0) ? cp : (q == 1) ? -sp : (q == 2) ? -cp : sp;
}
__device__ __forceinline__ int t5_bucket(int n) {
    if (n < 16) return n;
    const float v = logf((float)n * (1.0f / 16.0f)) / 4.852030263919617f * 16.0f;
    int b = 16 + (int)v; return b > 31 ? 31 : b;
}

struct Args {
    const float* x; const float* p; const float* norm_g; const float* w_in; const float* ret_norm_g; const float* q_norm_g; const float* k_norm_g; const float* rel_bias;
    const float* w_out; const float* w_ple; const float* ple_norm_g; const float* w_ple_gate; float* out; unsigned char* ws;
};
typedef const __attribute__((address_space(4))) Args* KA;
__device__ __forceinline__ KA get_ka() { KA p = (KA)__builtin_amdgcn_kernarg_segment_ptr(); asm volatile("" : "+s"(p)); return p; }
#define PHASE_IDS() int tid = threadIdx.x; asm volatile("" : "+v"(tid)); const int lane = tid & 63; const int wave = __builtin_amdgcn_readfirstlane(tid >> 6); \
    int bx_ = blockIdx.x; asm volatile("" : "+s"(bx_)); const int G = gridDim.x; const int vcu = (G % 8 == 0) ? (bx_ % 8) * (G / 8) + bx_ / 8 : bx_; (void)lane; (void)wave; (void)vcu

__device__ __forceinline__ void p0_prologue(KA A, LAS unsigned char* lds) {
    PHASE_IDS();
    unsigned char* ws = A->ws;
    LAS float* scr = (LAS float*)(lds + RING_OFF + wave * 16384);
    const int gw = vcu * NWAVES + wave, NGW = G * NWAVES;
    constexpr int I_IN = (DM / 64) * (INW / 32), I_O = (DM / 64) * (DM / 32), I_G = I_O, I_P = (PLE / 64) * (DM / 32), I_L = I_IN + I_O + I_G + I_P;
    for (int it = gw; it < DEPTH * I_L; it += NGW) {
        const int L = it / I_L; int r = it % I_L;
        if (r < I_IN) { p0_transpose_item<1>(A->w_in + (size_t)L * DM * INW, DM, INW, (bf16*)(ws + WS_WIN) + (size_t)L * INW * DM, A->norm_g + L * DM, scr, r, lane); continue; } r -= I_IN;
        if (r < I_O) { p0_transpose_item<0>(A->w_out + (size_t)L * DM * DM, DM, DM, (bf16*)(ws + WS_WOUT) + (size_t)L * DM * DM, nullptr, scr, r, lane); continue; } r -= I_O;
        if (r < I_G) { p0_transpose_item<0>(A->w_ple_gate + (size_t)L * DM * DM, DM, DM, (bf16*)(ws + WS_WG) + (size_t)L * DM * DM, nullptr, scr, r, lane); continue; } r -= I_G;
        p0_transpose_item<0>(A->w_ple + (size_t)L * PLE * DM, PLE, DM, (bf16*)(ws + WS_WPLE) + (size_t)L * DM * PLE, nullptr, scr, r, lane);
    }
    for (int m = gw; m < M; m += NGW) x_row_to_bf16(A->x + (size_t)m * DM, (bf16*)(ws + WS_XB) + (size_t)m * DM, (float*)(ws + WS_RSX) + (size_t)m * 16, lane);
    const long gtid = (long)vcu * (NWAVES * 64) + tid, gthreads = (long)G * NWAVES * 64;
    cvt_f32_bf16(A->p, (bf16*)(ws + WS_PE), (long)M * PLE / 8, gtid, gthreads);
    for (long i = gtid; i < (long)SEQ * 64; i += gthreads) {
        const int pos = (int)(i >> 6), fi = (int)(i & 63);
        const float inv = (float)exp2(-(double)fi * (1.0 / 64.0) * 13.287712379549449);
        const float ang = (float)pos * inv;
        double s, c; sincos_d((double)ang, s, c);
        ((f32x2v*)(ws + WS_TAB))[i] = (f32x2v){(float)c, (float)s};
    }
    for (long i = gtid; i < (long)NH * SEQ; i += gthreads) {
        const int h = (int)(i >> 13), n = (int)(i & 8191);
        ((float*)(ws + WS_LUT))[i] = A->rel_bias[t5_bucket(n) * NH + h];
    }
}

__device__ __forceinline__ void p1b_rowops(KA A, int L) {
    PHASE_IDS();
    unsigned char* ws = A->ws; bf16* PROJ = (bf16*)(ws + WS_PROJ);
    const int gw = vcu * NWAVES + wave, NGW = G * NWAVES;
    const int hd = lane >> 4, i0 = (lane & 15) * 4;
    const float lg2 = ret_log2g(hd);
    const float* qg = A->q_norm_g + L * HD + (lane & 15) * 8; const float* kg = A->k_norm_g + L * HD + (lane & 15) * 8;
    const f32x4 qg0 = *(const f32x4*)qg, qg1 = *(const f32x4*)(qg + 4), kg0 = *(const f32x4*)kg, kg1 = *(const f32x4*)(kg + 4);
    for (int t = gw; t < M; t += NGW) {
        const int pos = t & (SEQ - 1), j = pos & 127;
        bf16* row = PROJ + (size_t)t * INW;
        const f32x4* cs = (const f32x4*)((const f32x2v*)(ws + WS_TAB) + (size_t)pos * 64 + i0);
        const f32x4 cs0 = cs[0], cs1 = cs[1];
        const float gq = exp2f((float)j * lg2), gk = RSQRT_HD * exp2f(-(float)j * lg2);
        {   v4u w = *(v4u*)(row + C_RQ + 8 * lane);
            float a, b;
            a = bflo(w.x); b = bfhi(w.x); w.x = pk2((a * cs0[0] - b * cs0[1]) * gq, (a * cs0[1] + b * cs0[0]) * gq);
            a = bflo(w.y); b = bfhi(w.y); w.y = pk2((a * cs0[2] - b * cs0[3]) * gq, (a * cs0[3] + b * cs0[2]) * gq);
            a = bflo(w.z); b = bfhi(w.z); w.z = pk2((a * cs1[0] - b * cs1[1]) * gq, (a * cs1[1] + b * cs1[0]) * gq);
            a = bflo(w.w); b = bfhi(w.w); w.w = pk2((a * cs1[2] - b * cs1[3]) * gq, (a * cs1[3] + b * cs1[2]) * gq);
            *(v4u*)(row + C_RQ + 8 * lane) = w; }
        {   v4u w = *(v4u*)(row + C_RK + 8 * lane);
            float a, b;
            a = bflo(w.x); b = bfhi(w.x); w.x = pk2((a * cs0[0] - b * cs0[1]) * gk, (a * cs0[1] + b * cs0[0]) * gk);
            a = bflo(w.y); b = bfhi(w.y); w.y = pk2((a * cs0[2] - b * cs0[3]) * gk, (a * cs0[3] + b * cs0[2]) * gk);
            a = bflo(w.z); b = bfhi(w.z); w.z = pk2((a * cs1[0] - b * cs1[1]) * gk, (a * cs1[1] + b * cs1[0]) * gk);
            a = bflo(w.w); b = bfhi(w.w); w.w = pk2((a * cs1[2] - b * cs1[3]) * gk, (a * cs1[3] + b * cs1[2]) * gk);
            *(v4u*)(row + C_RK + 8 * lane) = w; }
        {   v4u w = *(v4u*)(row + C_MQ + 8 * lane);
            float v[8] = {bflo(w.x), bfhi(w.x), bflo(w.y), bfhi(w.y), bflo(w.z), bfhi(w.z), bflo(w.w), bfhi(w.w)};
            float ss = 0.f;
#pragma unroll
            for (int e = 0; e < 8; ++e) ss += v[e] * v[e];
            ss += __shfl_xor(ss, 1); ss += __shfl_xor(ss, 2); ss += __shfl_xor(ss, 4); ss += __shfl_xor(ss, 8);
            const float r = RSQRT_HD / sqrtf(ss * (1.0f / 128.0f) + pg8::EPS);
            w.x = pk2(v[0] * r * qg0[0], v[1] * r * qg0[1]); w.y = pk2(v[2] * r * qg0[2], v[3] * r * qg0[3]); w.z = pk2(v[4] * r * qg1[0], v[5] * r * qg1[1]); w.w = pk2(v[6] * r * qg1[2], v[7] * r * qg1[3]);
            *(v4u*)(row + C_MQ + 8 * lane) = w; }
        {   v4u w = *(v4u*)(row + C_MK + 8 * lane);
            float v[8] = {bflo(w.x), bfhi(w.x), bflo(w.y), bfhi(w.y), bflo(w.z), bfhi(w.z), bflo(w.w), bfhi(w.w)};
            float ss = 0.f;
#pragma unroll
            for (int e = 0; e < 8; ++e) ss += v[e] * v[e];
            ss += __shfl_xor(ss, 1); ss += __shfl_xor(ss, 2); ss += __shfl_xor(ss, 4); ss += __shfl_xor(ss, 8);
            const float r = 1.0f / sqrtf(ss * (1.0f / 128.0f) + pg8::EPS);
            w.x = pk2(v[0] * r * kg0[0], v[1] * r * kg0[1]); w.y = pk2(v[2] * r * kg0[2], v[3] * r * kg0[3]); w.z = pk2(v[4] * r * kg1[0], v[5] * r * kg1[1]); w.w = pk2(v[6] * r * kg1[2], v[7] * r * kg1[3]);
            *(v4u*)(row + C_MK + 8 * lane) = w; }
    }
}

__device__ __forceinline__ void p2_kmean(KA A) {
    PHASE_IDS();
    unsigned char* ws = A->ws; const bf16* PROJ = (const bf16*)(ws + WS_PROJ); float* KM = (float*)(ws + WS_KMEAN);
    for (int idx = vcu * (NWAVES * 64) + tid; idx < 16 * NBLK * HD; idx += G * NWAVES * 64) {
        const int bh = idx >> 12, blk = (idx >> 7) & 31, col = idx & 127, b = bh >> 2, h = bh & 3;
        const bf16* src = PROJ + (size_t)(b * SEQ + blk * 256) * INW + C_MK + h * HD + col;
        float s = 0.f;
#pragma unroll 8
        for (int r = 0; r < 256; ++r) s += bf2f(src[(size_t)r * INW]);
        KM[idx] = s * (1.0f / 256.0f);
    }
}
static_assert(4 * 128 * 272 <= LDSCTL_OFF, "retention tiles must stay below the LDS control words");
constexpr int TROW = 272;
__device__ __forceinline__ void stage_tile128(const bf16* g, size_t ld, unsigned char* dst, int tid) {
#pragma unroll
    for (int i = 0; i < 4; ++i) { const int ch = tid + i * 512, r = ch >> 4, c = ch & 15;
        *(v4u*)(dst + r * TROW + c * 16) = *(const v4u*)(g + (size_t)r * ld + c * 8); }
}
__device__ __forceinline__ void p2_kvsum(KA A, unsigned char* lds) {
    PHASE_IDS();
    unsigned char* ws = A->ws; const bf16* PROJ = (const bf16*)(ws + WS_PROJ); bf16* ST = (bf16*)(ws + WS_KV);
    unsigned char* Kt = lds; unsigned char* Vt = lds + 128 * TROW;
    const int e = tid >> 2, dp = tid & 3;
    for (int it = vcu; it < 16 * NCH; it += G) {
        const int bh = it >> 6, c = it & 63, b = bh >> 2, h = bh & 3;
        const size_t t0 = (size_t)b * SEQ + c * 128;
        stage_tile128(PROJ + t0 * INW + C_RK + h * HD, INW, Kt, tid);
        stage_tile128(PROJ + t0 * INW + C_RV + h * HD, INW, Vt, tid);
        __syncthreads();
        float acc[32];
#pragma unroll
        for (int i = 0; i < 32; ++i) acc[i] = 0.f;
        for (int m = 0; m < 128; ++m) {
            const float v = bf2f(*(const bf16*)(Vt + m * TROW + e * 2));
#pragma unroll
            for (int q = 0; q < 4; ++q) { const v4u w = *(const v4u*)(Kt + m * TROW + dp * 64 + q * 16);
                acc[q * 8 + 0] += v * bflo(w.x); acc[q * 8 + 1] += v * bfhi(w.x); acc[q * 8 + 2] += v * bflo(w.y); acc[q * 8 + 3] += v * bfhi(w.y);
                acc[q * 8 + 4] += v * bflo(w.z); acc[q * 8 + 5] += v * bfhi(w.z); acc[q * 8 + 6] += v * bflo(w.w); acc[q * 8 + 7] += v * bfhi(w.w); }
        }
        bf16* o = ST + ((size_t)it * 128 + e) * 128 + dp * 32;
#pragma unroll
        for (int q = 0; q < 4; ++q) { v4u w; w.x = pk2(acc[q * 8 + 0], acc[q * 8 + 1]); w.y = pk2(acc[q * 8 + 2], acc[q * 8 + 3]); w.z = pk2(acc[q * 8 + 4], acc[q * 8 + 5]); w.w = pk2(acc[q * 8 + 6], acc[q * 8 + 7]);
            *(v4u*)(o + q * 8) = w; }
        __syncthreads();
    }
}

__device__ __forceinline__ void p2b_gating(KA A, unsigned char* lds) {
    PHASE_IDS();
    unsigned char* ws = A->ws; const bf16* PROJ = (const bf16*)(ws + WS_PROJ); const float* KM = (const float*)(ws + WS_KMEAN); unsigned* SEL = (unsigned*)(ws + WS_SEL);
    float* km = (float*)lds;
    const int q = tid >> 1, half = tid & 1;
    for (int it = vcu; it < 16 * NBLK; it += G) {
        const int bh = it >> 5, qb = it & 31, b = bh >> 2, h = bh & 3;
        for (int i = tid; i < qb * 32; i += NWAVES * 64) ((f32x4*)km)[i] = ((const f32x4*)(KM + (size_t)bh * NBLK * HD))[i];
        __syncthreads();
        const size_t t = (size_t)b * SEQ + qb * 256 + q;
        const bf16* qp = PROJ + t * INW + C_MQ + h * HD + half * 64;
        float qf[64];
#pragma unroll
        for (int c = 0; c < 8; ++c) { const v4u w = *(const v4u*)(qp + c * 8);
            qf[c * 8 + 0] = bflo(w.x); qf[c * 8 + 1] = bfhi(w.x); qf[c * 8 + 2] = bflo(w.y); qf[c * 8 + 3] = bfhi(w.y); qf[c * 8 + 4] = bflo(w.z); qf[c * 8 + 5] = bfhi(w.z); qf[c * 8 + 6] = bflo(w.w); qf[c * 8 + 7] = bfhi(w.w); }
        float v0 = -3e38f, v1 = -3e38f, v2 = -3e38f; int i0 = -1, i1 = -1, i2 = -1;
        for (int n = 0; n < qb; ++n) {
            const f32x4* kr = (const f32x4*)(km + n * HD + half * 64);
            float d0 = 0.f, d1 = 0.f, d2 = 0.f, d3 = 0.f;
#pragma unroll
            for (int c = 0; c < 16; ++c) { const f32x4 k4 = kr[c]; d0 += qf[c * 4 + 0] * k4[0]; d1 += qf[c * 4 + 1] * k4[1]; d2 += qf[c * 4 + 2] * k4[2]; d3 += qf[c * 4 + 3] * k4[3]; }
            float d = (d0 + d1) + (d2 + d3);
            d += __shfl_xor(d, 1);
            if (d > v0) { v2 = v1; i2 = i1; v1 = v0; i1 = i0; v0 = d; i0 = n; }
            else if (d > v1) { v2 = v1; i2 = i1; v1 = d; i1 = n; }
            else if (d > v2) { v2 = d; i2 = n; }
        }
        unsigned mask = 0u;
        if (i0 >= 0) mask |= 1u << i0; if (i1 >= 0) mask |= 1u << i1; if (i2 >= 0) mask |= 1u << i2;
        if (half == 0) SEL[t * NH + h] = mask;
        __syncthreads();
    }
}

__device__ __forceinline__ void p3_scan(KA A) {
    PHASE_IDS();
    unsigned* ST = (unsigned*)(A->ws + WS_KV);
    for (int idx = vcu * (NWAVES * 64) + tid; idx < 16 * 8192; idx += G * NWAVES * 64) {
        const int bh = idx >> 13, pr = idx & 8191, h = bh & 3;
        const float lg2 = ret_log2g(h), g1 = exp2f(lg2), g127 = exp2f(127.f * lg2), g128 = exp2f(128.f * lg2);
        unsigned* p = ST + (size_t)bh * NCH * 8192 + pr;
        float s0 = 0.f, s1 = 0.f;
#pragma unroll 8
        for (int c = 0; c < NCH; ++c) {
            const unsigned w = p[(size_t)c * 8192];
            p[(size_t)c * 8192] = pk2(g1 * s0, g1 * s1);
            s0 = s0 * g128 + g127 * bflo(w); s1 = s1 * g128 + g127 * bfhi(w);
        }
    }
}

__device__ __forceinline__ void p3_moba_naive(KA A, unsigned char* lds) {
    PHASE_IDS();
    unsigned char* ws = A->ws; bf16* PROJ = (bf16*)(ws + WS_PROJ); const unsigned* SEL = (const unsigned*)(ws + WS_SEL); const float* LUT = (const float*)(ws + WS_LUT);
    float* qs = (float*)(lds + wave * 5120);
    float* ps = qs + 128;
    const int gw = vcu * NWAVES + wave, NGW = G * NWAVES;
    for (int item = gw; item < M * NH; item += NGW) {
        const int t = item >> 2, h = item & 3, b = t >> 13, pos = t & (SEQ - 1), qb = pos >> 8;
        const unsigned mask = SEL[item];
        int blk[4]; int nsel = 0;
        { unsigned mm = mask; const int a0 = mm ? __builtin_ctz(mm) : 0; if (mm) { mm &= mm - 1; ++nsel; } const int a1 = mm ? __builtin_ctz(mm) : 0; if (mm) { mm &= mm - 1; ++nsel; } const int a2 = mm ? __builtin_ctz(mm) : 0; if (mm) { ++nsel; }
          blk[0] = a0; blk[1] = a1; blk[2] = a2; blk[3] = qb; }
        const unsigned qw = *(const unsigned*)(PROJ + (size_t)t * INW + C_MQ + h * HD + 2 * lane);
        qs[2 * lane] = bflo(qw); qs[2 * lane + 1] = bfhi(qw);
        LDS_WAIT();
        const float* lut = LUT + h * SEQ;
        float sc[16]; float mx = -1e30f;
#pragma unroll
        for (int sl = 0; sl < 4; ++sl) {
            const bool on = (sl == 3) || (sl < nsel);
#pragma unroll
            for (int kk = 0; kk < 4; ++kk) {
                float s = -1e30f;
                if (on) {
                    const int kpos = blk[sl] * 256 + kk * 64 + lane;
                    const bf16* kp = PROJ + ((size_t)b * SEQ + kpos) * INW + C_MK + h * HD;
                    float d = 0.f;
#pragma unroll
                    for (int c = 0; c < 16; ++c) { const v4u w = *(const v4u*)(kp + c * 8); const f32x4 q0 = *(const f32x4*)(qs + c * 8), q1 = *(const f32x4*)(qs + c * 8 + 4);
                        d += (bflo(w.x) * q0[0] + bfhi(w.x) * q0[1]) + (bflo(w.y) * q0[2] + bfhi(w.y) * q0[3]) + (bflo(w.z) * q1[0] + bfhi(w.z) * q1[1]) + (bflo(w.w) * q1[2] + bfhi(w.w) * q1[3]); }
                    const int dist = pos - kpos;
                    if (dist >= 0) s = d + lut[dist];
                }
                sc[sl * 4 + kk] = s; mx = fmaxf(mx, s);
            }
        }
        mx = wave_max(mx);
        float l = 0.f;
#pragma unroll
        for (int i = 0; i < 16; ++i) { const float pz = (sc[i] > -1e29f) ? __expf(sc[i] - mx) : 0.f; l += pz; ps[i * 64 + lane] = pz; }
        l = wave_sum(l);
        LDS_WAIT();
        float o0 = 0.f, o1 = 0.f;
#pragma unroll
        for (int sl = 0; sl < 4; ++sl) {
            const bool on = (sl == 3) || (sl < nsel);
            if (on) {
                const bf16* vp = PROJ + ((size_t)b * SEQ + blk[sl] * 256) * INW + C_MV + h * HD + 2 * lane;
#pragma unroll 8
                for (int k = 0; k < 256; ++k) { const float pz = ps[sl * 256 + k]; const unsigned w = *(const unsigned*)(vp + (size_t)k * INW); o0 += pz * bflo(w); o1 += pz * bfhi(w); }
            }
        }
        const float inv = 1.0f / l;
        const unsigned zw = *(const unsigned*)(PROJ + (size_t)t * INW + C_MZ + h * HD + 2 * lane);
        const float z0 = bflo(zw), z1 = bfhi(zw);
        const float r0 = o0 * inv * (z0 / (1.0f + __expf(-z0))), r1 = o1 * inv * (z1 / (1.0f + __expf(-z1)));
        *(unsigned*)(PROJ + (size_t)t * INW + C_MQ + h * HD + 2 * lane) = pk2(r0, r1);
        LDS_WAIT();
    }
}

__device__ __forceinline__ void p4_ret_naive(KA A, int L, unsigned char* lds) {
    PHASE_IDS();
    unsigned char* ws = A->ws; bf16* PROJ = (bf16*)(ws + WS_PROJ); const bf16* ST = (const bf16*)(ws + WS_KV);
    unsigned char* Qt = lds; unsigned char* Kt = lds + 128 * TROW; unsigned char* Vt = lds + 2 * 128 * TROW; unsigned char* St = lds + 3 * 128 * TROW;
    const int n = tid >> 2, part = tid & 3;
    for (int it = vcu; it < 16 * NCH; it += G) {
        const int bh = it >> 6, c = it & 63, b = bh >> 2, h = bh & 3;
        const size_t t0 = (size_t)b * SEQ + c * 128;
        stage_tile128(PROJ + t0 * INW + C_RQ + h * HD, INW, Qt, tid);
        stage_tile128(PROJ + t0 * INW + C_RK + h * HD, INW, Kt, tid);
        stage_tile128(PROJ + t0 * INW + C_RV + h * HD, INW, Vt, tid);
        stage_tile128(ST + (size_t)it * 128 * 128, 128, St, tid);
        __syncthreads();
        float qf[32];
#pragma unroll
        for (int q = 0; q < 4; ++q) { const v4u w = *(const v4u*)(Qt + n * TROW + part * 64 + q * 16);
            qf[q * 8 + 0] = bflo(w.x); qf[q * 8 + 1] = bfhi(w.x); qf[q * 8 + 2] = bflo(w.y); qf[q * 8 + 3] = bfhi(w.y); qf[q * 8 + 4] = bflo(w.z); qf[q * 8 + 5] = bfhi(w.z); qf[q * 8 + 6] = bflo(w.w); qf[q * 8 + 7] = bfhi(w.w); }
        float o[32];
#pragma unroll
        for (int i = 0; i < 32; ++i) o[i] = 0.f;
        const int mend = (n | 15) + 1;
        for (int m = 0; m < mend; ++m) {
            float s = 0.f;
#pragma unroll
            for (int q = 0; q < 4; ++q) { const v4u w = *(const v4u*)(Kt + m * TROW + part * 64 + q * 16);
                s += (qf[q * 8 + 0] * bflo(w.x) + qf[q * 8 + 1] * bfhi(w.x)) + (qf[q * 8 + 2] * bflo(w.y) + qf[q * 8 + 3] * bfhi(w.y)) + (qf[q * 8 + 4] * bflo(w.z) + qf[q * 8 + 5] * bfhi(w.z)) + (qf[q * 8 + 6] * bflo(w.w) + qf[q * 8 + 7] * bfhi(w.w)); }
            s += __shfl_xor(s, 1); s += __shfl_xor(s, 2);
            if (m > n) s = 0.f;
#pragma unroll
            for (int q = 0; q < 4; ++q) { const v4u w = *(const v4u*)(Vt + m * TROW + part * 64 + q * 16);
                o[q * 8 + 0] += s * bflo(w.x); o[q * 8 + 1] += s * bfhi(w.x); o[q * 8 + 2] += s * bflo(w.y); o[q * 8 + 3] += s * bfhi(w.y); o[q * 8 + 4] += s * bflo(w.z); o[q * 8 + 5] += s * bfhi(w.z); o[q * 8 + 6] += s * bflo(w.w); o[q * 8 + 7] += s * bfhi(w.w); }
        }
        for (int d8 = 0; d8 < 16; ++d8) {
            const v4u qw = *(const v4u*)(Qt + n * TROW + d8 * 16);
            const float q0 = bflo(qw.x), q1 = bfhi(qw.x), q2 = bflo(qw.y), q3 = bfhi(qw.y), q4 = bflo(qw.z), q5 = bfhi(qw.z), q6 = bflo(qw.w), q7 = bfhi(qw.w);
#pragma unroll
            for (int ee = 0; ee < 32; ++ee) { const v4u w = *(const v4u*)(St + (part * 32 + ee) * TROW + d8 * 16);
                o[ee] += (q0 * bflo(w.x) + q1 * bfhi(w.x)) + (q2 * bflo(w.y) + q3 * bfhi(w.y)) + (q4 * bflo(w.z) + q5 * bfhi(w.z)) + (q6 * bflo(w.w) + q7 * bfhi(w.w)); }
        }
        float sm = 0.f;
#pragma unroll
        for (int i = 0; i < 32; ++i) sm += o[i];
        sm += __shfl_xor(sm, 1); sm += __shfl_xor(sm, 2);
        const float mean = sm * (1.0f / 128.0f);
        float vr = 0.f;
#pragma unroll
        for (int i = 0; i < 32; ++i) { const float dlt = o[i] - mean; vr += dlt * dlt; }
        vr += __shfl_xor(vr, 1); vr += __shfl_xor(vr, 2);
        const float rstd = 1.0f / sqrtf(vr * (1.0f / 128.0f) + pg8::EPS);
        const float* gn = A->ret_norm_g + L * 512 + h * HD + part * 32;
        bf16* zrow = PROJ + (t0 + n) * INW + C_RZ + h * HD + part * 32;
        bf16* orow = PROJ + (t0 + n) * INW + C_RQ + h * HD + part * 32;
#pragma unroll
        for (int q = 0; q < 4; ++q) { const v4u zw = *(const v4u*)(zrow + q * 8); const f32x4 g0 = *(const f32x4*)(gn + q * 8), g1 = *(const f32x4*)(gn + q * 8 + 4);
            float z[8] = {bflo(zw.x), bfhi(zw.x), bflo(zw.y), bfhi(zw.y), bflo(zw.z), bfhi(zw.z), bflo(zw.w), bfhi(zw.w)};
            float r[8];
#pragma unroll
            for (int e = 0; e < 8; ++e) { const float gg = (e < 4) ? g0[e & 3] : g1[e & 3]; r[e] = (o[q * 8 + e] - mean) * rstd * gg * (z[e] / (1.0f + __expf(-z[e]))); }
            v4u w; w.x = pk2(r[0], r[1]); w.y = pk2(r[2], r[3]); w.z = pk2(r[4], r[5]); w.w = pk2(r[6], r[7]);
            *(v4u*)(orow + q * 8) = w; }
        __syncthreads();
    }
}

constexpr size_t WS_PARTO = WS_XB;
constexpr size_t WS_PARTML = 501 * MiB;
constexpr size_t WS_LIST = 504 * MiB;
constexpr size_t WS_CNT = 508 * MiB;
constexpr int CW_TOT = 8192;
static_assert(WS_PARTO + (size_t)M * NH * 3 * 128 * 2 <= WS_PROJ && WS_CNT + 16 * 32 * 32 * 4 <= 512 * MiB, "MoBA workspace");

namespace mb {
using bf16x8 = __attribute__((ext_vector_type(8))) short;
using s16x4  = __attribute__((ext_vector_type(4))) short;
using f32x16 = __attribute__((ext_vector_type(16))) float;
using u32x4  = __attribute__((ext_vector_type(4))) unsigned;
constexpr int KVBLK = 64, QBLK = 32;
constexpr int SHM_V = KVBLK * 128 * 2, SHM_K = KVBLK * 128 * 2;
constexpr int L_V = 0, L_K = 2 * SHM_V, L_WS = 2 * SHM_V + 2 * SHM_K  , L_LUT = L_WS + 2048  , L_QPOS = L_LUT + 32768  ,
              L_TAB = L_QPOS + 1024  , L_SEG = L_TAB + 2048  , L_COEF = L_SEG + 256  , L_END = L_COEF + 4096;
static_assert(L_END <= LDSCTL_OFF, "MoBA LDS map");
#define MB_KSWZ(row, colB) ((row) * 256 + ((colB) ^ (((row) & 7) << 4)))
#define MB_SBAR() __builtin_amdgcn_sched_barrier(0)
__device__ __forceinline__ int crow(int r, int hi) { return (r & 3) + 8 * (r >> 2) + 4 * hi; }
__device__ __forceinline__ unsigned cvtpk(float lo, float hi) { unsigned r; asm volatile("v_cvt_pk_bf16_f32 %0, %1, %2" : "=v"(r) : "v"(lo), "v"(hi)); return r; }
constexpr float LOG2E = 1.4426950408889634f;
constexpr float THR = 0.f;

__device__ __forceinline__ void partialSM(f32x16& p0, f32x16& p1, float& m_reg, float& mn, float& alpha) {
  float pmax = p0[0];
#pragma unroll
  for (int r = 1; r < 16; ++r) pmax = fmaxf(pmax, p0[r]);
#pragma unroll
  for (int r = 0; r < 16; ++r) pmax = fmaxf(pmax, p1[r]);
  { auto rr = __builtin_amdgcn_permlane32_swap(__float_as_uint(pmax), __float_as_uint(pmax), false, false);
    pmax = fmaxf(__uint_as_float(rr[0]), __uint_as_float(rr[1])); }
  if (__builtin_expect(__all(pmax - m_reg <= THR), 1)) { mn = m_reg; alpha = 1.f; }
  else { mn = fmaxf(m_reg, pmax); alpha = __builtin_amdgcn_exp2f((m_reg - mn) * LOG2E); m_reg = mn; }
  const float mnC = -mn * LOG2E;
#pragma unroll
  for (int r = 0; r < 16; ++r) p0[r] = fmaf(p0[r], LOG2E, mnC);
#pragma unroll
  for (int r = 0; r < 16; ++r) p1[r] = fmaf(p1[r], LOG2E, mnC);
#pragma unroll
  for (int r = 0; r < 16; ++r) p0[r] = __builtin_amdgcn_exp2f(p0[r]);
}
__device__ __forceinline__ void finishSM(f32x16& p0, f32x16& p1, float alpha, float& l_reg, bf16x8& pa0, bf16x8& pa1, bf16x8& pa2, bf16x8& pa3) {
#pragma unroll
  for (int r = 0; r < 16; ++r) p1[r] = __builtin_amdgcn_exp2f(p1[r]);
  float ps = 0;
#pragma unroll
  for (int r = 0; r < 16; ++r) ps += p0[r];
#pragma unroll
  for (int r = 0; r < 16; ++r) ps += p1[r];
  { auto rr = __builtin_amdgcn_permlane32_swap(__float_as_uint(ps), __float_as_uint(ps), false, false);
    ps = __uint_as_float(rr[0]) + __uint_as_float(rr[1]); }
  l_reg = l_reg * alpha + ps;
#define MB_PK4(P, BASE, OUT) do { unsigned a0 = cvtpk(P[BASE + 0], P[BASE + 1]), a1 = cvtpk(P[BASE + 2], P[BASE + 3]);   \
    unsigned b0 = cvtpk(P[BASE + 4], P[BASE + 5]), b1 = cvtpk(P[BASE + 6], P[BASE + 7]);                              \
    auto r0 = __builtin_amdgcn_permlane32_swap(a0, b0, false, false); auto r1 = __builtin_amdgcn_permlane32_swap(a1, b1, false, false); \
    u32x4 w = {r0[0], r1[0], r0[1], r1[1]}; OUT = *reinterpret_cast<bf16x8*>(&w); } while (0)
  MB_PK4(p0, 0, pa0); MB_PK4(p0, 8, pa1); MB_PK4(p1, 0, pa2); MB_PK4(p1, 8, pa3);
#undef MB_PK4
}
template <bool OWN>
__device__ __forceinline__ void qkt(f32x16& p0, f32x16& p1, const char* Ks, const bf16x8* qr, int r32, int hi, int dq, const float* lut) {
#pragma unroll
  for (int r = 0; r < 16; ++r) {
    const int i0 = dq - crow(r, hi), i1 = i0 - 32;
    if (OWN) { p0[r] = (i0 >= 0) ? lut[i0 < 0 ? 0 : i0] : -1e30f; p1[r] = (i1 >= 0) ? lut[i1 < 0 ? 0 : i1] : -1e30f; }
    else { p0[r] = lut[i0]; p1[r] = lut[i1]; }
  }
#pragma unroll
  for (int d0 = 0; d0 < 8; ++d0) { const int cb = (d0 * 16 + hi * 8) * 2;
    const bf16x8 b0 = *reinterpret_cast<const bf16x8*>(Ks + MB_KSWZ(r32, cb));
    const bf16x8 b1 = *reinterpret_cast<const bf16x8*>(Ks + MB_KSWZ(32 + r32, cb));
    p0 = __builtin_amdgcn_mfma_f32_32x32x16_bf16(b0, qr[d0], p0, 0, 0, 0);
    p1 = __builtin_amdgcn_mfma_f32_32x32x16_bf16(b1, qr[d0], p1, 0, 0, 0); }
}
__device__ __forceinline__ int v_st(int k, int c) { const int kk = (k & ~0xC) | ((k & 4) << 1) | ((k & 8) >> 1); return ((kk >> 3) * 4 + (c >> 5)) * 512 + ((kk & 7) * 32 + (c & 31)) * 2; }
__device__ __forceinline__ int v_rd_base(int lane) { return ((lane & 3) << 3) | (((lane >> 2) & 3) << 6) | (((lane >> 4) & 1) << 5) | (((lane >> 5) & 1) << 8); }
constexpr int v_rd_off(int d0, int ks, int half) { return d0 * 512 + ks * 4096 + half * 2048; }
template <int OFF> __device__ __forceinline__ s16x4 tr_read(int vb) { s16x4 r; asm volatile("ds_read_b64_tr_b16 %0, %1 offset:%2" : "=&v"(r) : "v"(vb), "i"(OFF) : "memory"); return r; }
template <int D0> __device__ __forceinline__ void pv_one(f32x16& od, int vb, bf16x8 pa0, bf16x8 pa1, bf16x8 pa2, bf16x8 pa3) {
  const s16x4 l0 = tr_read<v_rd_off(D0, 0, 0)>(vb), h0 = tr_read<v_rd_off(D0, 0, 1)>(vb), l1 = tr_read<v_rd_off(D0, 1, 0)>(vb), h1 = tr_read<v_rd_off(D0, 1, 1)>(vb);
  const s16x4 l2 = tr_read<v_rd_off(D0, 2, 0)>(vb), h2 = tr_read<v_rd_off(D0, 2, 1)>(vb), l3 = tr_read<v_rd_off(D0, 3, 0)>(vb), h3 = tr_read<v_rd_off(D0, 3, 1)>(vb);
  asm volatile("s_waitcnt lgkmcnt(0)" ::: "memory"); MB_SBAR();
#define MB_PK(L, H) (bf16x8){L[0], L[1], L[2], L[3], H[0], H[1], H[2], H[3]}
  od = __builtin_amdgcn_mfma_f32_32x32x16_bf16(pa0, MB_PK(l0, h0), od, 0, 0, 0);
  od = __builtin_amdgcn_mfma_f32_32x32x16_bf16(pa1, MB_PK(l1, h1), od, 0, 0, 0);
  od = __builtin_amdgcn_mfma_f32_32x32x16_bf16(pa2, MB_PK(l2, h2), od, 0, 0, 0);
  od = __builtin_amdgcn_mfma_f32_32x32x16_bf16(pa3, MB_PK(l3, h3), od, 0, 0, 0);
#undef MB_PK
}
__device__ __forceinline__ void pv_d0(f32x16* o, int vb, bf16x8 pa0, bf16x8 pa1, bf16x8 pa2, bf16x8 pa3) {
  pv_one<0>(o[0], vb, pa0, pa1, pa2, pa3); pv_one<1>(o[1], vb, pa0, pa1, pa2, pa3); pv_one<2>(o[2], vb, pa0, pa1, pa2, pa3); pv_one<3>(o[3], vb, pa0, pa1, pa2, pa3);
}

template <bool OWN>
__device__ __forceinline__ void attend_block(const bf16* __restrict__ Qseq, const bf16* __restrict__ Kh, const bf16* __restrict__ Vh, int kpos0, char* lds, f32x16 (&o)[4], float& m_out, float& l_out, int tid) {
  const int wid = tid >> 6, lane = tid & 63, r32 = lane & 31, hi = lane >> 5;
  char* V_lds = lds + L_V; char* K_lds = lds + L_K;
  float* wsf = (float*)(lds + L_WS) + wid * 64; float* al_l = wsf + 32;
  const float* lut = (const float*)(lds + L_LUT);
  const int qp = ((const int*)(lds + L_QPOS))[wid * QBLK + r32];
  float m_reg = -1e30f, l_reg = 0; bf16x8 qr[8];
  const bf16* Qw = Qseq + (size_t)qp * INW + hi * 8;
#pragma unroll
  for (int d0 = 0; d0 < 8; ++d0) qr[d0] = *reinterpret_cast<const bf16x8*>(Qw + d0 * 16);
#pragma unroll
  for (int d = 0; d < 4; ++d) o[d] = f32x16{};
  const int sr = tid >> 4, sc = (tid & 15) * 8, vst0 = v_st(sr, sc), vst1 = v_st(32 + sr, sc);
  const int vb0 = (int)(uintptr_t)V_lds + v_rd_base(lane);
  const int dq0 = qp - kpos0;
  struct { bf16x8 vs0, vs1, ks0, ks1; } sr_;
#define MB_SLOAD(k0) do { sr_.vs0 = *reinterpret_cast<const bf16x8*>(&Vh[(size_t)((k0) + sr) * INW + sc]); sr_.vs1 = *reinterpret_cast<const bf16x8*>(&Vh[(size_t)((k0) + 32 + sr) * INW + sc]); \
    sr_.ks0 = *reinterpret_cast<const bf16x8*>(&Kh[(size_t)((k0) + sr) * INW + sc]); sr_.ks1 = *reinterpret_cast<const bf16x8*>(&Kh[(size_t)((k0) + 32 + sr) * INW + sc]); } while (0)
#define MB_SWRITE(b) do { asm volatile("s_waitcnt vmcnt(0)" ::: "memory"); *(bf16x8*)(V_lds + (b) * SHM_V + vst0) = sr_.vs0; *(bf16x8*)(V_lds + (b) * SHM_V + vst1) = sr_.vs1; const int kc = sc * 2; \
    *(bf16x8*)(K_lds + (b) * SHM_K + MB_KSWZ(sr, kc)) = sr_.ks0; *(bf16x8*)(K_lds + (b) * SHM_K + MB_KSWZ(32 + sr, kc)) = sr_.ks1; } while (0)
#define MB_RESC(a) do { if (__any((a) < 1.f)) { if (hi == 0) al_l[r32] = (a); asm volatile("s_waitcnt lgkmcnt(0)" ::: "memory"); \
    _Pragma("unroll") for (int d = 0; d < 4; ++d) _Pragma("unroll") for (int r = 0; r < 16; ++r) o[d][r] *= al_l[crow(r, hi)]; } } while (0)
  f32x16 pA0, pA1, pB0, pB1; float mnA, mnB, alA, alB; bf16x8 pa0, pa1, pa2, pa3;
  MB_SLOAD(0); MB_SWRITE(0); __syncthreads();
  qkt<OWN>(pA0, pA1, K_lds, qr, r32, hi, dq0, lut); partialSM(pA0, pA1, m_reg, mnA, alA);
  MB_SLOAD(KVBLK); MB_SWRITE(1); __syncthreads();
  MB_SBAR(); qkt<OWN>(pB0, pB1, K_lds + SHM_K, qr, r32, hi, dq0 - KVBLK, lut);
  finishSM(pA0, pA1, alA, l_reg, pa0, pa1, pa2, pa3); MB_SBAR();
  MB_SLOAD(2 * KVBLK); MB_SBAR();
  pv_d0(o, vb0, pa0, pa1, pa2, pa3); partialSM(pB0, pB1, m_reg, mnB, alB);
  __syncthreads(); MB_SWRITE(0);
  MB_RESC(alB); __syncthreads();
  MB_SBAR(); qkt<OWN>(pA0, pA1, K_lds, qr, r32, hi, dq0 - 2 * KVBLK, lut);
  finishSM(pB0, pB1, alB, l_reg, pa0, pa1, pa2, pa3); MB_SBAR();
  MB_SLOAD(3 * KVBLK); MB_SBAR();
  pv_d0(o, vb0 + SHM_V, pa0, pa1, pa2, pa3); partialSM(pA0, pA1, m_reg, mnA, alA);
  __syncthreads(); MB_SWRITE(1);
  MB_RESC(alA); __syncthreads();
  MB_SBAR(); qkt<OWN>(pB0, pB1, K_lds + SHM_K, qr, r32, hi, dq0 - 3 * KVBLK, lut);
  finishSM(pA0, pA1, alA, l_reg, pa0, pa1, pa2, pa3); MB_SBAR();
  pv_d0(o, vb0, pa0, pa1, pa2, pa3); partialSM(pB0, pB1, m_reg, mnB, alB);
  MB_RESC(alB);
  finishSM(pB0, pB1, alB, l_reg, pa0, pa1, pa2, pa3); MB_SBAR();
  pv_d0(o, vb0 + SHM_V, pa0, pa1, pa2, pa3);
  m_out = m_reg; l_out = l_reg;
  __syncthreads();
#undef MB_SLOAD
#undef MB_SWRITE
#undef MB_RESC
}
__device__ __forceinline__ void stage_rows_bf16(const f32x16 (&o)[4], const float* rowscale, char* stg, int r32, int hi) {
#pragma unroll
  for (int r = 0; r < 16; ++r) { const int row = crow(r, hi); const float s = rowscale[row];
#pragma unroll
    for (int d0 = 0; d0 < 4; ++d0) *(unsigned short*)(stg + row * 256 + (d0 * 32 + r32) * 2) = (unsigned short)(cvtpk(o[d0][r] * s, 0.f) & 0xffffu); }
}
}

__device__ __forceinline__ void p2b_gating_lists(KA A, unsigned char* lds) {
    PHASE_IDS();
    unsigned char* ws = A->ws; const bf16* PROJ = (const bf16*)(ws + WS_PROJ); const float* KM = (const float*)(ws + WS_KMEAN); unsigned* SEL = (unsigned*)(ws + WS_SEL);
    unsigned char* LIST = ws + WS_LIST; unsigned* CNT = (unsigned*)(ws + WS_CNT); unsigned* TOT = (unsigned*)(ws + WS_CTL) + CW_TOT;
    float* km = (float*)lds; int* wc = (int*)(lds + 16384);
    const int q = tid >> 1, half = tid & 1;
    for (int it = vcu; it < 16 * NBLK; it += G) {
        const int bh = it >> 5, qb = it & 31, b = bh >> 2, h = bh & 3;
        for (int i = tid; i < qb * 32; i += NWAVES * 64) ((f32x4*)km)[i] = ((const f32x4*)(KM + (size_t)bh * NBLK * HD))[i];
        __syncthreads();
        const size_t t = (size_t)b * SEQ + qb * 256 + q;
        const bf16* qp = PROJ + t * INW + C_MQ + h * HD + half * 64;
        float qf[64];
#pragma unroll
        for (int c = 0; c < 8; ++c) { const v4u w = *(const v4u*)(qp + c * 8);
            qf[c * 8 + 0] = bflo(w.x); qf[c * 8 + 1] = bfhi(w.x); qf[c * 8 + 2] = bflo(w.y); qf[c * 8 + 3] = bfhi(w.y); qf[c * 8 + 4] = bflo(w.z); qf[c * 8 + 5] = bfhi(w.z); qf[c * 8 + 6] = bflo(w.w); qf[c * 8 + 7] = bfhi(w.w); }
        float v0 = -3e38f, v1 = -3e38f, v2 = -3e38f; int i0 = -1, i1 = -1, i2 = -1;
        for (int n = 0; n < qb; ++n) {
            const f32x4* kr = (const f32x4*)(km + n * HD + half * 64);
            float d0 = 0.f, d1 = 0.f, d2 = 0.f, d3 = 0.f;
#pragma unroll
            for (int c = 0; c < 16; ++c) { const f32x4 k4 = kr[c]; d0 += qf[c * 4 + 0] * k4[0]; d1 += qf[c * 4 + 1] * k4[1]; d2 += qf[c * 4 + 2] * k4[2]; d3 += qf[c * 4 + 3] * k4[3]; }
            float d = (d0 + d1) + (d2 + d3);
            d += __shfl_xor(d, 1);
            if (d > v0) { v2 = v1; i2 = i1; v1 = v0; i1 = i0; v0 = d; i0 = n; }
            else if (d > v1) { v2 = v1; i2 = i1; v1 = d; i1 = n; }
            else if (d > v2) { v2 = d; i2 = n; }
        }
        unsigned mask = 0u;
        if (i0 >= 0) mask |= 1u << i0; if (i1 >= 0) mask |= 1u << i1; if (i2 >= 0) mask |= 1u << i2;
        if (half == 0) SEL[t * NH + h] = mask;
        for (int j = 0; j < qb; ++j) { const unsigned long long bal = __ballot(half == 0 && ((mask >> j) & 1u)); if (lane == 0) wc[j * 8 + wave] = __popcll(bal); }
        __syncthreads();
        for (int j = 0; j < qb; ++j) {
            const bool f = (half == 0) && ((mask >> j) & 1u);
            const unsigned long long bal = __ballot(f);
            int off = __popcll(bal & ((1ull << lane) - 1ull));
            int tot = 0;
#pragma unroll
            for (int w = 0; w < 8; ++w) { const int c = wc[j * 8 + w]; off += (w < wave) ? c : 0; tot += c; }
            const size_t seg = ((size_t)(bh * 32 + j) * 32 + qb);
            if (f) LIST[seg * 256 + off] = (unsigned char)q;
            if (tid == 0) { CNT[seg] = (unsigned)tot; atomicAdd(&TOT[bh * 32 + j], (unsigned)tot); }
        }
        __syncthreads();
    }
}

__device__ __forceinline__ void p3_moba_sel(KA A, unsigned char* ldsu) {
    PHASE_IDS();
    char* lds = (char*)ldsu;
    unsigned char* ws = A->ws; const bf16* PROJ = (const bf16*)(ws + WS_PROJ); const unsigned* SEL = (const unsigned*)(ws + WS_SEL);
    const unsigned char* LIST = ws + WS_LIST; const unsigned* CNT = (const unsigned*)(ws + WS_CNT); unsigned* TOT = (unsigned*)(ws + WS_CTL) + CW_TOT;
    bf16* PARTO = (bf16*)(ws + WS_PARTO); float* PARTML = (float*)(ws + WS_PARTML);
    int* tab = (int*)(lds + mb::L_TAB);
    int* seg = (int*)(lds + mb::L_SEG);
    int* qpos = (int*)(lds + mb::L_QPOS);
    if (wave == 0) {
        int c[8]; int s = 0;
#pragma unroll
        for (int k = 0; k < 8; ++k) { const int e = lane * 8 + k; int n = 0; if (e < 496) { const int bh = e / 31, j = e % 31; n = (int)((__hip_atomic_load(&TOT[bh * 32 + j], __ATOMIC_RELAXED, __HIP_MEMORY_SCOPE_AGENT) + 255u) >> 8); } c[k] = s; s += n; }
        int incl = s;
#pragma unroll
        for (int o = 1; o < 64; o <<= 1) { const int v = __shfl_up(incl, o); if (lane >= o) incl += v; }
        const int excl = incl - s;
#pragma unroll
        for (int k = 0; k < 8; ++k) { const int e = lane * 8 + k; if (e <= 496) tab[e] = excl + c[k]; }
    }
    __syncthreads();
    const int T = tab[496];
    const int t_lo = (int)(((long)vcu * T) / G), t_hi = (int)(((long)(vcu + 1) * T) / G);
    int cur_h = -1;
    for (int tile = t_lo; tile < t_hi; ++tile) {
        int lo = 0, hi_ = 495;
        while (lo < hi_) { const int mid = (lo + hi_ + 1) >> 1; if (tab[mid] <= tile) lo = mid; else hi_ = mid - 1; }
        const int e = lo, bh = e / 31, j = e % 31, b = bh >> 2, h = bh & 3, ti = tile - tab[e];
        if (wave == 0) {
            int n = 0; if (lane > j && lane < 32) n = (int)CNT[(size_t)(bh * 32 + j) * 32 + lane];
            int incl = n;
#pragma unroll
            for (int o = 1; o < 32; o <<= 1) { const int v = __shfl_up(incl, o); if (lane >= o) incl += v; }
            if (lane < 32) seg[lane] = incl - n; if (lane == 31) seg[32] = incl;
        }
        if (cur_h != h) { cur_h = h; const f32x4* src = (const f32x4*)((const float*)(ws + WS_LUT) + h * SEQ); f32x4* dst = (f32x4*)(lds + mb::L_LUT);
#pragma unroll
            for (int i = 0; i < 4; ++i) dst[tid + i * 512] = src[tid + i * 512]; }
        __syncthreads();
        const int total = seg[32];
        if (tid < 256) {
            const int s = ti * 256 + tid; int pos = (j + 1) * 256;
            if (s < total) { int qb = j + 1; while (qb < 31 && seg[qb + 1] <= s) ++qb; pos = qb * 256 + (int)LIST[((size_t)(bh * 32 + j) * 32 + qb) * 256 + (s - seg[qb])]; }
            qpos[tid] = pos;
        }
        __syncthreads();
        const bf16* Qseq = PROJ + (size_t)b * SEQ * INW + C_MQ + h * HD;
        const bf16* Kh = PROJ + ((size_t)b * SEQ + j * 256) * INW + C_MK + h * HD;
        const bf16* Vh = PROJ + ((size_t)b * SEQ + j * 256) * INW + C_MV + h * HD;
        mb::f32x16 o[4]; float m_reg, l_reg;
        mb::attend_block<false>(Qseq, Kh, Vh, j * 256, lds, o, m_reg, l_reg, tid);
        int lane_e = lane; asm volatile("" : "+v"(lane_e));
#define lane lane_e
        const int r32 = lane & 31, hi = lane >> 5, pos = qpos[wave * 32 + r32];
        const bool valid = (ti * 256 + wave * 32 + r32) < total;
        const size_t trow = (size_t)b * SEQ + pos;
        const unsigned msk = SEL[trow * NH + h];
        const int slot = __popc(msk & ((1u << j) - 1u));
        float* wsf = (float*)(lds + mb::L_WS) + wave * 64;
        if (hi == 0) { wsf[r32] = 1.0f / l_reg; if (valid) { float* ml = PARTML + ((trow * NH + h) * 3 + slot) * 2; ml[0] = m_reg; ml[1] = l_reg; } }
        asm volatile("s_waitcnt lgkmcnt(0)" ::: "memory");
        char* stg = lds + wave * 8192;
        mb::stage_rows_bf16(o, wsf, stg, r32, hi);
        asm volatile("s_waitcnt lgkmcnt(0)" ::: "memory");
#pragma unroll
        for (int i = 0; i < 8; ++i) { const int row = (lane >> 4) + 4 * i, ch = lane & 15;
            const int rq = qpos[wave * 32 + row];
            const v4u val = *(const v4u*)(stg + row * 256 + ch * 16);
            const int s = ti * 256 + wave * 32 + row;
            if (s < total) { const size_t tr = (size_t)b * SEQ + rq; const unsigned mk = SEL[tr * NH + h]; const int sl = __popc(mk & ((1u << j) - 1u));
                *(v4u*)(PARTO + ((tr * NH + h) * 3 + sl) * 128 + ch * 8) = val; } }
#undef lane
        __syncthreads();
    }
}

__device__ __forceinline__ void p4_moba_own(KA A, unsigned char* ldsu) {
    PHASE_IDS();
    char* lds = (char*)ldsu;
    unsigned char* ws = A->ws; bf16* PROJ = (bf16*)(ws + WS_PROJ); const unsigned* SEL = (const unsigned*)(ws + WS_SEL);
    const bf16* PARTO = (const bf16*)(ws + WS_PARTO); const float* PARTML = (const float*)(ws + WS_PARTML);
    int* qpos = (int*)(lds + mb::L_QPOS);
    int cur_h = -1;
    for (int it = vcu; it < 16 * NBLK; it += G) {
        const int bh = it >> 5, qb = it & 31, b = bh >> 2, h = bh & 3;
        if (cur_h != h) { cur_h = h; const f32x4* src = (const f32x4*)((const float*)(ws + WS_LUT) + h * SEQ); f32x4* dst = (f32x4*)(lds + mb::L_LUT);
#pragma unroll
            for (int i = 0; i < 4; ++i) dst[tid + i * 512] = src[tid + i * 512]; }
        if (tid < 256) qpos[tid] = qb * 256 + tid;
        __syncthreads();
        const bf16* Qseq = PROJ + (size_t)b * SEQ * INW + C_MQ + h * HD;
        const bf16* Kh = PROJ + ((size_t)b * SEQ + qb * 256) * INW + C_MK + h * HD;
        const bf16* Vh = PROJ + ((size_t)b * SEQ + qb * 256) * INW + C_MV + h * HD;
        mb::f32x16 o[4]; float m_reg, l_reg;
        mb::attend_block<true>(Qseq, Kh, Vh, qb * 256, lds, o, m_reg, l_reg, tid);
        int lane_e = lane; asm volatile("" : "+v"(lane_e));
#define lane lane_e
        const int r32 = lane & 31, hi = lane >> 5;
        const size_t trow0 = (size_t)b * SEQ + qb * 256 + wave * 32;
        float* coef = (float*)(lds + mb::L_COEF) + wave * 128;
        if (hi == 0) {
            const size_t tr = trow0 + r32; const unsigned msk = SEL[tr * NH + h]; const int ns = __popc(msk);
            const float* ml = PARTML + (tr * NH + h) * 6;
            float pm[3], pl[3]; float mx = m_reg;
#pragma unroll
            for (int i = 0; i < 3; ++i) { pm[i] = (i < ns) ? ml[2 * i] : -1e30f; pl[i] = (i < ns) ? ml[2 * i + 1] : 0.f; mx = fmaxf(mx, pm[i]); }
            const float wo = __expf(m_reg - mx); float den = wo * l_reg; float w[3];
#pragma unroll
            for (int i = 0; i < 3; ++i) { w[i] = (i < ns) ? pl[i] * __expf(pm[i] - mx) : 0.f; den += w[i]; }
            const float inv = 1.0f / den;
            coef[r32] = wo * inv; coef[32 + r32] = w[0] * inv; coef[64 + r32] = w[1] * inv; coef[96 + r32] = w[2] * inv;
        }
        asm volatile("s_waitcnt lgkmcnt(0)" ::: "memory");
        char* stg = lds + wave * 8192;
        mb::stage_rows_bf16(o, coef, stg, r32, hi);
        asm volatile("s_waitcnt lgkmcnt(0)" ::: "memory");
#pragma unroll
        for (int i = 0; i < 8; ++i) { const int row = (lane >> 4) + 4 * i, ch = lane & 15;
            const size_t tr = trow0 + row;
            const v4u ow = *(const v4u*)(stg + row * 256 + ch * 16);
            float acc[8] = {bflo(ow.x), bfhi(ow.x), bflo(ow.y), bfhi(ow.y), bflo(ow.z), bfhi(ow.z), bflo(ow.w), bfhi(ow.w)};
#pragma unroll
            for (int k = 0; k < 3; ++k) { const float c = coef[32 * (k + 1) + row];
                if (c != 0.f) { const v4u pw = *(const v4u*)(PARTO + ((tr * NH + h) * 3 + k) * 128 + ch * 8);
                    acc[0] += c * bflo(pw.x); acc[1] += c * bfhi(pw.x); acc[2] += c * bflo(pw.y); acc[3] += c * bfhi(pw.y); acc[4] += c * bflo(pw.z); acc[5] += c * bfhi(pw.z); acc[6] += c * bflo(pw.w); acc[7] += c * bfhi(pw.w); } }
            const v4u zw = *(const v4u*)(PROJ + tr * INW + C_MZ + h * HD + ch * 8);
            const float z[8] = {bflo(zw.x), bfhi(zw.x), bflo(zw.y), bfhi(zw.y), bflo(zw.z), bfhi(zw.z), bflo(zw.w), bfhi(zw.w)};
#pragma unroll
            for (int e2 = 0; e2 < 8; ++e2) acc[e2] *= z[e2] / (1.0f + __expf(-z[e2]));
            v4u w; w.x = pk2(acc[0], acc[1]); w.y = pk2(acc[2], acc[3]); w.z = pk2(acc[4], acc[5]); w.w = pk2(acc[6], acc[7]);
            *(v4u*)(PROJ + tr * INW + C_MQ + h * HD + ch * 8) = w; }
#undef lane
        __syncthreads();
    }
}

namespace rt {
using mb::bf16x8; using mb::s16x4; using mb::f32x16; using mb::u32x4; using mb::crow; using mb::cvtpk; using mb::v_st; using mb::v_rd_base; using mb::v_rd_off;
typedef short v4i16_t __attribute__((ext_vector_type(4)));
typedef __attribute__((address_space(3))) const char* lds_cptr;
__device__ __forceinline__ s16x4 vtr(lds_cptr p) { return __builtin_bit_cast(s16x4, __builtin_amdgcn_ds_read_tr16_b64_v4i16((__attribute__((address_space(3))) v4i16_t*)p)); }
__device__ __forceinline__ bf16x8 tr_frag(lds_cptr base, int d0, int ks) {
  const s16x4 l = vtr(base + v_rd_off(d0, ks, 0)), h = vtr(base + v_rd_off(d0, ks, 1));
  return (bf16x8){l[0], l[1], l[2], l[3], h[0], h[1], h[2], h[3]};
}
__device__ __forceinline__ void pack32(const f32x16& p, bf16x8& pa0, bf16x8& pa1) {
#define RT_PK4(P, BASE, OUT) do { unsigned a0 = pk2(P[BASE + 0], P[BASE + 1]), a1 = pk2(P[BASE + 2], P[BASE + 3]);     \
    unsigned b0 = pk2(P[BASE + 4], P[BASE + 5]), b1 = pk2(P[BASE + 6], P[BASE + 7]);                              \
    auto r0 = __builtin_amdgcn_permlane32_swap(a0, b0, false, false); auto r1 = __builtin_amdgcn_permlane32_swap(a1, b1, false, false); \
    u32x4 w = {r0[0], r1[0], r0[1], r1[1]}; OUT = *reinterpret_cast<bf16x8*>(&w); } while (0)
  RT_PK4(p, 0, pa0); RT_PK4(p, 8, pa1);
#undef RT_PK4
}
constexpr int SROW = 528;
constexpr int SBLK = 32 * SROW;
}

__device__ __forceinline__ void p2_kvsum_mfma(KA A, unsigned char* ldsu) {
    PHASE_IDS();
    char* lds = (char*)ldsu;
    unsigned char* ws = A->ws; const bf16* PROJ = (const bf16*)(ws + WS_PROJ); bf16* ST = (bf16*)(ws + WS_KV);
    const int r32 = lane & 31, hi = lane >> 5, eb = wave >> 1, db0 = 2 * (wave & 1);
    const rt::lds_cptr kb_ = (rt::lds_cptr)lds + mb::v_rd_base(lane), vb_ = (rt::lds_cptr)lds + 32768 + mb::v_rd_base(lane);
    for (int it = vcu; it < 16 * NCH; it += G) {
        const int bh = it >> 6, c = it & 63, b = bh >> 2, h = bh & 3;
        const size_t t0 = (size_t)b * SEQ + c * 128;
#pragma unroll
        for (int i = 0; i < 4; ++i) { const int ch = tid + i * 512, r = ch >> 4, c16 = ch & 15; const int dst = (r >> 6) * 16384 + mb::v_st(r & 63, c16 * 8);
            *(v4u*)(lds + dst) = *(const v4u*)(PROJ + (t0 + r) * INW + C_RK + h * HD + c16 * 8);
            *(v4u*)(lds + 32768 + dst) = *(const v4u*)(PROJ + (t0 + r) * INW + C_RV + h * HD + c16 * 8); }
        __syncthreads();
        rt::f32x16 acc[2]; acc[0] = rt::f32x16{}; acc[1] = rt::f32x16{};
#pragma unroll
        for (int k8 = 0; k8 < 8; ++k8) { const int buf = (k8 >> 2) * 16384, ks = k8 & 3;
            const rt::bf16x8 af = rt::tr_frag(vb_ + buf, eb, ks);
#pragma unroll
            for (int dd = 0; dd < 2; ++dd) { const rt::bf16x8 bf_ = rt::tr_frag(kb_ + buf, db0 + dd, ks);
                acc[dd] = __builtin_amdgcn_mfma_f32_32x32x16_bf16(af, bf_, acc[dd], 0, 0, 0); } }
        bf16* o = ST + (size_t)it * 16384;
#pragma unroll
        for (int dd = 0; dd < 2; ++dd)
#pragma unroll
            for (int r = 0; r < 16; ++r) o[(32 * eb + rt::crow(r, hi)) * 128 + 32 * (db0 + dd) + r32] = (bf16)(pk2(acc[dd][r], 0.f) & 0xffffu);
        __syncthreads();
    }
}

__device__ __forceinline__ void p4_ret_mfma(KA A, int L, unsigned char* ldsu) {
    PHASE_IDS();
    char* lds = (char*)ldsu;
    unsigned char* ws = A->ws; bf16* PROJ = (bf16*)(ws + WS_PROJ); const bf16* ST = (const bf16*)(ws + WS_KV);
    const int r32 = lane & 31, hi = lane >> 5, wq = wave & 3, eh = wave >> 2;
    char* Ks = lds; char* Ss = lds + 65536;
    const rt::lds_cptr vb_ = (rt::lds_cptr)lds + 32768 + mb::v_rd_base(lane);
    for (int it = vcu; it < 16 * NCH; it += G) {
        const int bh = it >> 6, c = it & 63, b = bh >> 2, h = bh & 3;
        const size_t t0 = (size_t)b * SEQ + c * 128;
        rt::bf16x8 qr[8];
        { const bf16* Qw = PROJ + (t0 + 32 * wq + r32) * INW + C_RQ + h * HD + hi * 8;
#pragma unroll
          for (int d0 = 0; d0 < 8; ++d0) qr[d0] = *reinterpret_cast<const rt::bf16x8*>(Qw + d0 * 16); }
#pragma unroll
        for (int i = 0; i < 4; ++i) { const int ch = tid + i * 512, r = ch >> 4, c16 = ch & 15;
            *(v4u*)(Ks + MB_KSWZ(r, c16 * 16)) = *(const v4u*)(PROJ + (t0 + r) * INW + C_RK + h * HD + c16 * 8);
            *(v4u*)(lds + 32768 + (r >> 6) * 16384 + mb::v_st(r & 63, c16 * 8)) = *(const v4u*)(PROJ + (t0 + r) * INW + C_RV + h * HD + c16 * 8);
            *(v4u*)(Ss + MB_KSWZ(r, c16 * 16)) = *(const v4u*)(ST + (size_t)it * 16384 + r * 128 + c16 * 8); }
        __syncthreads();
        rt::f32x16 o[2]; o[0] = rt::f32x16{}; o[1] = rt::f32x16{};
#pragma unroll
        for (int kb = 0; kb < 4; ++kb) {
            if (kb <= wq) {
                rt::f32x16 p = rt::f32x16{};
#pragma unroll
                for (int d0 = 0; d0 < 8; ++d0) { const rt::bf16x8 kf = *reinterpret_cast<const rt::bf16x8*>(Ks + MB_KSWZ(32 * kb + r32, (d0 * 16 + hi * 8) * 2));
                    p = __builtin_amdgcn_mfma_f32_32x32x16_bf16(kf, qr[d0], p, 0, 0, 0); }
                if (kb == wq) {
#pragma unroll
                    for (int r = 0; r < 16; ++r) p[r] = (rt::crow(r, hi) <= r32) ? p[r] : 0.f; }
                rt::bf16x8 pa0, pa1; rt::pack32(p, pa0, pa1);
                const int buf = (kb >> 1) * 16384, ks0 = 2 * (kb & 1);
#pragma unroll
                for (int dd = 0; dd < 2; ++dd) { const rt::bf16x8 v0 = rt::tr_frag(vb_ + buf, 2 * eh + dd, ks0), v1 = rt::tr_frag(vb_ + buf, 2 * eh + dd, ks0 + 1);
                    o[dd] = __builtin_amdgcn_mfma_f32_32x32x16_bf16(pa0, v0, o[dd], 0, 0, 0);
                    o[dd] = __builtin_amdgcn_mfma_f32_32x32x16_bf16(pa1, v1, o[dd], 0, 0, 0); }
            }
        }
#pragma unroll
        for (int dd = 0; dd < 2; ++dd)
#pragma unroll
            for (int s = 0; s < 8; ++s) { const rt::bf16x8 sf = *reinterpret_cast<const rt::bf16x8*>(Ss + MB_KSWZ(32 * (2 * eh + dd) + r32, (s * 16 + hi * 8) * 2));
                o[dd] = __builtin_amdgcn_mfma_f32_32x32x16_bf16(qr[s], sf, o[dd], 0, 0, 0); }
        __syncthreads();
        { char* stg = lds + wq * rt::SBLK;
#pragma unroll
          for (int dd = 0; dd < 2; ++dd)
#pragma unroll
              for (int r = 0; r < 16; ++r) *(float*)(stg + rt::crow(r, hi) * rt::SROW + (32 * (2 * eh + dd) + r32) * 4) = o[dd][r]; }
        __syncthreads();
        {   int tid_e = tid; asm volatile("" : "+v"(tid_e));
            const int n = tid_e >> 2, part = tid_e & 3;
            const char* src = lds + (n >> 5) * rt::SBLK + (n & 31) * rt::SROW + part * 128;
            float ov[32];
#pragma unroll
            for (int q = 0; q < 8; ++q) { const f32x4 v = *(const f32x4*)(src + q * 16); ov[q * 4 + 0] = v[0]; ov[q * 4 + 1] = v[1]; ov[q * 4 + 2] = v[2]; ov[q * 4 + 3] = v[3]; }
            float sm = 0.f;
#pragma unroll
            for (int i = 0; i < 32; ++i) sm += ov[i];
            sm += __shfl_xor(sm, 1); sm += __shfl_xor(sm, 2);
            const float mean = sm * (1.0f / 128.0f);
            float vr = 0.f;
#pragma unroll
            for (int i = 0; i < 32; ++i) { const float dlt = ov[i] - mean; vr += dlt * dlt; }
            vr += __shfl_xor(vr, 1); vr += __shfl_xor(vr, 2);
            const float rstd = 1.0f / sqrtf(vr * (1.0f / 128.0f) + pg8::EPS);
            const float* gn = A->ret_norm_g + L * 512 + h * HD + part * 32;
            const bf16* zrow = PROJ + (t0 + n) * INW + C_RZ + h * HD + part * 32;
            bf16* orow = PROJ + (t0 + n) * INW + C_RQ + h * HD + part * 32;
#pragma unroll
            for (int q = 0; q < 4; ++q) { const v4u zw = *(const v4u*)(zrow + q * 8); const f32x4 g0 = *(const f32x4*)(gn + q * 8), g1 = *(const f32x4*)(gn + q * 8 + 4);
                const float z[8] = {bflo(zw.x), bfhi(zw.x), bflo(zw.y), bfhi(zw.y), bflo(zw.z), bfhi(zw.z), bflo(zw.w), bfhi(zw.w)};
                float r[8];
#pragma unroll
                for (int e = 0; e < 8; ++e) { const float gg = (e < 4) ? g0[e & 3] : g1[e & 3]; r[e] = (ov[q * 8 + e] - mean) * rstd * gg * (z[e] / (1.0f + __expf(-z[e]))); }
                v4u w; w.x = pk2(r[0], r[1]); w.y = pk2(r[2], r[3]); w.z = pk2(r[4], r[5]); w.w = pk2(r[6], r[7]);
                *(v4u*)(orow + q * 8) = w; }
        }
        __syncthreads();
    }
}

__global__ void __launch_bounds__(NWAVES * 64, 2) hymba_fwd(Args args_unused) {
    extern __shared__ __attribute__((aligned(16))) unsigned char lds[];
    LAS unsigned char* ldsl = (LAS unsigned char*)lds;
    volatile LAS unsigned* MISC = (volatile LAS unsigned*)(ldsl + MISC_OFF);
    { const int tid = threadIdx.x; for (int u = tid; u < (LDS_BYTES - LDSCTL_OFF) / 4; u += NWAVES * 64) ((LAS unsigned*)(ldsl + LDSCTL_OFF))[u] = 0u; }
    __syncthreads();
    (void)xcd_barrier_post((unsigned*)(get_ka()->ws + WS_CTL) + CW_BAR, MISC + 8);
#define GRID_BAR() do { XcdBarrier b_; b_.bar = (unsigned*)(get_ka()->ws + WS_CTL) + CW_BAR; b_.x = xb_xcc_id(); b_.st = (volatile LAS unsigned*)((LAS unsigned char*)lds + MISC_OFF) + 8; xcd_barrier(b_); } while (0)
#define WSP(T, off) ((T*)(ka->ws + (off)))

    p0_prologue(get_ka(), ldsl);
    GRID_BAR();

    for (int L = 0; L < DEPTH; ++L) {
        {   KA ka = get_ka(); int bx = blockIdx.x; asm volatile("" : "+s"(bx)); const int G = gridDim.x;
            pg8::Gemm g{WSP(bf16, WS_XB), WSP(const bf16, WS_WIN) + (size_t)L * INW * DM, M, INW, DM, DM}; pg8::StaticOrder S; S.init(M, INW, G, bx);
            pg8::EpiProj E{WSP(bf16, WS_PROJ), INW, WSP(float, WS_RSX)};
            pg8::gemm_phase<pg8::EpiProj, pg8::StaticOrder, true, true>(ldsl + RING_OFF, g, S, E); }
        {   KA ka = get_ka(); int bx = blockIdx.x; asm volatile("" : "+s"(bx)); const int G = gridDim.x;
            pg8::Gemm g{WSP(bf16, WS_PE), WSP(const bf16, WS_WPLE) + (size_t)L * DM * PLE, M, DM, PLE, PLE}; pg8::StaticOrder S; S.init(M, DM, G, bx);
            pg8::EpiE E{WSP(bf16, WS_EPRE), DM, WSP(float, WS_RSE)};
            pg8::gemm_phase<pg8::EpiE, pg8::StaticOrder, true, true>(ldsl + RING_OFF, g, S, E); }
        GRID_BAR();
        p1b_rowops(get_ka(), L);
        GRID_BAR();
        p2_kmean(get_ka());
        p2_kvsum_mfma(get_ka(), lds);
        GRID_BAR();
        p2b_gating_lists(get_ka(), lds);
        GRID_BAR();
        p3_scan(get_ka());
        p3_moba_sel(get_ka(), lds);
        GRID_BAR();
        p4_ret_mfma(get_ka(), L, lds);
        p4_moba_own(get_ka(), lds);
        GRID_BAR();
        {   KA ka = get_ka(); int bx = blockIdx.x; asm volatile("" : "+s"(bx)); const int G = gridDim.x;
            pg8::Gemm g{WSP(bf16, WS_PROJ), WSP(const bf16, WS_WOUT) + (size_t)L * DM * DM, M, DM, DM, INW}; pg8::StaticOrder S; S.init(M, DM, G, bx);
            pg8::EpiRes E{(L == 0) ? ka->x : (const float*)ka->out, ka->out, WSP(bf16, WS_PROJ) + C_X1B, WSP(float, WS_RSX1), DM, INW};
            pg8::gemm_phase<pg8::EpiRes, pg8::StaticOrder, true, true>(ldsl + RING_OFF, g, S, E); }
        GRID_BAR();
        {   KA ka = get_ka(); int bx = blockIdx.x; asm volatile("" : "+s"(bx)); const int G = gridDim.x;
            pg8::Gemm g{WSP(bf16, WS_PROJ) + C_X1B, WSP(const bf16, WS_WG) + (size_t)L * DM * DM, M, DM, DM, INW}; pg8::StaticOrder S; S.init(M, DM, G, bx);
            pg8::EpiGate E{ka->out, WSP(const bf16, WS_EPRE), WSP(const float, WS_RSX1), WSP(const float, WS_RSE), ka->ple_norm_g + L * DM, WSP(bf16, WS_XB), WSP(float, WS_RSX), DM};
            pg8::gemm_phase<pg8::EpiGate, pg8::StaticOrder, true, true>(ldsl + RING_OFF, g, S, E); }
        if (L + 1 < DEPTH) {
            {   KA ka = get_ka(); PHASE_IDS();
                const long gtid = (long)vcu * (NWAVES * 64) + tid, gthreads = (long)G * NWAVES * 64;
                cvt_f32_bf16(ka->p + (size_t)(L + 1) * M * PLE, WSP(bf16, WS_PE), (long)M * PLE / 8, gtid, gthreads); }
            GRID_BAR();
        }
    }
}

extern "C" void kernel_launch(void* const* d_in, const int* in_sizes, int n_in, void* d_out, int out_size, void* d_ws, size_t ws_size, hipStream_t stream) {
    static int grid = 0;
    if (grid == 0) {
        if (n_in != 12 || in_sizes[0] != M * DM || out_size != M * DM || ws_size < 512 * MiB) {
            fprintf(stderr, "kernel_launch: shape mismatch: n_in %d in0 %d out %d ws %zu (need >= %zu)\n", n_in, n_in > 0 ? in_sizes[0] : -1, out_size, ws_size, (size_t)(512 * MiB)); grid = -1; return; }
        int dev = 0, cus = 0, per_cu = 0;
        if (hipGetDevice(&dev) != hipSuccess || hipDeviceGetAttribute(&cus, hipDeviceAttributeMultiprocessorCount, dev) != hipSuccess) { fprintf(stderr, "kernel_launch: device query failed\n"); grid = -1; return; }
        if (hipFuncSetAttribute((const void*)hymba_fwd, hipFuncAttributeMaxDynamicSharedMemorySize, LDS_BYTES) != hipSuccess) { fprintf(stderr, "kernel_launch: hipFuncSetAttribute failed\n"); grid = -1; return; }
        if (hipOccupancyMaxActiveBlocksPerMultiprocessor(&per_cu, (const void*)hymba_fwd, NWAVES * 64, LDS_BYTES) != hipSuccess || per_cu < 1)
            fprintf(stderr, "kernel_launch: note: occupancy query reports %d workgroups per CU\n", per_cu);
        (void)hipGetLastError();
        grid = cus;
        fprintf(stderr, "kernel_launch: grid %d, ws %zu bytes\n", grid, ws_size);
    }
    if (grid < 0) return;
    if (hipMemsetAsync((char*)d_ws + WS_CTL, 0, CTL_ZERO_BYTES, stream) != hipSuccess) { fprintf(stderr, "kernel_launch: memset failed\n"); return; }
    Args a{};
    a.x = (const float*)d_in[0]; a.p = (const float*)d_in[1]; a.norm_g = (const float*)d_in[2]; a.w_in = (const float*)d_in[3]; a.ret_norm_g = (const float*)d_in[4];
    a.q_norm_g = (const float*)d_in[5]; a.k_norm_g = (const float*)d_in[6]; a.rel_bias = (const float*)d_in[7]; a.w_out = (const float*)d_in[8]; a.w_ple = (const float*)d_in[9];
    a.ple_norm_g = (const float*)d_in[10]; a.w_ple_gate = (const float*)d_in[11]; a.out = (float*)d_out; a.ws = (unsigned char*)d_ws;
    hipLaunchKernelGGL(hymba_fwd, dim3(grid), dim3(NWAVES * 64), LDS_BYTES, stream, a);
    const hipError_t le = hipPeekAtLastError();
    if (le != hipSuccess) fprintf(stderr, "kernel_launch: launch failed: %s\n", hipGetErrorName(le));
}
```

```cpp
#include <hip/hip_runtime.h>
#include <cstdio>
#include <cstdint>

namespace pg8 {
#define PG8_LAS __attribute__((address_space(3)))
typedef unsigned short bf16_t;
typedef short bf16x8 __attribute__((ext_vector_type(8)));
typedef float f32x4 __attribute__((ext_vector_type(4)));
typedef unsigned u32x4 __attribute__((ext_vector_type(4)));
typedef unsigned u32x2 __attribute__((ext_vector_type(2)));
constexpr int BM = 256, BK = 64, HALF = 128, HTB = HALF * BK * 2  , STAGE_BYTES = 8 * HTB, NXCD = 8, WGM = 8;

__host__ __device__ __forceinline__ int lds_byte(int r, int c) { const int st = (r >> 4) * 2 + (c >> 5), rr = r & 15, cc = c & 31, ob = rr * 64 + cc * 2; return st * 1024 + (ob ^ (((ob >> 9) & 1) << 5)); }
__host__ __device__ __forceinline__ void stage_rc(int b, int& R, int& C) { const int st = b / 1024, sb = b % 1024, swz = sb ^ (((sb >> 9) & 1) << 5); R = (st >> 1) * 16 + swz / 64; C = (st & 1) * 32 + (swz % 64) / 2; }
__host__ __device__ __forceinline__ int perm32(int rho) { const int n = rho >> 4, i = rho & 15; return 8 * (i >> 2) + 4 * n + (i & 3); }

struct Unit { int pm, pn; };
struct Gemm { const bf16_t* A; const bf16_t* Bt; int M, N, K, lda; };

struct StaticOrder {
    int nM, nN, nwg, G, c;
    __host__ __device__ void init(int M, int N, int G_, int c_) { nM = M / BM; nN = N / BM; nwg = nM * nN; G = G_; c = c_; }
    __host__ __device__ bool next(int i, Unit& u) const {
        const long L = (long)i * G + c; if (L >= nwg) return false;
        int wgid = (int)L; { const int q = nwg / NXCD, r = nwg % NXCD, xcd = wgid % NXCD, off = wgid / NXCD; wgid = (xcd < r ? xcd * (q + 1) : r * (q + 1) + (xcd - r) * q) + off; }
        const int nig = WGM * nN, gid = wgid / nig, fm = gid * WGM, gsz = (nM - fm) < WGM ? (nM - fm) : WGM;
        u.pm = fm + ((wgid % nig) % gsz); u.pn = (wgid % nig) / gsz; return true;
    }
    __device__ __forceinline__ void a_ready(const Unit&) const {}
    __device__ __forceinline__ void done(const Unit&) const {}
};

struct SubsetOrder {
    StaticOrder S; int kind;
    __host__ __device__ void init(int M, int kind_, int G_, int c_) { kind = kind_; S.init(M, (kind_ == 2 ? 8 : 4) * BM, G_, c_); }
    __host__ __device__ bool next(int i, Unit& u) const {
        if (!S.next(i, u)) return false;
        const int p = u.pn; u.pn = (kind == 0) ? ((p & 1) + 4 * (p >> 1)) : (kind == 1) ? (2 + (p & 1) + 8 * (p >> 1)) : (6 + p + 2 * (p >> 2)); return true;
    }
    __device__ __forceinline__ void a_ready(const Unit&) const {}
    __device__ __forceinline__ void done(const Unit&) const {}
};

typedef float f32x2 __attribute__((ext_vector_type(2)));
typedef __bf16 bf16x2_t __attribute__((ext_vector_type(2)));
__device__ __forceinline__ unsigned pk2(float lo, float hi) { f32x2 v = {lo, hi}; bf16x2_t b = __builtin_convertvector(v, bf16x2_t); return __builtin_bit_cast(unsigned, b); }
__device__ __forceinline__ float bflo(unsigned w) { return __uint_as_float(w << 16); }
__device__ __forceinline__ float bfhi(unsigned w) { return __uint_as_float(w & 0xffff0000u); }
__device__ __forceinline__ float sum16(const float* p) {
    const f32x4 a = *(const f32x4*)p, b = *(const f32x4*)(p + 4), c = *(const f32x4*)(p + 8), d = *(const f32x4*)(p + 12);
    return (((a[0] + a[1]) + (a[2] + a[3])) + ((b[0] + b[1]) + (b[2] + b[3]))) + (((c[0] + c[1]) + (c[2] + c[3])) + ((d[0] + d[1]) + (d[2] + d[3])));
}
constexpr float EPS = 1e-6f;
__device__ __forceinline__ float rowsum16(const float* p16, int fq) {
    const f32x4 a = *(const f32x4*)(p16 + 4 * fq); float s = (a[0] + a[1]) + (a[2] + a[3]);
    s += __shfl_xor(s, 16); s += __shfl_xor(s, 32); return s;
}

template <int KIND  > struct EpiProj {
    static constexpr bool PERM = true, AFTER_DRAIN = false;
    bf16_t* O; int ldc; const float* rss; const float* tab  ; const float* qg; const float* kg; float* kmean  ; PG8_LAS float* xl;
    __device__ __forceinline__ void store8(bf16_t* p, const f32x4& v0, const f32x4& v1) const { u32x4 w; w.x = pk2(v0[0], v0[1]); w.y = pk2(v0[2], v0[3]); w.z = pk2(v1[0], v1[1]); w.w = pk2(v1[2], v1[3]); *(u32x4*)p = w; }
    __device__ __forceinline__ void operator()(const f32x4 (&acc)[2][2][4][2], const Unit& u, int wr, int wc, int fr, int fq) const {
        const int row0 = u.pm * BM + wr * 64 + fr, col0 = u.pn * BM + wc * 32 + 8 * fq;
        const int grp = u.pn >> 1;
        float rstd[2][4];
#pragma unroll
        for (int ai = 0; ai < 2; ++ai)
#pragma unroll
            for (int m = 0; m < 4; ++m) rstd[ai][m] = 1.0f / sqrtf(rowsum16(rss + (size_t)(row0 + ai * HALF + m * 16) * 16, fq) * (1.0f / 1024.0f) + EPS);
        asm volatile("" ::: "memory");
        if constexpr (KIND == 0) {
            const int i0 = 16 * wc + 4 * fq;
            float lg2[2];
#pragma unroll
            for (int bj = 0; bj < 2; ++bj) lg2[bj] = log2f(1.0f - exp2f(-5.0f - (float)(2 * (u.pn & 1) + bj)));
#pragma unroll
            for (int m = 0; m < 4; ++m) { const float jf = (float)(wr * 64 + m * 16 + fr);
                float sc[2];
#pragma unroll
                for (int bj = 0; bj < 2; ++bj) sc[bj] = (grp == 0) ? exp2f(jf * lg2[bj]) : 0.08838834764831845f * exp2f(-jf * lg2[bj]);
#pragma unroll
                for (int ai = 0; ai < 2; ++ai) { const int row = row0 + ai * HALF + m * 16; const int pos = row & 8191;
                    const f32x4* cs = (const f32x4*)(tab + ((size_t)pos * 64 + i0) * 2); const f32x4 cs0 = cs[0], cs1 = cs[1];
                    bf16_t* rowp = O + (size_t)row * ldc + col0;
#pragma unroll
                    for (int bj = 0; bj < 2; ++bj) { const float r = rstd[ai][m]; const f32x4 a0 = acc[ai][bj][m][0] * r, a1 = acc[ai][bj][m][1] * r; const float s = sc[bj];
                        f32x4 v0, v1;
                        v0[0] = (a0[0] * cs0[0] - a0[1] * cs0[1]) * s; v0[1] = (a0[0] * cs0[1] + a0[1] * cs0[0]) * s; v0[2] = (a0[2] * cs0[2] - a0[3] * cs0[3]) * s; v0[3] = (a0[2] * cs0[3] + a0[3] * cs0[2]) * s;
                        v1[0] = (a1[0] * cs1[0] - a1[1] * cs1[1]) * s; v1[1] = (a1[0] * cs1[1] + a1[1] * cs1[0]) * s; v1[2] = (a1[2] * cs1[2] - a1[3] * cs1[3]) * s; v1[3] = (a1[2] * cs1[3] + a1[3] * cs1[2]) * s;
                        store8(rowp + bj * HALF, v0, v1); } }
                asm volatile("" ::: "memory"); }
        } else if constexpr (KIND == 1) {
            PG8_LAS float* P = xl;
#pragma unroll
            for (int ai = 0; ai < 2; ++ai)
#pragma unroll
                for (int m = 0; m < 4; ++m)
#pragma unroll
                    for (int bj = 0; bj < 2; ++bj) { const float r = rstd[ai][m]; const f32x4 a0 = acc[ai][bj][m][0] * r, a1 = acc[ai][bj][m][1] * r;
                        float s = ((a0[0] * a0[0] + a0[1] * a0[1]) + (a0[2] * a0[2] + a0[3] * a0[3])) + ((a1[0] * a1[0] + a1[1] * a1[1]) + (a1[2] * a1[2] + a1[3] * a1[3]));
                        s += __shfl_xor(s, 16); s += __shfl_xor(s, 32);
                        if (fq == 0) P[((ai * HALF + wr * 64 + m * 16 + fr) * 2 + bj) * 4 + wc] = s; }
            asm volatile("s_waitcnt lgkmcnt(0)" ::: "memory"); __builtin_amdgcn_s_barrier(); asm volatile("" ::: "memory");
            const float* gp = ((grp == 1) ? qg : kg) + wc * 32 + 8 * fq; const f32x4 g0 = *(const f32x4*)gp, g1 = *(const f32x4*)(gp + 4);
            const float qs = (grp == 1) ? 0.08838834764831845f : 1.0f;
            f32x4 cs0[2], cs1[2];
#pragma unroll
            for (int bj = 0; bj < 2; ++bj) { cs0[bj] = (f32x4){0.f, 0.f, 0.f, 0.f}; cs1[bj] = (f32x4){0.f, 0.f, 0.f, 0.f}; }
#pragma unroll
            for (int ai = 0; ai < 2; ++ai)
#pragma unroll
                for (int m = 0; m < 4; ++m) { const int row = row0 + ai * HALF + m * 16; bf16_t* rowp = O + (size_t)row * ldc + col0;
#pragma unroll
                    for (int bj = 0; bj < 2; ++bj) { const f32x4 pq = *(const PG8_LAS f32x4*)(P + ((ai * HALF + wr * 64 + m * 16 + fr) * 2 + bj) * 4);
                        const float tot = (pq[0] + pq[1]) + (pq[2] + pq[3]);
                        const float r = rstd[ai][m] * qs / sqrtf(tot * (1.0f / 128.0f) + EPS);
                        const f32x4 v0 = acc[ai][bj][m][0] * r * g0, v1 = acc[ai][bj][m][1] * r * g1;
                        if (grp == 5) { cs0[bj] += v0; cs1[bj] += v1; }
                        store8(rowp + bj * HALF, v0, v1); } }
            if (grp == 5) {
                PG8_LAS float* KS = xl + 2048;
#pragma unroll
                for (int bj = 0; bj < 2; ++bj)
#pragma unroll
                    for (int e = 0; e < 4; ++e) { float a = cs0[bj][e], b = cs1[bj][e];
                        a += __shfl_xor(a, 1); a += __shfl_xor(a, 2); a += __shfl_xor(a, 4); a += __shfl_xor(a, 8);
                        b += __shfl_xor(b, 1); b += __shfl_xor(b, 2); b += __shfl_xor(b, 4); b += __shfl_xor(b, 8);
                        if (fr == 0) { KS[wr * 256 + bj * HALF + wc * 32 + 8 * fq + e] = a; KS[wr * 256 + bj * HALF + wc * 32 + 8 * fq + 4 + e] = b; } }
                asm volatile("s_waitcnt lgkmcnt(0)" ::: "memory"); __builtin_amdgcn_s_barrier(); asm volatile("" ::: "memory");
                const int t = (wr * 4 + wc) * 64 + fq * 16 + fr;
                if (t < 256) { const int b = u.pm >> 5, blk = u.pm & 31, hh = 2 * (u.pn & 1) + (t >> 7);
                    kmean[((size_t)(b * 4 + hh) * 32 + blk) * 128 + (t & 127)] = (KS[t] + KS[256 + t]) * (1.0f / 256.0f); }
            }
            asm volatile("s_waitcnt lgkmcnt(0)" ::: "memory"); __builtin_amdgcn_s_barrier(); asm volatile("" ::: "memory");
        } else {
#pragma unroll
            for (int ai = 0; ai < 2; ++ai)
#pragma unroll
                for (int m = 0; m < 4; ++m) { const int row = row0 + ai * HALF + m * 16; const float r = rstd[ai][m];
                    bf16_t* rowp = O + (size_t)row * ldc + col0;
#pragma unroll
                    for (int bj = 0; bj < 2; ++bj) store8(rowp + bj * HALF, acc[ai][bj][m][0] * r, acc[ai][bj][m][1] * r); }
        }
    }
};
struct EpiE {
    static constexpr bool PERM = true, AFTER_DRAIN = false;
    bf16_t* O; int ldc; float* rs;
    __device__ __forceinline__ void operator()(const f32x4 (&acc)[2][2][4][2], const Unit& u, int wr, int wc, int fr, int fq) const {
        const int row0 = u.pm * BM + wr * 64 + fr, col0 = u.pn * BM + wc * 32 + 8 * fq;
#pragma unroll
        for (int ai = 0; ai < 2; ++ai)
#pragma unroll
            for (int m = 0; m < 4; ++m) { const int row = row0 + ai * HALF + m * 16; float s = 0.f;
                bf16_t* rowp = O + (size_t)row * ldc + col0;
#pragma unroll
                for (int bj = 0; bj < 2; ++bj) { const f32x4 v0 = acc[ai][bj][m][0], v1 = acc[ai][bj][m][1];
                    s += (v0[0] * v0[0] + v0[1] * v0[1]) + (v0[2] * v0[2] + v0[3] * v0[3]); s += (v1[0] * v1[0] + v1[1] * v1[1]) + (v1[2] * v1[2] + v1[3] * v1[3]);
                    u32x4 w; w.x = pk2(v0[0], v0[1]); w.y = pk2(v0[2], v0[3]); w.z = pk2(v1[0], v1[1]); w.w = pk2(v1[2], v1[3]);
                    *(u32x4*)(rowp + bj * HALF) = w; }
                s += __shfl_xor(s, 16); s += __shfl_xor(s, 32);
                if (fq == 0) rs[(size_t)row * 16 + u.pn * 4 + wc] = s; }
    }
};
struct EpiRes {
    static constexpr bool PERM = false, AFTER_DRAIN = false;
    const float* base; float* out; bf16_t* xb; float* rs; int ldc; int ldxb;
    __device__ __forceinline__ void operator()(const f32x4 (&acc)[2][2][4][2], const Unit& u, int wr, int wc, int fr, int fq) const {
        const int row0 = u.pm * BM + wr * 64 + fr, col0 = u.pn * BM + wc * 32 + 4 * fq;
#pragma unroll
        for (int ai = 0; ai < 2; ++ai)
#pragma unroll
            for (int m = 0; m < 4; ++m) { const int row = row0 + ai * HALF + m * 16; float s = 0.f; const size_t off = (size_t)row * ldc + col0, offb = (size_t)row * ldxb + col0;
#pragma unroll
                for (int bj = 0; bj < 2; ++bj)
#pragma unroll
                    for (int n = 0; n < 2; ++n) { const size_t o = off + bj * HALF + n * 16;
                        const f32x4 x = *(const f32x4*)(base + o) + acc[ai][bj][m][n];
                        *(f32x4*)(out + o) = x; s += (x[0] * x[0] + x[1] * x[1]) + (x[2] * x[2] + x[3] * x[3]);
                        u32x2 w; w.x = pk2(x[0], x[1]); w.y = pk2(x[2], x[3]); *(u32x2*)(xb + offb + bj * HALF + n * 16) = w; }
                s += __shfl_xor(s, 16); s += __shfl_xor(s, 32);
                if (fq == 0) rs[(size_t)row * 16 + u.pn * 4 + wc] = s; }
    }
};
struct EpiGate {
    static constexpr bool PERM = false, AFTER_DRAIN = false;
    float* xio; const bf16_t* epre; const float* rs1; const float* rse; const float* pg; bf16_t* xb; float* rso; int ldc;
    __device__ __forceinline__ void operator()(const f32x4 (&acc)[2][2][4][2], const Unit& u, int wr, int wc, int fr, int fq) const {
        const int row0 = u.pm * BM + wr * 64 + fr, col0 = u.pn * BM + wc * 32 + 4 * fq;
#pragma unroll
        for (int ai = 0; ai < 2; ++ai)
#pragma unroll
            for (int m = 0; m < 4; ++m) { const int row = row0 + ai * HALF + m * 16; float s = 0.f; const size_t off = (size_t)row * ldc + col0;
                const float r1 = 1.0f / sqrtf(rowsum16(rs1 + (size_t)row * 16, fq) * (1.0f / 1024.0f) + EPS);
                const float re = 1.0f / sqrtf(rowsum16(rse + (size_t)row * 16, fq) * (1.0f / 1024.0f) + EPS);
#pragma unroll
                for (int bj = 0; bj < 2; ++bj)
#pragma unroll
                    for (int n = 0; n < 2; ++n) { const size_t o = off + bj * HALF + n * 16; const int c = col0 + bj * HALF + n * 16;
                        const f32x4 a = acc[ai][bj][m][n] * r1; const u32x2 ew = *(const u32x2*)(epre + o); const f32x4 g = *(const f32x4*)(pg + c);
                        f32x4 e; e[0] = bflo(ew.x); e[1] = bfhi(ew.x); e[2] = bflo(ew.y); e[3] = bfhi(ew.y); e = e * re * g;
                        f32x4 sg; sg[0] = 1.0f / (1.0f + __expf(-a[0])); sg[1] = 1.0f / (1.0f + __expf(-a[1])); sg[2] = 1.0f / (1.0f + __expf(-a[2])); sg[3] = 1.0f / (1.0f + __expf(-a[3]));
                        const f32x4 x = *(const f32x4*)(xio + o) + sg * e;
                        *(f32x4*)(xio + o) = x; s += (x[0] * x[0] + x[1] * x[1]) + (x[2] * x[2] + x[3] * x[3]);
                        u32x2 w; w.x = pk2(x[0], x[1]); w.y = pk2(x[2], x[3]); *(u32x2*)(xb + o) = w; }
                s += __shfl_xor(s, 16); s += __shfl_xor(s, 32);
                if (fq == 0) rso[(size_t)row * 16 + u.pn * 4 + wc] = s; }
    }
};

template <class Epi, class Sched, bool ALIGN_EPI = false, bool SP2 = false>
__device__ __forceinline__ void gemm_phase(PG8_LAS unsigned char* lds, const Gemm g, const Sched& S, const Epi& E) {
    int tid = threadIdx.x; asm volatile("" : "+v"(tid));
    const int wid = __builtin_amdgcn_readfirstlane(tid >> 6), lane = tid & 63, wr = wid >> 2, wc = wid & 3, fr = lane & 15, fq = lane >> 4;
    const int K = g.K, lda = g.lda, nt = K / BK;
    unsigned voffA[2], voffB[2];
#pragma unroll
    for (int i = 0; i < 2; ++i) { int R, C; stage_rc(tid * 16 + i * 8192, R, C); const int Rb = Epi::PERM ? ((R & ~31) + perm32(R & 31)) : R;
        voffA[i] = (unsigned)(R * lda + C) * 2u; voffB[i] = (unsigned)(Rb * K + C) * 2u; }
    const size_t kstep = (size_t)(BK * 2);
    const size_t hstepB = (size_t)HALF * K * 2, hstepA = (size_t)HALF * lda * 2;
    const size_t tstepB = 2 * hstepB, tstepA = 2 * hstepA;
    const unsigned ldsw = (unsigned)wid * 1024u;
    const int aoff = lds_byte(wr * 64 + fr, fq * 8), boff = lds_byte(wc * 32 + fr, fq * 8);
#define PG8_SA(b, h) (((b) * 2 + (h)) * HTB)
#define PG8_SB(b, h) ((4 + (b) * 2 + (h)) * HTB)
#define PG8_STAGE(bufoff, gbase, voff) do { _Pragma("unroll") for (int _i = 0; _i < 2; ++_i) \
        __builtin_amdgcn_global_load_lds((const unsigned*)((const char*)(gbase) + (voff)[_i]), (PG8_LAS unsigned*)(lds + (bufoff) + ldsw + _i * 8192), 16, 0, 0); } while (0)
#define PG8_LDA(dst, b, h) do { _Pragma("unroll") for (int m = 0; m < 4; ++m) _Pragma("unroll") for (int k = 0; k < 2; ++k) dst[m][k] = *(const PG8_LAS bf16x8*)(lds + PG8_SA(b, h) + aoff + m * 2048 + k * 1024); } while (0)
#define PG8_LDB(dst, b, h) do { _Pragma("unroll") for (int n = 0; n < 2; ++n) _Pragma("unroll") for (int k = 0; k < 2; ++k) dst[n][k] = *(const PG8_LAS bf16x8*)(lds + PG8_SB(b, h) + boff + n * 2048 + k * 1024); } while (0)
#define PG8_MMA(ai, bj, At, Bt) do { __builtin_amdgcn_s_setprio(1); _Pragma("unroll") for (int m = 0; m < 4; ++m) _Pragma("unroll") for (int n = 0; n < 2; ++n) _Pragma("unroll") for (int k = 0; k < 2; ++k) \
        acc[ai][bj][m][n] = __builtin_amdgcn_mfma_f32_16x16x32_bf16(Bt[n][k], At[m][k], acc[ai][bj][m][n], 0, 0, 0); __builtin_amdgcn_s_setprio(0); } while (0)
#define PG8_WAIT_V(n) asm volatile("s_waitcnt vmcnt(" #n ")" ::: "memory")
#define PG8_WAIT_L(n) asm volatile("s_waitcnt lgkmcnt(" #n ")" ::: "memory")
#define PG8_BAR __builtin_amdgcn_s_barrier()
#define PG8_SCHED __builtin_amdgcn_sched_barrier(0)
    Unit cur, nxt; int ui = 0;
    if (!S.next(0, cur)) return;
    f32x4 acc[2][2][4][2];
#pragma unroll
    for (int a = 0; a < 2; ++a)
#pragma unroll
        for (int b = 0; b < 2; ++b)
#pragma unroll
            for (int m = 0; m < 4; ++m)
#pragma unroll
                for (int n = 0; n < 2; ++n) acc[a][b][m][n] = (f32x4){0.f, 0.f, 0.f, 0.f};
    bf16x8 At[4][2], B0[2][2], B1[2][2];
    const char* cA = (const char*)g.A + (size_t)cur.pm * tstepA; const char* cB = (const char*)g.Bt + (size_t)cur.pn * tstepB;
    S.a_ready(cur);
    if constexpr (SP2) {
        PG8_STAGE(PG8_SB(0, 0), cB, voffB); PG8_STAGE(PG8_SB(0, 1), cB + hstepB, voffB); PG8_STAGE(PG8_SA(0, 0), cA, voffA); PG8_STAGE(PG8_SA(0, 1), cA + hstepA, voffA);
        if (wr == 1) PG8_BAR;
        PG8_WAIT_V(2); PG8_BAR;
        PG8_STAGE(PG8_SB(1, 0), cB + kstep, voffB); PG8_STAGE(PG8_SA(1, 0), cA + kstep, voffA); PG8_STAGE(PG8_SB(1, 1), cB + hstepB + kstep, voffB);
        PG8_WAIT_V(6); PG8_BAR;
    } else {
        PG8_STAGE(PG8_SB(0, 0), cB, voffB); PG8_STAGE(PG8_SA(0, 0), cA, voffA); PG8_STAGE(PG8_SB(0, 1), cB + hstepB, voffB); PG8_STAGE(PG8_SA(0, 1), cA + hstepA, voffA);
        if (wr == 1) PG8_BAR;
        PG8_WAIT_V(4); PG8_BAR;
        PG8_STAGE(PG8_SB(1, 0), cB + kstep, voffB); PG8_STAGE(PG8_SA(1, 0), cA + kstep, voffA); PG8_STAGE(PG8_SB(1, 1), cB + hstepB + kstep, voffB);
        PG8_WAIT_V(6); PG8_BAR;
    }
    for (;;) {
        const bool has_next = S.next(ui + 1, nxt);
        const char* nA = has_next ? (const char*)g.A + (size_t)nxt.pm * tstepA : cA; const char* nB = has_next ? (const char*)g.Bt + (size_t)nxt.pn * tstepB : cB;
#pragma nounroll
        for (int t = 0; t < nt; t += 2) {
            const bool last = (t == nt - 2);
            const char* a1 = cA + (size_t)(t + 1) * kstep;
            const char* a2 = last ? nA : cA + (size_t)(t + 2) * kstep; const char* b2 = last ? nB : cB + (size_t)(t + 2) * kstep;
            const char* a3 = a2 + kstep; const char* b3 = b2 + kstep;
            if (last && has_next) S.a_ready(nxt);
            if constexpr (SP2) {
            PG8_LDB(B0, 0, 0); PG8_LDB(B1, 0, 1); PG8_SCHED; PG8_LDA(At, 0, 0); PG8_STAGE(PG8_SA(1, 1), a1 + hstepA, voffA);
            PG8_WAIT_V(8); PG8_WAIT_L(0); PG8_BAR; PG8_MMA(0, 0, At, B0); PG8_MMA(0, 1, At, B1); PG8_BAR; PG8_SCHED;
            PG8_LDA(At, 0, 1); PG8_STAGE(PG8_SB(0, 0), b2, voffB); PG8_STAGE(PG8_SB(0, 1), b2 + hstepB, voffB); PG8_STAGE(PG8_SA(0, 0), a2, voffA);
            PG8_WAIT_V(8); PG8_WAIT_L(0); PG8_BAR; PG8_MMA(1, 0, At, B0); PG8_MMA(1, 1, At, B1); PG8_BAR; PG8_SCHED;
            PG8_LDB(B0, 1, 0); PG8_LDB(B1, 1, 1); PG8_SCHED; PG8_LDA(At, 1, 0); PG8_STAGE(PG8_SA(0, 1), a2 + hstepA, voffA);
            PG8_WAIT_V(8); PG8_WAIT_L(0); PG8_BAR; PG8_MMA(0, 0, At, B0); PG8_MMA(0, 1, At, B1); PG8_BAR; PG8_SCHED;
            PG8_LDA(At, 1, 1); PG8_STAGE(PG8_SB(1, 0), b3, voffB); PG8_STAGE(PG8_SB(1, 1), b3 + hstepB, voffB); PG8_STAGE(PG8_SA(1, 0), a3, voffA);
            PG8_WAIT_V(8); PG8_WAIT_L(0); PG8_BAR; PG8_MMA(1, 0, At, B0); PG8_MMA(1, 1, At, B1); PG8_BAR; PG8_SCHED;
            } else {
            PG8_LDB(B0, 0, 0); PG8_SCHED; PG8_LDA(At, 0, 0); PG8_STAGE(PG8_SA(1, 1), a1 + hstepA, voffA);
            PG8_WAIT_L(8); PG8_BAR; PG8_WAIT_L(0); PG8_MMA(0, 0, At, B0); PG8_BAR; PG8_SCHED;
            PG8_LDB(B1, 0, 1); PG8_STAGE(PG8_SB(0, 0), b2, voffB);
            PG8_BAR; PG8_WAIT_L(0); PG8_MMA(0, 1, At, B1); PG8_BAR;
            PG8_LDA(At, 0, 1); PG8_STAGE(PG8_SA(0, 0), a2, voffA);
            PG8_BAR; PG8_WAIT_L(0); PG8_MMA(1, 0, At, B0); PG8_BAR; PG8_SCHED;
            PG8_STAGE(PG8_SB(0, 1), b2 + hstepB, voffB);
            PG8_WAIT_V(6); PG8_BAR; PG8_MMA(1, 1, At, B1); PG8_BAR;
            PG8_LDB(B0, 1, 0); PG8_SCHED; PG8_LDA(At, 1, 0); PG8_STAGE(PG8_SA(0, 1), a2 + hstepA, voffA);
            PG8_WAIT_L(8); PG8_BAR; PG8_WAIT_L(0); PG8_MMA(0, 0, At, B0); PG8_BAR; PG8_SCHED;
            PG8_LDB(B1, 1, 1); PG8_STAGE(PG8_SB(1, 0), b3, voffB);
            PG8_BAR; PG8_WAIT_L(0); PG8_MMA(0, 1, At, B1); PG8_BAR;
            PG8_LDA(At, 1, 1); PG8_STAGE(PG8_SA(1, 0), a3, voffA);
            PG8_BAR; PG8_WAIT_L(0); PG8_MMA(1, 0, At, B0); PG8_BAR; PG8_SCHED;
            PG8_STAGE(PG8_SB(1, 1), b3 + hstepB, voffB);
            PG8_WAIT_V(6); PG8_BAR; PG8_MMA(1, 1, At, B1); PG8_BAR;
            }
        }
        if constexpr (ALIGN_EPI) { if (wr == 0) PG8_BAR; }
        if constexpr (!Epi::AFTER_DRAIN) { E(acc, cur, wr, wc, fr, fq); S.done(cur); }
        if (!has_next) break;
#pragma unroll
        for (int a = 0; a < 2; ++a)
#pragma unroll
            for (int b = 0; b < 2; ++b)
#pragma unroll
                for (int m = 0; m < 4; ++m)
#pragma unroll
                    for (int n = 0; n < 2; ++n) acc[a][b][m][n] = (f32x4){0.f, 0.f, 0.f, 0.f};
        cur = nxt; cA = nA; cB = nB; ++ui;
        if constexpr (ALIGN_EPI) { if (wr == 1) PG8_BAR; }
    }
    PG8_WAIT_V(0);
    if constexpr (!ALIGN_EPI) { if (wr == 0) PG8_BAR; }
    PG8_BAR;
    if constexpr (Epi::AFTER_DRAIN) { E.fused(acc, cur, wr, wc, fr, fq, lds, wid, lane); S.done(cur); }
#undef PG8_SA
#undef PG8_SB
#undef PG8_STAGE
#undef PG8_LDA
#undef PG8_LDB
#undef PG8_MMA
#undef PG8_WAIT_V
#undef PG8_WAIT_L
#undef PG8_BAR
#undef PG8_SCHED
}
}

constexpr int NWAVES = 8;
constexpr int DM = 1024, SEQ = 8192, NBATCH = 4, M = NBATCH * SEQ, INW = 4096, PLE = 256, DEPTH = 2, HD = 128, NH = 4, NBLK = 32  , NCH = 64  ;
constexpr int C_RQ = 0, C_MQ = 512, C_RK = 1024, C_RV = 1536, C_RZ = 2048, C_MK = 2560, C_MV = 3072, C_MZ = 3584;
constexpr int C_X1B = 1024;
constexpr float RSQRT_HD = 0.08838834764831845f;

constexpr size_t MiB = 1u << 20;
constexpr size_t WS_CTL = 0, CTL_ZERO_BYTES = 1 * MiB;
constexpr size_t WS_WIN = 1 * MiB;
constexpr size_t WS_WOUT = 17 * MiB;
constexpr size_t WS_WG = 21 * MiB;
constexpr size_t WS_WPLE = 25 * MiB;
constexpr size_t WS_TAB = 26 * MiB;
constexpr size_t WS_LUT = 30 * MiB;
constexpr size_t WS_KMEAN = 30 * MiB + 128 * 1024;
constexpr size_t WS_SEL = 30 * MiB + 512 * 1024;
constexpr size_t WS_RSX = 31 * MiB;
constexpr size_t WS_RSX1 = 33 * MiB;
constexpr size_t WS_RSE = 35 * MiB;
constexpr size_t WS_PE = 37 * MiB;
constexpr size_t WS_KV = 53 * MiB;
constexpr size_t WS_EPRE = 85 * MiB;
constexpr size_t WS_XB = 149 * MiB;
constexpr size_t WS_PROJ = 245 * MiB;
constexpr size_t WS_END = 501 * MiB;
constexpr int CW_BAR = 4096;

constexpr int RING_OFF = 0, RING_BYTES = 131072;
constexpr int LDSCTL_OFF = 143360, MISC_OFF = LDSCTL_OFF + 320;
constexpr int LDS_BYTES = 147456;

#define GAS __attribute__((address_space(1)))
#define LAS __attribute__((address_space(3)))
typedef unsigned short bf16;
typedef unsigned v4u __attribute__((ext_vector_type(4)));
typedef unsigned v2u __attribute__((ext_vector_type(2)));
typedef float f32x4 __attribute__((ext_vector_type(4)));
typedef float f32x2v __attribute__((ext_vector_type(2)));
typedef GAS unsigned gu32;
#define RLX_AGENT __ATOMIC_RELAXED, __HIP_MEMORY_SCOPE_AGENT
#define LDS_WAIT() asm volatile("s_waitcnt lgkmcnt(0)" ::: "memory")
#define VM_WAIT() asm volatile("s_waitcnt vmcnt(0)" ::: "memory")
using pg8::pk2; using pg8::bflo; using pg8::bfhi;
__device__ __forceinline__ float bf2f(unsigned short u) { return __uint_as_float(((unsigned)u) << 16); }
#define XB_TMO      128
#define XB_XCNT(j)  (256  + 64 * (j))
#define XB_XSUB(j)  (1280 + 64 * (j))
#define XB_XGEN(j)  (2304 + 64 * (j))
#define XB_TOP      3328
#define XB_TOPGEN   3392
#define XCD_BAR_WORDS 3456
#define XB_SPIN_CAP (1u << 18)

__device__ __forceinline__ unsigned xb_ld(unsigned* p)              { return __hip_atomic_load(p, __ATOMIC_RELAXED, __HIP_MEMORY_SCOPE_AGENT); }
__device__ __forceinline__ unsigned xb_add(unsigned* p, unsigned v) { return __hip_atomic_fetch_add(p, v, __ATOMIC_RELAXED, __HIP_MEMORY_SCOPE_AGENT); }
__device__ __forceinline__ unsigned xb_xcc_id() { return (unsigned)__builtin_amdgcn_s_getreg((3 << 11) | 20) & 0xFu; }
#define XB_SPIN(cond, bar) do { unsigned _sp = 0; while (cond) { __builtin_amdgcn_s_sleep(1); \
    if ((++_sp & 255u) == 0u) { if (xb_ld(&(bar)[XB_TMO])) break; if (_sp > XB_SPIN_CAP) { atomicAdd(&(bar)[XB_TMO], 1u); break; } } } } while (0)

struct XcdBarrier {
    unsigned* bar; unsigned x;
    volatile LAS unsigned* st;
};

__device__ __forceinline__ XcdBarrier xcd_barrier_post(unsigned* bar, volatile LAS unsigned* st) {
    XcdBarrier b; b.bar = bar; b.x = xb_xcc_id(); b.st = st;
    if (threadIdx.x == 0) (void)xb_add(&bar[XB_XCNT(b.x)], 1u);
    return b;
}
__device__ __forceinline__ void xcd_barrier_complete(unsigned* bar, unsigned x, unsigned& nloc, unsigned& nx) {
    const unsigned G = gridDim.x * gridDim.y * gridDim.z;
    unsigned sum, cnt, mine, sp = 0u;
    for (;;) {
        sum = 0u; cnt = 0u; mine = 0u;
#pragma nounroll
        for (unsigned j = 0; j < 16; ++j) { const unsigned c = xb_ld(&bar[XB_XCNT(j)]); sum += c; cnt += (c > 0u) ? 1u : 0u; mine = (j == x) ? c : mine; }
        if (sum == G) break;
        __builtin_amdgcn_s_sleep(1);
        if ((++sp & 255u) == 0u) { if (xb_ld(&bar[XB_TMO])) break; if (sp > XB_SPIN_CAP) { atomicAdd(&bar[XB_TMO], 1u); break; } }
    }
    nloc = mine > 0u ? mine : 1u; nx = cnt > 0u ? cnt : 1u;
}

__device__ __forceinline__ void xcd_barrier(const XcdBarrier& b) {
    asm volatile("s_waitcnt vmcnt(0)" ::: "memory");
    __syncthreads();
    if (threadIdx.x == 0) {
        unsigned* bar = b.bar;
        __builtin_amdgcn_s_waitcnt(0);
        unsigned nloc = b.st[0], nx = b.st[1];
        if (nloc == 0u) { xcd_barrier_complete(bar, b.x, nloc, nx); b.st[0] = nloc; b.st[1] = nx; }
        const unsigned old = xb_add(&bar[XB_XSUB(b.x)], 1u);
        const unsigned gen = old / nloc;
        if (old + 1u == (gen + 1u) * nloc) {
            __builtin_amdgcn_fence(__ATOMIC_RELEASE, "agent");
            asm volatile("s_waitcnt vmcnt(0)" ::: "memory");
            const unsigned og = xb_add(&bar[XB_TOP], 1u);
            const unsigned tg = og / nx;
            if (og + 1u == (tg + 1u) * nx) xb_add(&bar[XB_TOPGEN], 1u);
            else XB_SPIN(xb_ld(&bar[XB_TOPGEN]) == tg, bar);
            __builtin_amdgcn_fence(__ATOMIC_ACQUIRE, "agent");
            xb_add(&bar[XB_XGEN(b.x)], 1u);
            asm volatile("s_waitcnt vmcnt(0)" ::: "memory");
        } else {
            XB_SPIN(xb_ld(&bar[XB_XGEN(b.x)]) == gen, bar);
            __builtin_amdgcn_fence(__ATOMIC_ACQUIRE, "agent");
            asm volatile("s_waitcnt vmcnt(0)" ::: "memory");
        }
    }
    __syncthreads();
}

__device__ __forceinline__ float wave_sum(float v) {
#pragma unroll
    for (int o = 1; o < 64; o <<= 1) v += __shfl_xor(v, o);
    return v;
}
__device__ __forceinline__ float wave_max(float v) {
#pragma unroll
    for (int o = 1; o < 64; o <<= 1) v = fmaxf(v, __shfl_xor(v, o));
    return v;
}
__device__ __forceinline__ float ret_log2g(int h) { return log2f(1.0f - exp2f(-5.0f - (float)h)); }

__device__ __forceinline__ int win_dst(int c) {
    const int g = c >> 9, w = c & 511, hd = w >> 7, i = w & 127;
    const int base = (g == 0) ? C_RQ : (g == 1) ? C_RK : (g == 2) ? C_RV : (g == 3) ? C_RZ : (g == 4) ? C_MQ : (g == 5) ? C_MK : (g == 6) ? C_MV : C_MZ;
    const int pos = (g <= 1) ? ((i < 64) ? 2 * i : 2 * (i - 64) + 1) : i;
    return base + hd * 128 + pos;
}
template <int MODE>
__device__ __forceinline__ void p0_transpose_item(const float* W, int K, int N, bf16* WT, const float* gk, LAS float* scr, int item, int lane) {
    const int nblk = N / 32, kb = item / nblk, nb = item % nblk, k0 = 64 * kb, n0 = 32 * nb;
#pragma unroll 8
    for (int i = 0; i < 32; ++i) { const int kk = 2 * i + (lane >> 5); float v = W[(size_t)(k0 + kk) * N + n0 + (lane & 31)]; if (MODE == 1) v *= gk[k0 + kk]; scr[kk * 33 + (lane & 31)] = v; }
    LDS_WAIT(); asm volatile("" ::: "memory");
    const int c = lane & 7;
#pragma unroll
    for (int j = 0; j < 4; ++j) { const int n = (lane >> 3) + 8 * j; const LAS float* s = scr + (8 * c) * 33 + n;
        v4u o; o.x = pk2(s[0 * 33], s[1 * 33]); o.y = pk2(s[2 * 33], s[3 * 33]); o.z = pk2(s[4 * 33], s[5 * 33]); o.w = pk2(s[6 * 33], s[7 * 33]);
        const int dst = (MODE == 1) ? win_dst(n0 + n) : (n0 + n);
        *(v4u*)(WT + (size_t)dst * K + k0 + 8 * c) = o; }
    LDS_WAIT(); asm volatile("" ::: "memory");
}
__device__ __forceinline__ void x_row_to_bf16(const float* xrow, bf16* orow, float* rs16, int lane) {
    const f32x4* xr = (const f32x4*)xrow + lane;
    f32x4 v[4]; float s = 0.f;
#pragma unroll
    for (int j = 0; j < 4; ++j) { v[j] = xr[64 * j]; s += (v[j][0] * v[j][0] + v[j][1] * v[j][1]) + (v[j][2] * v[j][2] + v[j][3] * v[j][3]); }
    s = wave_sum(s);
    v2u* o8 = (v2u*)orow + lane;
#pragma unroll
    for (int j = 0; j < 4; ++j) { v2u w; w.x = pk2(v[j][0], v[j][1]); w.y = pk2(v[j][2], v[j][3]); o8[64 * j] = w; }
    if (lane < 16) rs16[lane] = (lane == 0) ? s : 0.f;
}
__device__ __forceinline__ void cvt_f32_bf16(const float* src, bf16* dst, long n8, long gtid, long gthreads) {
    for (long i = gtid; i < n8; i += gthreads) {
        const f32x4 a = *(const f32x4*)(src + i * 8), b = *(const f32x4*)(src + i * 8 + 4);
        v4u w; w.x = pk2(a[0], a[1]); w.y = pk2(a[2], a[3]); w.z = pk2(b[0], b[1]); w.w = pk2(b[2], b[3]);
        *(v4u*)(dst + i * 8) = w; }
}
__device__ __forceinline__ void sincos_d(double a, double& s, double& c) {
    const double k = rint(a * 0.63661977236758134308);
    double r = fma(-k, 1.57079632679489655800e+00, a); r = fma(-k, 6.12323399573676603587e-17, r);
    const double r2 = r * r;
    double sp = 1.0 / 6227020800.0; sp = fma(sp, r2, -1.0 / 39916800.0); sp = fma(sp, r2, 1.0 / 362880.0); sp = fma(sp, r2, -1.0 / 5040.0); sp = fma(sp, r2, 1.0 / 120.0); sp = fma(sp, r2, -1.0 / 6.0); sp = fma(sp * r2, r, r);
    double cp = 1.0 / 87178291200.0; cp = fma(cp, r2, -1.0 / 479001600.0); cp = fma(cp, r2, 1.0 / 3628800.0); cp = fma(cp, r2, -1.0 / 40320.0); cp = fma(cp, r2, 1.0 / 720.0); cp = fma(cp, r2, -1.0 / 24.0); cp = fma(cp, r2, 0.5); cp = fma(-cp, r2, 1.0);
    const int q = ((int)k) & 3;
    s = (q == 0) ? sp : (q == 1) ? cp : (q == 2) ? -sp : -cp;
    c = (q == 0) ? cp : (q == 1) ? -sp : (q == 2) ? -cp : sp;
}
__device__ __forceinline__ int t5_bucket(int n) {
    if (n < 16) return n;
    const float v = logf((float)n * (1.0f / 16.0f)) / 4.852030263919617f * 16.0f;
    int b = 16 + (int)v; return b > 31 ? 31 : b;
}

struct Args {
    const float* x; const float* p; const float* norm_g; const float* w_in; const float* ret_norm_g; const float* q_norm_g; const float* k_norm_g; const float* rel_bias;
    const float* w_out; const float* w_ple; const float* ple_norm_g; const float* w_ple_gate; float* out; unsigned char* ws;
};
typedef const __attribute__((address_space(4))) Args* KA;
__device__ __forceinline__ KA get_ka() { KA p = (KA)__builtin_amdgcn_kernarg_segment_ptr(); asm volatile("" : "+s"(p)); return p; }
#define PHASE_IDS() int tid = threadIdx.x; asm volatile("" : "+v"(tid)); const int lane = tid & 63; const int wave = __builtin_amdgcn_readfirstlane(tid >> 6); \
    int bx_ = blockIdx.x; asm volatile("" : "+s"(bx_)); const int G = gridDim.x; const int vcu = (G % 8 == 0) ? (bx_ % 8) * (G / 8) + bx_ / 8 : bx_; (void)lane; (void)wave; (void)vcu

__device__ __forceinline__ void p0_prologue(KA A, LAS unsigned char* lds) {
    PHASE_IDS();
    unsigned char* ws = A->ws;
    LAS float* scr = (LAS float*)(lds + RING_OFF + wave * 16384);
    const int gw = vcu * NWAVES + wave, NGW = G * NWAVES;
    constexpr int I_IN = (DM / 64) * (INW / 32), I_O = (DM / 64) * (DM / 32), I_G = I_O, I_P = (PLE / 64) * (DM / 32), I_L = I_IN + I_O + I_G + I_P;
    for (int it = gw; it < DEPTH * I_L; it += NGW) {
        const int L = it / I_L; int r = it % I_L;
        if (r < I_IN) { p0_transpose_item<1>(A->w_in + (size_t)L * DM * INW, DM, INW, (bf16*)(ws + WS_WIN) + (size_t)L * INW * DM, A->norm_g + L * DM, scr, r, lane); continue; } r -= I_IN;
        if (r < I_O) { p0_transpose_item<0>(A->w_out + (size_t)L * DM * DM, DM, DM, (bf16*)(ws + WS_WOUT) + (size_t)L * DM * DM, nullptr, scr, r, lane); continue; } r -= I_O;
        if (r < I_G) { p0_transpose_item<0>(A->w_ple_gate + (size_t)L * DM * DM, DM, DM, (bf16*)(ws + WS_WG) + (size_t)L * DM * DM, nullptr, scr, r, lane); continue; } r -= I_G;
        p0_transpose_item<0>(A->w_ple + (size_t)L * PLE * DM, PLE, DM, (bf16*)(ws + WS_WPLE) + (size_t)L * DM * PLE, nullptr, scr, r, lane);
    }
    for (int m = gw; m < M; m += NGW) x_row_to_bf16(A->x + (size_t)m * DM, (bf16*)(ws + WS_XB) + (size_t)m * DM, (float*)(ws + WS_RSX) + (size_t)m * 16, lane);
    const long gtid = (long)vcu * (NWAVES * 64) + tid, gthreads = (long)G * NWAVES * 64;
    cvt_f32_bf16(A->p, (bf16*)(ws + WS_PE), (long)M * PLE / 8, gtid, gthreads);
    for (long i = gtid; i < (long)SEQ * 64; i += gthreads) {
        const int pos = (int)(i >> 6), fi = (int)(i & 63);
        const float inv = (float)exp2(-(double)fi * (1.0 / 64.0) * 13.287712379549449);
        const float ang = (float)pos * inv;
        double s, c; sincos_d((double)ang, s, c);
        ((f32x2v*)(ws + WS_TAB))[i] = (f32x2v){(float)c, (float)s};
    }
    for (long i = gtid; i < (long)NH * SEQ; i += gthreads) {
        const int h = (int)(i >> 13), n = (int)(i & 8191);
        ((float*)(ws + WS_LUT))[i] = A->rel_bias[t5_bucket(n) * NH + h];
    }
}

__device__ __forceinline__ void p1b_rowops(KA A, int L) {
    PHASE_IDS();
    unsigned char* ws = A->ws; bf16* PROJ = (bf16*)(ws + WS_PROJ);
    const int gw = vcu * NWAVES + wave, NGW = G * NWAVES;
    const int hd = lane >> 4, i0 = (lane & 15) * 4;
    const float lg2 = ret_log2g(hd);
    const float* qg = A->q_norm_g + L * HD + (lane & 15) * 8; const float* kg = A->k_norm_g + L * HD + (lane & 15) * 8;
    const f32x4 qg0 = *(const f32x4*)qg, qg1 = *(const f32x4*)(qg + 4), kg0 = *(const f32x4*)kg, kg1 = *(const f32x4*)(kg + 4);
    for (int t = gw; t < M; t += NGW) {
        const int pos = t & (SEQ - 1), j = pos & 127;
        bf16* row = PROJ + (size_t)t * INW;
        const f32x4* cs = (const f32x4*)((const f32x2v*)(ws + WS_TAB) + (size_t)pos * 64 + i0);
        const f32x4 cs0 = cs[0], cs1 = cs[1];
        const float gq = exp2f((float)j * lg2), gk = RSQRT_HD * exp2f(-(float)j * lg2);
        {   v4u w = *(v4u*)(row + C_RQ + 8 * lane);
            float a, b;
            a = bflo(w.x); b = bfhi(w.x); w.x = pk2((a * cs0[0] - b * cs0[1]) * gq, (a * cs0[1] + b * cs0[0]) * gq);
            a = bflo(w.y); b = bfhi(w.y); w.y = pk2((a * cs0[2] - b * cs0[3]) * gq, (a * cs0[3] + b * cs0[2]) * gq);
            a = bflo(w.z); b = bfhi(w.z); w.z = pk2((a * cs1[0] - b * cs1[1]) * gq, (a * cs1[1] + b * cs1[0]) * gq);
            a = bflo(w.w); b = bfhi(w.w); w.w = pk2((a * cs1[2] - b * cs1[3]) * gq, (a * cs1[3] + b * cs1[2]) * gq);
            *(v4u*)(row + C_RQ + 8 * lane) = w; }
        {   v4u w = *(v4u*)(row + C_RK + 8 * lane);
            float a, b;
            a = bflo(w.x); b = bfhi(w.x); w.x = pk2((a * cs0[0] - b * cs0[1]) * gk, (a * cs0[1] + b * cs0[0]) * gk);
            a = bflo(w.y); b = bfhi(w.y); w.y = pk2((a * cs0[2] - b * cs0[3]) * gk, (a * cs0[3] + b * cs0[2]) * gk);
            a = bflo(w.z); b = bfhi(w.z); w.z = pk2((a * cs1[0] - b * cs1[1]) * gk, (a * cs1[1] + b * cs1[0]) * gk);
            a = bflo(w.w); b = bfhi(w.w); w.w = pk2((a * cs1[2] - b * cs1[3]) * gk, (a * cs1[3] + b * cs1[2]) * gk);
            *(v4u*)(row + C_RK + 8 * lane) = w; }
        {   v4u w = *(v4u*)(row + C_MQ + 8 * lane);
            float v[8] = {bflo(w.x), bfhi(w.x), bflo(w.y), bfhi(w.y), bflo(w.z), bfhi(w.z), bflo(w.w), bfhi(w.w)};
            float ss = 0.f;
#pragma unroll
            for (int e = 0; e < 8; ++e) ss += v[e] * v[e];
            ss += __shfl_xor(ss, 1); ss += __shfl_xor(ss, 2); ss += __shfl_xor(ss, 4); ss += __shfl_xor(ss, 8);
            const float r = RSQRT_HD / sqrtf(ss * (1.0f / 128.0f) + pg8::EPS);
            w.x = pk2(v[0] * r * qg0[0], v[1] * r * qg0[1]); w.y = pk2(v[2] * r * qg0[2], v[3] * r * qg0[3]); w.z = pk2(v[4] * r * qg1[0], v[5] * r * qg1[1]); w.w = pk2(v[6] * r * qg1[2], v[7] * r * qg1[3]);
            *(v4u*)(row + C_MQ + 8 * lane) = w; }
        {   v4u w = *(v4u*)(row + C_MK + 8 * lane);
            float v[8] = {bflo(w.x), bfhi(w.x), bflo(w.y), bfhi(w.y), bflo(w.z), bfhi(w.z), bflo(w.w), bfhi(w.w)};
            float ss = 0.f;
#pragma unroll
            for (int e = 0; e < 8; ++e) ss += v[e] * v[e];
            ss += __shfl_xor(ss, 1); ss += __shfl_xor(ss, 2); ss += __shfl_xor(ss, 4); ss += __shfl_xor(ss, 8);
            const float r = 1.0f / sqrtf(ss * (1.0f / 128.0f) + pg8::EPS);
            w.x = pk2(v[0] * r * kg0[0], v[1] * r * kg0[1]); w.y = pk2(v[2] * r * kg0[2], v[3] * r * kg0[3]); w.z = pk2(v[4] * r * kg1[0], v[5] * r * kg1[1]); w.w = pk2(v[6] * r * kg1[2], v[7] * r * kg1[3]);
            *(v4u*)(row + C_MK + 8 * lane) = w; }
    }
}

__device__ __forceinline__ void p2_kmean(KA A) {
    PHASE_IDS();
    unsigned char* ws = A->ws; const bf16* PROJ = (const bf16*)(ws + WS_PROJ); float* KM = (float*)(ws + WS_KMEAN);
    for (int idx = vcu * (NWAVES * 64) + tid; idx < 16 * NBLK * HD; idx += G * NWAVES * 64) {
        const int bh = idx >> 12, blk = (idx >> 7) & 31, col = idx & 127, b = bh >> 2, h = bh & 3;
        const bf16* src = PROJ + (size_t)(b * SEQ + blk * 256) * INW + C_MK + h * HD + col;
        float s = 0.f;
#pragma unroll 8
        for (int r = 0; r < 256; ++r) s += bf2f(src[(size_t)r * INW]);
        KM[idx] = s * (1.0f / 256.0f);
    }
}
static_assert(4 * 128 * 272 <= LDSCTL_OFF, "retention tiles must stay below the LDS control words");
constexpr int TROW = 272;
__device__ __forceinline__ void stage_tile128(const bf16* g, size_t ld, unsigned char* dst, int tid) {
#pragma unroll
    for (int i = 0; i < 4; ++i) { const int ch = tid + i * 512, r = ch >> 4, c = ch & 15;
        *(v4u*)(dst + r * TROW + c * 16) = *(const v4u*)(g + (size_t)r * ld + c * 8); }
}
__device__ __forceinline__ void p2_kvsum(KA A, unsigned char* lds) {
    PHASE_IDS();
    unsigned char* ws = A->ws; const bf16* PROJ = (const bf16*)(ws + WS_PROJ); bf16* ST = (bf16*)(ws + WS_KV);
    unsigned char* Kt = lds; unsigned char* Vt = lds + 128 * TROW;
    const int e = tid >> 2, dp = tid & 3;
    for (int it = vcu; it < 16 * NCH; it += G) {
        const int bh = it >> 6, c = it & 63, b = bh >> 2, h = bh & 3;
        const size_t t0 = (size_t)b * SEQ + c * 128;
        stage_tile128(PROJ + t0 * INW + C_RK + h * HD, INW, Kt, tid);
        stage_tile128(PROJ + t0 * INW + C_RV + h * HD, INW, Vt, tid);
        __syncthreads();
        float acc[32];
#pragma unroll
        for (int i = 0; i < 32; ++i) acc[i] = 0.f;
        for (int m = 0; m < 128; ++m) {
            const float v = bf2f(*(const bf16*)(Vt + m * TROW + e * 2));
#pragma unroll
            for (int q = 0; q < 4; ++q) { const v4u w = *(const v4u*)(Kt + m * TROW + dp * 64 + q * 16);
                acc[q * 8 + 0] += v * bflo(w.x); acc[q * 8 + 1] += v * bfhi(w.x); acc[q * 8 + 2] += v * bflo(w.y); acc[q * 8 + 3] += v * bfhi(w.y);
                acc[q * 8 + 4] += v * bflo(w.z); acc[q * 8 + 5] += v * bfhi(w.z); acc[q * 8 + 6] += v * bflo(w.w); acc[q * 8 + 7] += v * bfhi(w.w); }
        }
        bf16* o = ST + ((size_t)it * 128 + e) * 128 + dp * 32;
#pragma unroll
        for (int q = 0; q < 4; ++q) { v4u w; w.x = pk2(acc[q * 8 + 0], acc[q * 8 + 1]); w.y = pk2(acc[q * 8 + 2], acc[q * 8 + 3]); w.z = pk2(acc[q * 8 + 4], acc[q * 8 + 5]); w.w = pk2(acc[q * 8 + 6], acc[q * 8 + 7]);
            *(v4u*)(o + q * 8) = w; }
        __syncthreads();
    }
}

__device__ __forceinline__ void p2b_gating(KA A, unsigned char* lds) {
    PHASE_IDS();
    unsigned char* ws = A->ws; const bf16* PROJ = (const bf16*)(ws + WS_PROJ); const float* KM = (const float*)(ws + WS_KMEAN); unsigned* SEL = (unsigned*)(ws + WS_SEL);
    float* km = (float*)lds;
    const int q = tid >> 1, half = tid & 1;
    for (int it = vcu; it < 16 * NBLK; it += G) {
        const int bh = it >> 5, qb = it & 31, b = bh >> 2, h = bh & 3;
        for (int i = tid; i < qb * 32; i += NWAVES * 64) ((f32x4*)km)[i] = ((const f32x4*)(KM + (size_t)bh * NBLK * HD))[i];
        __syncthreads();
        const size_t t = (size_t)b * SEQ + qb * 256 + q;
        const bf16* qp = PROJ + t * INW + C_MQ + h * HD + half * 64;
        float qf[64];
#pragma unroll
        for (int c = 0; c < 8; ++c) { const v4u w = *(const v4u*)(qp + c * 8);
            qf[c * 8 + 0] = bflo(w.x); qf[c * 8 + 1] = bfhi(w.x); qf[c * 8 + 2] = bflo(w.y); qf[c * 8 + 3] = bfhi(w.y); qf[c * 8 + 4] = bflo(w.z); qf[c * 8 + 5] = bfhi(w.z); qf[c * 8 + 6] = bflo(w.w); qf[c * 8 + 7] = bfhi(w.w); }
        float v0 = -3e38f, v1 = -3e38f, v2 = -3e38f; int i0 = -1, i1 = -1, i2 = -1;
        for (int n = 0; n < qb; ++n) {
            const f32x4* kr = (const f32x4*)(km + n * HD + half * 64);
            float d0 = 0.f, d1 = 0.f, d2 = 0.f, d3 = 0.f;
#pragma unroll
            for (int c = 0; c < 16; ++c) { const f32x4 k4 = kr[c]; d0 += qf[c * 4 + 0] * k4[0]; d1 += qf[c * 4 + 1] * k4[1]; d2 += qf[c * 4 + 2] * k4[2]; d3 += qf[c * 4 + 3] * k4[3]; }
            float d = (d0 + d1) + (d2 + d3);
            d += __shfl_xor(d, 1);
            if (d > v0) { v2 = v1; i2 = i1; v1 = v0; i1 = i0; v0 = d; i0 = n; }
            else if (d > v1) { v2 = v1; i2 = i1; v1 = d; i1 = n; }
            else if (d > v2) { v2 = d; i2 = n; }
        }
        unsigned mask = 0u;
        if (i0 >= 0) mask |= 1u << i0; if (i1 >= 0) mask |= 1u << i1; if (i2 >= 0) mask |= 1u << i2;
        if (half == 0) SEL[t * NH + h] = mask;
        __syncthreads();
    }
}

__device__ __forceinline__ void p3_scan(KA A) {
    PHASE_IDS();
    unsigned* ST = (unsigned*)(A->ws + WS_KV);
    for (int idx = vcu * (NWAVES * 64) + tid; idx < 16 * 8192; idx += G * NWAVES * 64) {
        const int bh = idx >> 13, pr = idx & 8191, h = bh & 3;
        const float lg2 = ret_log2g(h), g1 = exp2f(lg2), g127 = exp2f(127.f * lg2), g128 = exp2f(128.f * lg2);
        unsigned* p = ST + (size_t)bh * NCH * 8192 + pr;
        float s0 = 0.f, s1 = 0.f;
#pragma unroll 8
        for (int c = 0; c < NCH; ++c) {
            const unsigned w = p[(size_t)c * 8192];
            p[(size_t)c * 8192] = pk2(g1 * s0, g1 * s1);
            s0 = s0 * g128 + g127 * bflo(w); s1 = s1 * g128 + g127 * bfhi(w);
        }
    }
}

__device__ __forceinline__ void p3_moba_naive(KA A, unsigned char* lds) {
    PHASE_IDS();
    unsigned char* ws = A->ws; bf16* PROJ = (bf16*)(ws + WS_PROJ); const unsigned* SEL = (const unsigned*)(ws + WS_SEL); const float* LUT = (const float*)(ws + WS_LUT);
    float* qs = (float*)(lds + wave * 5120);
    float* ps = qs + 128;
    const int gw = vcu * NWAVES + wave, NGW = G * NWAVES;
    for (int item = gw; item < M * NH; item += NGW) {
        const int t = item >> 2, h = item & 3, b = t >> 13, pos = t & (SEQ - 1), qb = pos >> 8;
        const unsigned mask = SEL[item];
        int blk[4]; int nsel = 0;
        { unsigned mm = mask; const int a0 = mm ? __builtin_ctz(mm) : 0; if (mm) { mm &= mm - 1; ++nsel; } const int a1 = mm ? __builtin_ctz(mm) : 0; if (mm) { mm &= mm - 1; ++nsel; } const int a2 = mm ? __builtin_ctz(mm) : 0; if (mm) { ++nsel; }
          blk[0] = a0; blk[1] = a1; blk[2] = a2; blk[3] = qb; }
        const unsigned qw = *(const unsigned*)(PROJ + (size_t)t * INW + C_MQ + h * HD + 2 * lane);
        qs[2 * lane] = bflo(qw); qs[2 * lane + 1] = bfhi(qw);
        LDS_WAIT();
        const float* lut = LUT + h * SEQ;
        float sc[16]; float mx = -1e30f;
#pragma unroll
        for (int sl = 0; sl < 4; ++sl) {
            const bool on = (sl == 3) || (sl < nsel);
#pragma unroll
            for (int kk = 0; kk < 4; ++kk) {
                float s = -1e30f;
                if (on) {
                    const int kpos = blk[sl] * 256 + kk * 64 + lane;
                    const bf16* kp = PROJ + ((size_t)b * SEQ + kpos) * INW + C_MK + h * HD;
                    float d = 0.f;
#pragma unroll
                    for (int c = 0; c < 16; ++c) { const v4u w = *(const v4u*)(kp + c * 8); const f32x4 q0 = *(const f32x4*)(qs + c * 8), q1 = *(const f32x4*)(qs + c * 8 + 4);
                        d += (bflo(w.x) * q0[0] + bfhi(w.x) * q0[1]) + (bflo(w.y) * q0[2] + bfhi(w.y) * q0[3]) + (bflo(w.z) * q1[0] + bfhi(w.z) * q1[1]) + (bflo(w.w) * q1[2] + bfhi(w.w) * q1[3]); }
                    const int dist = pos - kpos;
                    if (dist >= 0) s = d + lut[dist];
                }
                sc[sl * 4 + kk] = s; mx = fmaxf(mx, s);
            }
        }
        mx = wave_max(mx);
        float l = 0.f;
#pragma unroll
        for (int i = 0; i < 16; ++i) { const float pz = (sc[i] > -1e29f) ? __expf(sc[i] - mx) : 0.f; l += pz; ps[i * 64 + lane] = pz; }
        l = wave_sum(l);
        LDS_WAIT();
        float o0 = 0.f, o1 = 0.f;
#pragma unroll
        for (int sl = 0; sl < 4; ++sl) {
            const bool on = (sl == 3) || (sl < nsel);
            if (on) {
                const bf16* vp = PROJ + ((size_t)b * SEQ + blk[sl] * 256) * INW + C_MV + h * HD + 2 * lane;
#pragma unroll 8
                for (int k = 0; k < 256; ++k) { const float pz = ps[sl * 256 + k]; const unsigned w = *(const unsigned*)(vp + (size_t)k * INW); o0 += pz * bflo(w); o1 += pz * bfhi(w); }
            }
        }
        const float inv = 1.0f / l;
        const unsigned zw = *(const unsigned*)(PROJ + (size_t)t * INW + C_MZ + h * HD + 2 * lane);
        const float z0 = bflo(zw), z1 = bfhi(zw);
        const float r0 = o0 * inv * (z0 / (1.0f + __expf(-z0))), r1 = o1 * inv * (z1 / (1.0f + __expf(-z1)));
        *(unsigned*)(PROJ + (size_t)t * INW + C_MQ + h * HD + 2 * lane) = pk2(r0, r1);
        LDS_WAIT();
    }
}

__device__ __forceinline__ void p4_ret_naive(KA A, int L, unsigned char* lds) {
    PHASE_IDS();
    unsigned char* ws = A->ws; bf16* PROJ = (bf16*)(ws + WS_PROJ); const bf16* ST = (const bf16*)(ws + WS_KV);
    unsigned char* Qt = lds; unsigned char* Kt = lds + 128 * TROW; unsigned char* Vt = lds + 2 * 128 * TROW; unsigned char* St = lds + 3 * 128 * TROW;
    const int n = tid >> 2, part = tid & 3;
    for (int it = vcu; it < 16 * NCH; it += G) {
        const int bh = it >> 6, c = it & 63, b = bh >> 2, h = bh & 3;
        const size_t t0 = (size_t)b * SEQ + c * 128;
        stage_tile128(PROJ + t0 * INW + C_RQ + h * HD, INW, Qt, tid);
        stage_tile128(PROJ + t0 * INW + C_RK + h * HD, INW, Kt, tid);
        stage_tile128(PROJ + t0 * INW + C_RV + h * HD, INW, Vt, tid);
        stage_tile128(ST + (size_t)it * 128 * 128, 128, St, tid);
        __syncthreads();
        float qf[32];
#pragma unroll
        for (int q = 0; q < 4; ++q) { const v4u w = *(const v4u*)(Qt + n * TROW + part * 64 + q * 16);
            qf[q * 8 + 0] = bflo(w.x); qf[q * 8 + 1] = bfhi(w.x); qf[q * 8 + 2] = bflo(w.y); qf[q * 8 + 3] = bfhi(w.y); qf[q * 8 + 4] = bflo(w.z); qf[q * 8 + 5] = bfhi(w.z); qf[q * 8 + 6] = bflo(w.w); qf[q * 8 + 7] = bfhi(w.w); }
        float o[32];
#pragma unroll
        for (int i = 0; i < 32; ++i) o[i] = 0.f;
        const int mend = (n | 15) + 1;
        for (int m = 0; m < mend; ++m) {
            float s = 0.f;
#pragma unroll
            for (int q = 0; q < 4; ++q) { const v4u w = *(const v4u*)(Kt + m * TROW + part * 64 + q * 16);
                s += (qf[q * 8 + 0] * bflo(w.x) + qf[q * 8 + 1] * bfhi(w.x)) + (qf[q * 8 + 2] * bflo(w.y) + qf[q * 8 + 3] * bfhi(w.y)) + (qf[q * 8 + 4] * bflo(w.z) + qf[q * 8 + 5] * bfhi(w.z)) + (qf[q * 8 + 6] * bflo(w.w) + qf[q * 8 + 7] * bfhi(w.w)); }
            s += __shfl_xor(s, 1); s += __shfl_xor(s, 2);
            if (m > n) s = 0.f;
#pragma unroll
            for (int q = 0; q < 4; ++q) { const v4u w = *(const v4u*)(Vt + m * TROW + part * 64 + q * 16);
                o[q * 8 + 0] += s * bflo(w.x); o[q * 8 + 1] += s * bfhi(w.x); o[q * 8 + 2] += s * bflo(w.y); o[q * 8 + 3] += s * bfhi(w.y); o[q * 8 + 4] += s * bflo(w.z); o[q * 8 + 5] += s * bfhi(w.z); o[q * 8 + 6] += s * bflo(w.w); o[q * 8 + 7] += s * bfhi(w.w); }
        }
        for (int d8 = 0; d8 < 16; ++d8) {
            const v4u qw = *(const v4u*)(Qt + n * TROW + d8 * 16);
            const float q0 = bflo(qw.x), q1 = bfhi(qw.x), q2 = bflo(qw.y), q3 = bfhi(qw.y), q4 = bflo(qw.z), q5 = bfhi(qw.z), q6 = bflo(qw.w), q7 = bfhi(qw.w);
#pragma unroll
            for (int ee = 0; ee < 32; ++ee) { const v4u w = *(const v4u*)(St + (part * 32 + ee) * TROW + d8 * 16);
                o[ee] += (q0 * bflo(w.x) + q1 * bfhi(w.x)) + (q2 * bflo(w.y) + q3 * bfhi(w.y)) + (q4 * bflo(w.z) + q5 * bfhi(w.z)) + (q6 * bflo(w.w) + q7 * bfhi(w.w)); }
        }
        float sm = 0.f;
#pragma unroll
        for (int i = 0; i < 32; ++i) sm += o[i];
        sm += __shfl_xor(sm, 1); sm += __shfl_xor(sm, 2);
        const float mean = sm * (1.0f / 128.0f);
        float vr = 0.f;
#pragma unroll
        for (int i = 0; i < 32; ++i) { const float dlt = o[i] - mean; vr += dlt * dlt; }
        vr += __shfl_xor(vr, 1); vr += __shfl_xor(vr, 2);
        const float rstd = 1.0f / sqrtf(vr * (1.0f / 128.0f) + pg8::EPS);
        const float* gn = A->ret_norm_g + L * 512 + h * HD + part * 32;
        bf16* zrow = PROJ + (t0 + n) * INW + C_RZ + h * HD + part * 32;
        bf16* orow = PROJ + (t0 + n) * INW + C_RQ + h * HD + part * 32;
#pragma unroll
        for (int q = 0; q < 4; ++q) { const v4u zw = *(const v4u*)(zrow + q * 8); const f32x4 g0 = *(const f32x4*)(gn + q * 8), g1 = *(const f32x4*)(gn + q * 8 + 4);
            float z[8] = {bflo(zw.x), bfhi(zw.x), bflo(zw.y), bfhi(zw.y), bflo(zw.z), bfhi(zw.z), bflo(zw.w), bfhi(zw.w)};
            float r[8];
#pragma unroll
            for (int e = 0; e < 8; ++e) { const float gg = (e < 4) ? g0[e & 3] : g1[e & 3]; r[e] = (o[q * 8 + e] - mean) * rstd * gg * (z[e] / (1.0f + __expf(-z[e]))); }
            v4u w; w.x = pk2(r[0], r[1]); w.y = pk2(r[2], r[3]); w.z = pk2(r[4], r[5]); w.w = pk2(r[6], r[7]);
            *(v4u*)(orow + q * 8) = w; }
        __syncthreads();
    }
}

constexpr size_t WS_PARTO = WS_XB;
constexpr size_t WS_PARTML = 501 * MiB;
constexpr size_t WS_LIST = 504 * MiB;
constexpr size_t WS_CNT = 508 * MiB;
constexpr int CW_TOT = 8192;
static_assert(WS_PARTO + (size_t)M * NH * 3 * 128 * 2 <= WS_PROJ && WS_CNT + 16 * 32 * 32 * 4 <= 512 * MiB, "MoBA workspace");

namespace mb {
using bf16x8 = __attribute__((ext_vector_type(8))) short;
using s16x4  = __attribute__((ext_vector_type(4))) short;
using f32x16 = __attribute__((ext_vector_type(16))) float;
using u32x4  = __attribute__((ext_vector_type(4))) unsigned;
constexpr int KVBLK = 64, QBLK = 32;
constexpr int SHM_V = KVBLK * 128 * 2, SHM_K = KVBLK * 128 * 2;
constexpr int L_V = 0, L_K = 2 * SHM_V, L_WS = 2 * SHM_V + 2 * SHM_K  , L_LUT = L_WS + 2048  , L_QPOS = L_LUT + 32768  ,
              L_TAB = L_QPOS + 1024  , L_SEG = L_TAB + 2048  , L_COEF = L_SEG + 256  , L_END = L_COEF + 4096;
static_assert(L_END <= LDSCTL_OFF, "MoBA LDS map");
#define MB_KSWZ(row, colB) ((row) * 256 + ((colB) ^ (((row) & 7) << 4)))
#define MB_SBAR() __builtin_amdgcn_sched_barrier(0)
__device__ __forceinline__ int crow(int r, int hi) { return (r & 3) + 8 * (r >> 2) + 4 * hi; }
__device__ __forceinline__ unsigned cvtpk(float lo, float hi) { unsigned r; asm volatile("v_cvt_pk_bf16_f32 %0, %1, %2" : "=v"(r) : "v"(lo), "v"(hi)); return r; }
constexpr float LOG2E = 1.4426950408889634f;
constexpr float THR = 0.f;

__device__ __forceinline__ void partialSM(f32x16& p0, f32x16& p1, float& m_reg, float& mn, float& alpha) {
  float pmax = p0[0];
#pragma unroll
  for (int r = 1; r < 16; ++r) pmax = fmaxf(pmax, p0[r]);
#pragma unroll
  for (int r = 0; r < 16; ++r) pmax = fmaxf(pmax, p1[r]);
  { auto rr = __builtin_amdgcn_permlane32_swap(__float_as_uint(pmax), __float_as_uint(pmax), false, false);
    pmax = fmaxf(__uint_as_float(rr[0]), __uint_as_float(rr[1])); }
  if (__builtin_expect(__all(pmax - m_reg <= THR), 1)) { mn = m_reg; alpha = 1.f; }
  else { mn = fmaxf(m_reg, pmax); alpha = __builtin_amdgcn_exp2f((m_reg - mn) * LOG2E); m_reg = mn; }
  const float mnC = -mn * LOG2E;
#pragma unroll
  for (int r = 0; r < 16; ++r) p0[r] = fmaf(p0[r], LOG2E, mnC);
#pragma unroll
  for (int r = 0; r < 16; ++r) p1[r] = fmaf(p1[r], LOG2E, mnC);
#pragma unroll
  for (int r = 0; r < 16; ++r) p0[r] = __builtin_amdgcn_exp2f(p0[r]);
}
__device__ __forceinline__ void finishSM(f32x16& p0, f32x16& p1, float alpha, float& l_reg, bf16x8& pa0, bf16x8& pa1, bf16x8& pa2, bf16x8& pa3) {
#pragma unroll
  for (int r = 0; r < 16; ++r) p1[r] = __builtin_amdgcn_exp2f(p1[r]);
  float ps = 0;
#pragma unroll
  for (int r = 0; r < 16; ++r) ps += p0[r];
#pragma unroll
  for (int r = 0; r < 16; ++r) ps += p1[r];
  { auto rr = __builtin_amdgcn_permlane32_swap(__float_as_uint(ps), __float_as_uint(ps), false, false);
    ps = __uint_as_float(rr[0]) + __uint_as_float(rr[1]); }
  l_reg = l_reg * alpha + ps;
#define MB_PK4(P, BASE, OUT) do { unsigned a0 = cvtpk(P[BASE + 0], P[BASE + 1]), a1 = cvtpk(P[BASE + 2], P[BASE + 3]);   \
    unsigned b0 = cvtpk(P[BASE + 4], P[BASE + 5]), b1 = cvtpk(P[BASE + 6], P[BASE + 7]);                              \
    auto r0 = __builtin_amdgcn_permlane32_swap(a0, b0, false, false); auto r1 = __builtin_amdgcn_permlane32_swap(a1, b1, false, false); \
    u32x4 w = {r0[0], r1[0], r0[1], r1[1]}; OUT = *reinterpret_cast<bf16x8*>(&w); } while (0)
  MB_PK4(p0, 0, pa0); MB_PK4(p0, 8, pa1); MB_PK4(p1, 0, pa2); MB_PK4(p1, 8, pa3);
#undef MB_PK4
}
template <bool OWN>
__device__ __forceinline__ void qkt(f32x16& p0, f32x16& p1, const char* Ks, const bf16x8* qr, int r32, int hi, int dq, const float* lut) {
#pragma unroll
  for (int r = 0; r < 16; ++r) {
    const int i0 = dq - crow(r, hi), i1 = i0 - 32;
    if (OWN) { p0[r] = (i0 >= 0) ? lut[i0 < 0 ? 0 : i0] : -1e30f; p1[r] = (i1 >= 0) ? lut[i1 < 0 ? 0 : i1] : -1e30f; }
    else { p0[r] = lut[i0]; p1[r] = lut[i1]; }
  }
#pragma unroll
  for (int d0 = 0; d0 < 8; ++d0) { const int cb = (d0 * 16 + hi * 8) * 2;
    const bf16x8 b0 = *reinterpret_cast<const bf16x8*>(Ks + MB_KSWZ(r32, cb));
    const bf16x8 b1 = *reinterpret_cast<const bf16x8*>(Ks + MB_KSWZ(32 + r32, cb));
    p0 = __builtin_amdgcn_mfma_f32_32x32x16_bf16(b0, qr[d0], p0, 0, 0, 0);
    p1 = __builtin_amdgcn_mfma_f32_32x32x16_bf16(b1, qr[d0], p1, 0, 0, 0); }
}
__device__ __forceinline__ int v_st(int k, int c) { const int kk = (k & ~0xC) | ((k & 4) << 1) | ((k & 8) >> 1); return ((kk >> 3) * 4 + (c >> 5)) * 512 + ((kk & 7) * 32 + (c & 31)) * 2; }
__device__ __forceinline__ int v_rd_base(int lane) { return ((lane & 3) << 3) | (((lane >> 2) & 3) << 6) | (((lane >> 4) & 1) << 5) | (((lane >> 5) & 1) << 8); }
constexpr int v_rd_off(int d0, int ks, int half) { return d0 * 512 + ks * 4096 + half * 2048; }
template <int OFF> __device__ __forceinline__ s16x4 tr_read(int vb) { s16x4 r; asm volatile("ds_read_b64_tr_b16 %0, %1 offset:%2" : "=&v"(r) : "v"(vb), "i"(OFF) : "memory"); return r; }
template <int D0> __device__ __forceinline__ void pv_one(f32x16& od, int vb, bf16x8 pa0, bf16x8 pa1, bf16x8 pa2, bf16x8 pa3) {
  const s16x4 l0 = tr_read<v_rd_off(D0, 0, 0)>(vb), h0 = tr_read<v_rd_off(D0, 0, 1)>(vb), l1 = tr_read<v_rd_off(D0, 1, 0)>(vb), h1 = tr_read<v_rd_off(D0, 1, 1)>(vb);
  const s16x4 l2 = tr_read<v_rd_off(D0, 2, 0)>(vb), h2 = tr_read<v_rd_off(D0, 2, 1)>(vb), l3 = tr_read<v_rd_off(D0, 3, 0)>(vb), h3 = tr_read<v_rd_off(D0, 3, 1)>(vb);
  asm volatile("s_waitcnt lgkmcnt(0)" ::: "memory"); MB_SBAR();
#define MB_PK(L, H) (bf16x8){L[0], L[1], L[2], L[3], H[0], H[1], H[2], H[3]}
  od = __builtin_amdgcn_mfma_f32_32x32x16_bf16(pa0, MB_PK(l0, h0), od, 0, 0, 0);
  od = __builtin_amdgcn_mfma_f32_32x32x16_bf16(pa1, MB_PK(l1, h1), od, 0, 0, 0);
  od = __builtin_amdgcn_mfma_f32_32x32x16_bf16(pa2, MB_PK(l2, h2), od, 0, 0, 0);
  od = __builtin_amdgcn_mfma_f32_32x32x16_bf16(pa3, MB_PK(l3, h3), od, 0, 0, 0);
#undef MB_PK
}
__device__ __forceinline__ void pv_d0(f32x16* o, int vb, bf16x8 pa0, bf16x8 pa1, bf16x8 pa2, bf16x8 pa3) {
  pv_one<0>(o[0], vb, pa0, pa1, pa2, pa3); pv_one<1>(o[1], vb, pa0, pa1, pa2, pa3); pv_one<2>(o[2], vb, pa0, pa1, pa2, pa3); pv_one<3>(o[3], vb, pa0, pa1, pa2, pa3);
}

template <bool OWN>
__device__ __forceinline__ void attend_block(const bf16* __restrict__ Qseq, const bf16* __restrict__ Kh, const bf16* __restrict__ Vh, int kpos0, char* lds, f32x16 (&o)[4], float& m_out, float& l_out, int tid) {
  const int wid = tid >> 6, lane = tid & 63, r32 = lane & 31, hi = lane >> 5;
  char* V_lds = lds + L_V; char* K_lds = lds + L_K;
  float* wsf = (float*)(lds + L_WS) + wid * 64; float* al_l = wsf + 32;
  const float* lut = (const float*)(lds + L_LUT);
  const int qp = ((const int*)(lds + L_QPOS))[wid * QBLK + r32];
  float m_reg = -1e30f, l_reg = 0; bf16x8 qr[8];
  const bf16* Qw = Qseq + (size_t)qp * INW + hi * 8;
#pragma unroll
  for (int d0 = 0; d0 < 8; ++d0) qr[d0] = *reinterpret_cast<const bf16x8*>(Qw + d0 * 16);
#pragma unroll
  for (int d = 0; d < 4; ++d) o[d] = f32x16{};
  const int sr = tid >> 4, sc = (tid & 15) * 8, vst0 = v_st(sr, sc), vst1 = v_st(32 + sr, sc);
  const int vb0 = (int)(uintptr_t)V_lds + v_rd_base(lane);
  const int dq0 = qp - kpos0;
  struct { bf16x8 vs0, vs1, ks0, ks1; } sr_;
#define MB_SLOAD(k0) do { sr_.vs0 = *reinterpret_cast<const bf16x8*>(&Vh[(size_t)((k0) + sr) * INW + sc]); sr_.vs1 = *reinterpret_cast<const bf16x8*>(&Vh[(size_t)((k0) + 32 + sr) * INW + sc]); \
    sr_.ks0 = *reinterpret_cast<const bf16x8*>(&Kh[(size_t)((k0) + sr) * INW + sc]); sr_.ks1 = *reinterpret_cast<const bf16x8*>(&Kh[(size_t)((k0) + 32 + sr) * INW + sc]); } while (0)
#define MB_SWRITE(b) do { asm volatile("s_waitcnt vmcnt(0)" ::: "memory"); *(bf16x8*)(V_lds + (b) * SHM_V + vst0) = sr_.vs0; *(bf16x8*)(V_lds + (b) * SHM_V + vst1) = sr_.vs1; const int kc = sc * 2; \
    *(bf16x8*)(K_lds + (b) * SHM_K + MB_KSWZ(sr, kc)) = sr_.ks0; *(bf16x8*)(K_lds + (b) * SHM_K + MB_KSWZ(32 + sr, kc)) = sr_.ks1; } while (0)
#define MB_RESC(a) do { if (__any((a) < 1.f)) { if (hi == 0) al_l[r32] = (a); asm volatile("s_waitcnt lgkmcnt(0)" ::: "memory"); \
    _Pragma("unroll") for (int d = 0; d < 4; ++d) _Pragma("unroll") for (int r = 0; r < 16; ++r) o[d][r] *= al_l[crow(r, hi)]; } } while (0)
  f32x16 pA0, pA1, pB0, pB1; float mnA, mnB, alA, alB; bf16x8 pa0, pa1, pa2, pa3;
  MB_SLOAD(0); MB_SWRITE(0); __syncthreads();
  qkt<OWN>(pA0, pA1, K_lds, qr, r32, hi, dq0, lut); partialSM(pA0, pA1, m_reg, mnA, alA);
  MB_SLOAD(KVBLK); MB_SWRITE(1); __syncthreads();
  MB_SBAR(); qkt<OWN>(pB0, pB1, K_lds + SHM_K, qr, r32, hi, dq0 - KVBLK, lut);
  finishSM(pA0, pA1, alA, l_reg, pa0, pa1, pa2, pa3); MB_SBAR();
  MB_SLOAD(2 * KVBLK); MB_SBAR();
  pv_d0(o, vb0, pa0, pa1, pa2, pa3); partialSM(pB0, pB1, m_reg, mnB, alB);
  __syncthreads(); MB_SWRITE(0);
  MB_RESC(alB); __syncthreads();
  MB_SBAR(); qkt<OWN>(pA0, pA1, K_lds, qr, r32, hi, dq0 - 2 * KVBLK, lut);
  finishSM(pB0, pB1, alB, l_reg, pa0, pa1, pa2, pa3); MB_SBAR();
  MB_SLOAD(3 * KVBLK); MB_SBAR();
  pv_d0(o, vb0 + SHM_V, pa0, pa1, pa2, pa3); partialSM(pA0, pA1, m_reg, mnA, alA);
  __syncthreads(); MB_SWRITE(1);
  MB_RESC(alA); __syncthreads();
  MB_SBAR(); qkt<OWN>(pB0, pB1, K_lds + SHM_K, qr, r32, hi, dq0 - 3 * KVBLK, lut);
  finishSM(pA0, pA1, alA, l_reg, pa0, pa1, pa2, pa3); MB_SBAR();
  pv_d0(o, vb0, pa0, pa1, pa2, pa3); partialSM(pB0, pB1, m_reg, mnB, alB);
  MB_RESC(alB);
  finishSM(pB0, pB1, alB, l_reg, pa0, pa1, pa2, pa3); MB_SBAR();
  pv_d0(o, vb0 + SHM_V, pa0, pa1, pa2, pa3);
  m_out = m_reg; l_out = l_reg;
  __syncthreads();
#undef MB_SLOAD
#undef MB_SWRITE
#undef MB_RESC
}
__device__ __forceinline__ void stage_rows_bf16(const f32x16 (&o)[4], const float* rowscale, char* stg, int r32, int hi) {
#pragma unroll
  for (int r = 0; r < 16; ++r) { const int row = crow(r, hi); const float s = rowscale[row];
#pragma unroll
    for (int d0 = 0; d0 < 4; ++d0) *(unsigned short*)(stg + row * 256 + (d0 * 32 + r32) * 2) = (unsigned short)(cvtpk(o[d0][r] * s, 0.f) & 0xffffu); }
}
}

__device__ __forceinline__ void p2b_gating_lists(KA A, unsigned char* lds) {
    PHASE_IDS();
    unsigned char* ws = A->ws; const bf16* PROJ = (const bf16*)(ws + WS_PROJ); const float* KM = (const float*)(ws + WS_KMEAN); unsigned* SEL = (unsigned*)(ws + WS_SEL);
    unsigned char* LIST = ws + WS_LIST; unsigned* CNT = (unsigned*)(ws + WS_CNT); unsigned* TOT = (unsigned*)(ws + WS_CTL) + CW_TOT;
    float* km = (float*)lds; int* wc = (int*)(lds + 16384);
    const int q = tid >> 1, half = tid & 1;
    for (int it = vcu; it < 16 * NBLK; it += G) {
        const int bh = it >> 5, qb = it & 31, b = bh >> 2, h = bh & 3;
        for (int i = tid; i < qb * 32; i += NWAVES * 64) ((f32x4*)km)[i] = ((const f32x4*)(KM + (size_t)bh * NBLK * HD))[i];
        __syncthreads();
        const size_t t = (size_t)b * SEQ + qb * 256 + q;
        const bf16* qp = PROJ + t * INW + C_MQ + h * HD + half * 64;
        float qf[64];
#pragma unroll
        for (int c = 0; c < 8; ++c) { const v4u w = *(const v4u*)(qp + c * 8);
            qf[c * 8 + 0] = bflo(w.x); qf[c * 8 + 1] = bfhi(w.x); qf[c * 8 + 2] = bflo(w.y); qf[c * 8 + 3] = bfhi(w.y); qf[c * 8 + 4] = bflo(w.z); qf[c * 8 + 5] = bfhi(w.z); qf[c * 8 + 6] = bflo(w.w); qf[c * 8 + 7] = bfhi(w.w); }
        float v0 = -3e38f, v1 = -3e38f, v2 = -3e38f; int i0 = -1, i1 = -1, i2 = -1;
        for (int n = 0; n < qb; ++n) {
            const f32x4* kr = (const f32x4*)(km + n * HD + half * 64);
            float d0 = 0.f, d1 = 0.f, d2 = 0.f, d3 = 0.f;
#pragma unroll
            for (int c = 0; c < 16; ++c) { const f32x4 k4 = kr[c]; d0 += qf[c * 4 + 0] * k4[0]; d1 += qf[c * 4 + 1] * k4[1]; d2 += qf[c * 4 + 2] * k4[2]; d3 += qf[c * 4 + 3] * k4[3]; }
            float d = (d0 + d1) + (d2 + d3);
            d += __shfl_xor(d, 1);
            if (d > v0) { v2 = v1; i2 = i1; v1 = v0; i1 = i0; v0 = d; i0 = n; }
            else if (d > v1) { v2 = v1; i2 = i1; v1 = d; i1 = n; }
            else if (d > v2) { v2 = d; i2 = n; }
        }
        unsigned mask = 0u;
        if (i0 >= 0) mask |= 1u << i0; if (i1 >= 0) mask |= 1u << i1; if (i2 >= 0) mask |= 1u << i2;
        if (half == 0) SEL[t * NH + h] = mask;
        for (int j = 0; j < qb; ++j) { const unsigned long long bal = __ballot(half == 0 && ((mask >> j) & 1u)); if (lane == 0) wc[j * 8 + wave] = __popcll(bal); }
        __syncthreads();
        for (int j = 0; j < qb; ++j) {
            const bool f = (half == 0) && ((mask >> j) & 1u);
            const unsigned long long bal = __ballot(f);
            int off = __popcll(bal & ((1ull << lane) - 1ull));
            int tot = 0;
#pragma unroll
            for (int w = 0; w < 8; ++w) { const int c = wc[j * 8 + w]; off += (w < wave) ? c : 0; tot += c; }
            const size_t seg = ((size_t)(bh * 32 + j) * 32 + qb);
            if (f) LIST[seg * 256 + off] = (unsigned char)q;
            if (tid == 0) { CNT[seg] = (unsigned)tot; atomicAdd(&TOT[bh * 32 + j], (unsigned)tot); }
        }
        __syncthreads();
    }
}

__device__ __forceinline__ void p3_moba_sel(KA A, unsigned char* ldsu) {
    PHASE_IDS();
    char* lds = (char*)ldsu;
    unsigned char* ws = A->ws; const bf16* PROJ = (const bf16*)(ws + WS_PROJ); const unsigned* SEL = (const unsigned*)(ws + WS_SEL);
    const unsigned char* LIST = ws + WS_LIST; const unsigned* CNT = (const unsigned*)(ws + WS_CNT); unsigned* TOT = (unsigned*)(ws + WS_CTL) + CW_TOT;
    bf16* PARTO = (bf16*)(ws + WS_PARTO); float* PARTML = (float*)(ws + WS_PARTML);
    int* tab = (int*)(lds + mb::L_TAB);
    int* seg = (int*)(lds + mb::L_SEG);
    int* qpos = (int*)(lds + mb::L_QPOS);
    if (wave == 0) {
        int c[8]; int s = 0;
#pragma unroll
        for (int k = 0; k < 8; ++k) { const int e = lane * 8 + k; int n = 0; if (e < 496) { const int bh = e / 31, j = e % 31; n = (int)((__hip_atomic_load(&TOT[bh * 32 + j], __ATOMIC_RELAXED, __HIP_MEMORY_SCOPE_AGENT) + 255u) >> 8); } c[k] = s; s += n; }
        int incl = s;
#pragma unroll
        for (int o = 1; o < 64; o <<= 1) { const int v = __shfl_up(incl, o); if (lane >= o) incl += v; }
        const int excl = incl - s;
#pragma unroll
        for (int k = 0; k < 8; ++k) { const int e = lane * 8 + k; if (e <= 496) tab[e] = excl + c[k]; }
    }
    __syncthreads();
    const int T = tab[496];
    const int t_lo = (int)(((long)vcu * T) / G), t_hi = (int)(((long)(vcu + 1) * T) / G);
    int cur_h = -1;
    for (int tile = t_lo; tile < t_hi; ++tile) {
        int lo = 0, hi_ = 495;
        while (lo < hi_) { const int mid = (lo + hi_ + 1) >> 1; if (tab[mid] <= tile) lo = mid; else hi_ = mid - 1; }
        const int e = lo, bh = e / 31, j = e % 31, b = bh >> 2, h = bh & 3, ti = tile - tab[e];
        if (wave == 0) {
            int n = 0; if (lane > j && lane < 32) n = (int)CNT[(size_t)(bh * 32 + j) * 32 + lane];
            int incl = n;
#pragma unroll
            for (int o = 1; o < 32; o <<= 1) { const int v = __shfl_up(incl, o); if (lane >= o) incl += v; }
            if (lane < 32) seg[lane] = incl - n; if (lane == 31) seg[32] = incl;
        }
        if (cur_h != h) { cur_h = h; const f32x4* src = (const f32x4*)((const float*)(ws + WS_LUT) + h * SEQ); f32x4* dst = (f32x4*)(lds + mb::L_LUT);
#pragma unroll
            for (int i = 0; i < 4; ++i) dst[tid + i * 512] = src[tid + i * 512]; }
        __syncthreads();
        const int total = seg[32];
        if (tid < 256) {
            const int s = ti * 256 + tid; int pos = (j + 1) * 256;
            if (s < total) { int qb = j + 1; while (qb < 31 && seg[qb + 1] <= s) ++qb; pos = qb * 256 + (int)LIST[((size_t)(bh * 32 + j) * 32 + qb) * 256 + (s - seg[qb])]; }
            qpos[tid] = pos;
        }
        __syncthreads();
        const bf16* Qseq = PROJ + (size_t)b * SEQ * INW + C_MQ + h * HD;
        const bf16* Kh = PROJ + ((size_t)b * SEQ + j * 256) * INW + C_MK + h * HD;
        const bf16* Vh = PROJ + ((size_t)b * SEQ + j * 256) * INW + C_MV + h * HD;
        mb::f32x16 o[4]; float m_reg, l_reg;
        mb::attend_block<false>(Qseq, Kh, Vh, j * 256, lds, o, m_reg, l_reg, tid);
        int lane_e = lane; asm volatile("" : "+v"(lane_e));
#define lane lane_e
        const int r32 = lane & 31, hi = lane >> 5, pos = qpos[wave * 32 + r32];
        const bool valid = (ti * 256 + wave * 32 + r32) < total;
        const size_t trow = (size_t)b * SEQ + pos;
        const unsigned msk = SEL[trow * NH + h];
        const int slot = __popc(msk & ((1u << j) - 1u));
        float* wsf = (float*)(lds + mb::L_WS) + wave * 64;
        if (hi == 0) { wsf[r32] = 1.0f / l_reg; if (valid) { float* ml = PARTML + ((trow * NH + h) * 3 + slot) * 2; ml[0] = m_reg; ml[1] = l_reg; } }
        asm volatile("s_waitcnt lgkmcnt(0)" ::: "memory");
        char* stg = lds + wave * 8192;
        mb::stage_rows_bf16(o, wsf, stg, r32, hi);
        asm volatile("s_waitcnt lgkmcnt(0)" ::: "memory");
#pragma unroll
        for (int i = 0; i < 8; ++i) { const int row = (lane >> 4) + 4 * i, ch = lane & 15;
            const int rq = qpos[wave * 32 + row];
            const v4u val = *(const v4u*)(stg + row * 256 + ch * 16);
            const int s = ti * 256 + wave * 32 + row;
            if (s < total) { const size_t tr = (size_t)b * SEQ + rq; const unsigned mk = SEL[tr * NH + h]; const int sl = __popc(mk & ((1u << j) - 1u));
                *(v4u*)(PARTO + ((tr * NH + h) * 3 + sl) * 128 + ch * 8) = val; } }
#undef lane
        __syncthreads();
    }
}

__device__ __forceinline__ void p4_moba_own(KA A, unsigned char* ldsu) {
    PHASE_IDS();
    char* lds = (char*)ldsu;
    unsigned char* ws = A->ws; bf16* PROJ = (bf16*)(ws + WS_PROJ); const unsigned* SEL = (const unsigned*)(ws + WS_SEL);
    const bf16* PARTO = (const bf16*)(ws + WS_PARTO); const float* PARTML = (const float*)(ws + WS_PARTML);
    int* qpos = (int*)(lds + mb::L_QPOS);
    int cur_h = -1;
    for (int it = vcu; it < 16 * NBLK; it += G) {
        const int bh = it >> 5, qb = it & 31, b = bh >> 2, h = bh & 3;
        if (cur_h != h) { cur_h = h; const f32x4* src = (const f32x4*)((const float*)(ws + WS_LUT) + h * SEQ); f32x4* dst = (f32x4*)(lds + mb::L_LUT);
#pragma unroll
            for (int i = 0; i < 4; ++i) dst[tid + i * 512] = src[tid + i * 512]; }
        if (tid < 256) qpos[tid] = qb * 256 + tid;
        __syncthreads();
        const bf16* Qseq = PROJ + (size_t)b * SEQ * INW + C_MQ + h * HD;
        const bf16* Kh = PROJ + ((size_t)b * SEQ + qb * 256) * INW + C_MK + h * HD;
        const bf16* Vh = PROJ + ((size_t)b * SEQ + qb * 256) * INW + C_MV + h * HD;
        mb::f32x16 o[4]; float m_reg, l_reg;
        mb::attend_block<true>(Qseq, Kh, Vh, qb * 256, lds, o, m_reg, l_reg, tid);
        int lane_e = lane; asm volatile("" : "+v"(lane_e));
#define lane lane_e
        const int r32 = lane & 31, hi = lane >> 5;
        const size_t trow0 = (size_t)b * SEQ + qb * 256 + wave * 32;
        float* coef = (float*)(lds + mb::L_COEF) + wave * 128;
        if (hi == 0) {
            const size_t tr = trow0 + r32; const unsigned msk = SEL[tr * NH + h]; const int ns = __popc(msk);
            const float* ml = PARTML + (tr * NH + h) * 6;
            float pm[3], pl[3]; float mx = m_reg;
#pragma unroll
            for (int i = 0; i < 3; ++i) { pm[i] = (i < ns) ? ml[2 * i] : -1e30f; pl[i] = (i < ns) ? ml[2 * i + 1] : 0.f; mx = fmaxf(mx, pm[i]); }
            const float wo = __expf(m_reg - mx); float den = wo * l_reg; float w[3];
#pragma unroll
            for (int i = 0; i < 3; ++i) { w[i] = (i < ns) ? pl[i] * __expf(pm[i] - mx) : 0.f; den += w[i]; }
            const float inv = 1.0f / den;
            coef[r32] = wo * inv; coef[32 + r32] = w[0] * inv; coef[64 + r32] = w[1] * inv; coef[96 + r32] = w[2] * inv;
        }
        asm volatile("s_waitcnt lgkmcnt(0)" ::: "memory");
        char* stg = lds + wave * 8192;
        mb::stage_rows_bf16(o, coef, stg, r32, hi);
        asm volatile("s_waitcnt lgkmcnt(0)" ::: "memory");
#pragma unroll
        for (int i = 0; i < 8; ++i) { const int row = (lane >> 4) + 4 * i, ch = lane & 15;
            const size_t tr = trow0 + row;
            const v4u ow = *(const v4u*)(stg + row * 256 + ch * 16);
            float acc[8] = {bflo(ow.x), bfhi(ow.x), bflo(ow.y), bfhi(ow.y), bflo(ow.z), bfhi(ow.z), bflo(ow.w), bfhi(ow.w)};
#pragma unroll
            for (int k = 0; k < 3; ++k) { const float c = coef[32 * (k + 1) + row];
                if (c != 0.f) { const v4u pw = *(const v4u*)(PARTO + ((tr * NH + h) * 3 + k) * 128 + ch * 8);
                    acc[0] += c * bflo(pw.x); acc[1] += c * bfhi(pw.x); acc[2] += c * bflo(pw.y); acc[3] += c * bfhi(pw.y); acc[4] += c * bflo(pw.z); acc[5] += c * bfhi(pw.z); acc[6] += c * bflo(pw.w); acc[7] += c * bfhi(pw.w); } }
            const v4u zw = *(const v4u*)(PROJ + tr * INW + C_MZ + h * HD + ch * 8);
            const float z[8] = {bflo(zw.x), bfhi(zw.x), bflo(zw.y), bfhi(zw.y), bflo(zw.z), bfhi(zw.z), bflo(zw.w), bfhi(zw.w)};
#pragma unroll
            for (int e2 = 0; e2 < 8; ++e2) acc[e2] *= z[e2] / (1.0f + __expf(-z[e2]));
            v4u w; w.x = pk2(acc[0], acc[1]); w.y = pk2(acc[2], acc[3]); w.z = pk2(acc[4], acc[5]); w.w = pk2(acc[6], acc[7]);
            *(v4u*)(PROJ + tr * INW + C_MQ + h * HD + ch * 8) = w; }
#undef lane
        __syncthreads();
    }
}

namespace rt {
using mb::bf16x8; using mb::s16x4; using mb::f32x16; using mb::u32x4; using mb::crow; using mb::cvtpk; using mb::v_st; using mb::v_rd_base; using mb::v_rd_off;
typedef short v4i16_t __attribute__((ext_vector_type(4)));
typedef __attribute__((address_space(3))) const char* lds_cptr;
__device__ __forceinline__ s16x4 vtr(lds_cptr p) { return __builtin_bit_cast(s16x4, __builtin_amdgcn_ds_read_tr16_b64_v4i16((__attribute__((address_space(3))) v4i16_t*)p)); }
__device__ __forceinline__ bf16x8 tr_frag(lds_cptr base, int d0, int ks) {
  const s16x4 l = vtr(base + v_rd_off(d0, ks, 0)), h = vtr(base + v_rd_off(d0, ks, 1));
  return (bf16x8){l[0], l[1], l[2], l[3], h[0], h[1], h[2], h[3]};
}
__device__ __forceinline__ void pack32(const f32x16& p, bf16x8& pa0, bf16x8& pa1) {
#define RT_PK4(P, BASE, OUT) do { unsigned a0 = pk2(P[BASE + 0], P[BASE + 1]), a1 = pk2(P[BASE + 2], P[BASE + 3]);     \
    unsigned b0 = pk2(P[BASE + 4], P[BASE + 5]), b1 = pk2(P[BASE + 6], P[BASE + 7]);                              \
    auto r0 = __builtin_amdgcn_permlane32_swap(a0, b0, false, false); auto r1 = __builtin_amdgcn_permlane32_swap(a1, b1, false, false); \
    u32x4 w = {r0[0], r1[0], r0[1], r1[1]}; OUT = *reinterpret_cast<bf16x8*>(&w); } while (0)
  RT_PK4(p, 0, pa0); RT_PK4(p, 8, pa1);
#undef RT_PK4
}
constexpr int SROW = 528;
constexpr int SBLK = 32 * SROW;
}

__device__ __forceinline__ void p2_kvsum_mfma(KA A, unsigned char* ldsu) {
    PHASE_IDS();
    char* lds = (char*)ldsu;
    unsigned char* ws = A->ws; const bf16* PROJ = (const bf16*)(ws + WS_PROJ); bf16* ST = (bf16*)(ws + WS_KV);
    const int r32 = lane & 31, hi = lane >> 5, eb = wave >> 1, db0 = 2 * (wave & 1);
    const rt::lds_cptr kb_ = (rt::lds_cptr)lds + mb::v_rd_base(lane), vb_ = (rt::lds_cptr)lds + 32768 + mb::v_rd_base(lane);
    for (int it = vcu; it < 16 * NCH; it += G) {
        const int bh = it >> 6, c = it & 63, b = bh >> 2, h = bh & 3;
        const size_t t0 = (size_t)b * SEQ + c * 128;
#pragma unroll
        for (int i = 0; i < 4; ++i) { const int ch = tid + i * 512, r = ch >> 4, c16 = ch & 15; const int dst = (r >> 6) * 16384 + mb::v_st(r & 63, c16 * 8);
            *(v4u*)(lds + dst) = *(const v4u*)(PROJ + (t0 + r) * INW + C_RK + h * HD + c16 * 8);
            *(v4u*)(lds + 32768 + dst) = *(const v4u*)(PROJ + (t0 + r) * INW + C_RV + h * HD + c16 * 8); }
        __syncthreads();
        rt::f32x16 acc[2]; acc[0] = rt::f32x16{}; acc[1] = rt::f32x16{};
#pragma unroll
        for (int k8 = 0; k8 < 8; ++k8) { const int buf = (k8 >> 2) * 16384, ks = k8 & 3;
            const rt::bf16x8 af = rt::tr_frag(vb_ + buf, eb, ks);
#pragma unroll
            for (int dd = 0; dd < 2; ++dd) { const rt::bf16x8 bf_ = rt::tr_frag(kb_ + buf, db0 + dd, ks);
                acc[dd] = __builtin_amdgcn_mfma_f32_32x32x16_bf16(af, bf_, acc[dd], 0, 0, 0); } }
        bf16* o = ST + (size_t)it * 16384;
#pragma unroll
        for (int dd = 0; dd < 2; ++dd)
#pragma unroll
            for (int r = 0; r < 16; ++r) o[(32 * eb + rt::crow(r, hi)) * 128 + 32 * (db0 + dd) + r32] = (bf16)(pk2(acc[dd][r], 0.f) & 0xffffu);
        __syncthreads();
    }
}

__device__ __forceinline__ void p4_ret_mfma(KA A, int L, unsigned char* ldsu) {
    PHASE_IDS();
    char* lds = (char*)ldsu;
    unsigned char* ws = A->ws; bf16* PROJ = (bf16*)(ws + WS_PROJ); const bf16* ST = (const bf16*)(ws + WS_KV);
    const int r32 = lane & 31, hi = lane >> 5, wq = wave & 3, eh = wave >> 2;
    char* Ks = lds; char* Ss = lds + 65536;
    const rt::lds_cptr vb_ = (rt::lds_cptr)lds + 32768 + mb::v_rd_base(lane);
    for (int it = vcu; it < 16 * NCH; it += G) {
        const int bh = it >> 6, c = it & 63, b = bh >> 2, h = bh & 3;
        const size_t t0 = (size_t)b * SEQ + c * 128;
        rt::bf16x8 qr[8];
        { const bf16* Qw = PROJ + (t0 + 32 * wq + r32) * INW + C_RQ + h * HD + hi * 8;
#pragma unroll
          for (int d0 = 0; d0 < 8; ++d0) qr[d0] = *reinterpret_cast<const rt::bf16x8*>(Qw + d0 * 16); }
#pragma unroll
        for (int i = 0; i < 4; ++i) { const int ch = tid + i * 512, r = ch >> 4, c16 = ch & 15;
            *(v4u*)(Ks + MB_KSWZ(r, c16 * 16)) = *(const v4u*)(PROJ + (t0 + r) * INW + C_RK + h * HD + c16 * 8);
            *(v4u*)(lds + 32768 + (r >> 6) * 16384 + mb::v_st(r & 63, c16 * 8)) = *(const v4u*)(PROJ + (t0 + r) * INW + C_RV + h * HD + c16 * 8);
            *(v4u*)(Ss + MB_KSWZ(r, c16 * 16)) = *(const v4u*)(ST + (size_t)it * 16384 + r * 128 + c16 * 8); }
        __syncthreads();
        rt::f32x16 o[2]; o[0] = rt::f32x16{}; o[1] = rt::f32x16{};
#pragma unroll
        for (int kb = 0; kb < 4; ++kb) {
            if (kb <= wq) {
                rt::f32x16 p = rt::f32x16{};
#pragma unroll
                for (int d0 = 0; d0 < 8; ++d0) { const rt::bf16x8 kf = *reinterpret_cast<const rt::bf16x8*>(Ks + MB_KSWZ(32 * kb + r32, (d0 * 16 + hi * 8) * 2));
                    p = __builtin_amdgcn_mfma_f32_32x32x16_bf16(kf, qr[d0], p, 0, 0, 0); }
                if (kb == wq) {
#pragma unroll
                    for (int r = 0; r < 16; ++r) p[r] = (rt::crow(r, hi) <= r32) ? p[r] : 0.f; }
                rt::bf16x8 pa0, pa1; rt::pack32(p, pa0, pa1);
                const int buf = (kb >> 1) * 16384, ks0 = 2 * (kb & 1);
#pragma unroll
                for (int dd = 0; dd < 2; ++dd) { const rt::bf16x8 v0 = rt::tr_frag(vb_ + buf, 2 * eh + dd, ks0), v1 = rt::tr_frag(vb_ + buf, 2 * eh + dd, ks0 + 1);
                    o[dd] = __builtin_amdgcn_mfma_f32_32x32x16_bf16(pa0, v0, o[dd], 0, 0, 0);
                    o[dd] = __builtin_amdgcn_mfma_f32_32x32x16_bf16(pa1, v1, o[dd], 0, 0, 0); }
            }
        }
#pragma unroll
        for (int dd = 0; dd < 2; ++dd)
#pragma unroll
            for (int s = 0; s < 8; ++s) { const rt::bf16x8 sf = *reinterpret_cast<const rt::bf16x8*>(Ss + MB_KSWZ(32 * (2 * eh + dd) + r32, (s * 16 + hi * 8) * 2));
                o[dd] = __builtin_amdgcn_mfma_f32_32x32x16_bf16(qr[s], sf, o[dd], 0, 0, 0); }
        __syncthreads();
        { char* stg = lds + wq * rt::SBLK;
#pragma unroll
          for (int dd = 0; dd < 2; ++dd)
#pragma unroll
              for (int r = 0; r < 16; ++r) *(float*)(stg + rt::crow(r, hi) * rt::SROW + (32 * (2 * eh + dd) + r32) * 4) = o[dd][r]; }
        __syncthreads();
        {   int tid_e = tid; asm volatile("" : "+v"(tid_e));
            const int n = tid_e >> 2, part = tid_e & 3;
            const char* src = lds + (n >> 5) * rt::SBLK + (n & 31) * rt::SROW + part * 128;
            float ov[32];
#pragma unroll
            for (int q = 0; q < 8; ++q) { const f32x4 v = *(const f32x4*)(src + q * 16); ov[q * 4 + 0] = v[0]; ov[q * 4 + 1] = v[1]; ov[q * 4 + 2] = v[2]; ov[q * 4 + 3] = v[3]; }
            float sm = 0.f;
#pragma unroll
            for (int i = 0; i < 32; ++i) sm += ov[i];
            sm += __shfl_xor(sm, 1); sm += __shfl_xor(sm, 2);
            const float mean = sm * (1.0f / 128.0f);
            float vr = 0.f;
#pragma unroll
            for (int i = 0; i < 32; ++i) { const float dlt = ov[i] - mean; vr += dlt * dlt; }
            vr += __shfl_xor(vr, 1); vr += __shfl_xor(vr, 2);
            const float rstd = 1.0f / sqrtf(vr * (1.0f / 128.0f) + pg8::EPS);
            const float* gn = A->ret_norm_g + L * 512 + h * HD + part * 32;
            const bf16* zrow = PROJ + (t0 + n) * INW + C_RZ + h * HD + part * 32;
            bf16* orow = PROJ + (t0 + n) * INW + C_RQ + h * HD + part * 32;
#pragma unroll
            for (int q = 0; q < 4; ++q) { const v4u zw = *(const v4u*)(zrow + q * 8); const f32x4 g0 = *(const f32x4*)(gn + q * 8), g1 = *(const f32x4*)(gn + q * 8 + 4);
                const float z[8] = {bflo(zw.x), bfhi(zw.x), bflo(zw.y), bfhi(zw.y), bflo(zw.z), bfhi(zw.z), bflo(zw.w), bfhi(zw.w)};
                float r[8];
#pragma unroll
                for (int e = 0; e < 8; ++e) { const float gg = (e < 4) ? g0[e & 3] : g1[e & 3]; r[e] = (ov[q * 8 + e] - mean) * rstd * gg * (z[e] / (1.0f + __expf(-z[e]))); }
                v4u w; w.x = pk2(r[0], r[1]); w.y = pk2(r[2], r[3]); w.z = pk2(r[4], r[5]); w.w = pk2(r[6], r[7]);
                *(v4u*)(orow + q * 8) = w; }
        }
        __syncthreads();
    }
}

__global__ void __launch_bounds__(NWAVES * 64, 2) hymba_fwd(Args args_unused) {
    extern __shared__ __attribute__((aligned(16))) unsigned char lds[];
    LAS unsigned char* ldsl = (LAS unsigned char*)lds;
    volatile LAS unsigned* MISC = (volatile LAS unsigned*)(ldsl + MISC_OFF);
    { const int tid = threadIdx.x; for (int u = tid; u < (LDS_BYTES - LDSCTL_OFF) / 4; u += NWAVES * 64) ((LAS unsigned*)(ldsl + LDSCTL_OFF))[u] = 0u; }
    __syncthreads();
    (void)xcd_barrier_post((unsigned*)(get_ka()->ws + WS_CTL) + CW_BAR, MISC + 8);
#define GRID_BAR() do { XcdBarrier b_; b_.bar = (unsigned*)(get_ka()->ws + WS_CTL) + CW_BAR; b_.x = xb_xcc_id(); b_.st = (volatile LAS unsigned*)((LAS unsigned char*)lds + MISC_OFF) + 8; xcd_barrier(b_); } while (0)
#define WSP(T, off) ((T*)(ka->ws + (off)))

    p0_prologue(get_ka(), ldsl);
    GRID_BAR();

    for (int L = 0; L < DEPTH; ++L) {
#define INPROJ_PART(KIND) {   KA ka = get_ka(); int bx = blockIdx.x; asm volatile("" : "+s"(bx)); const int G = gridDim.x; \
            pg8::Gemm g{WSP(bf16, WS_XB), WSP(const bf16, WS_WIN) + (size_t)L * INW * DM, M, INW, DM, DM}; pg8::SubsetOrder S; S.init(M, KIND, G, bx); \
            pg8::EpiProj<KIND> E{WSP(bf16, WS_PROJ), INW, WSP(float, WS_RSX), WSP(const float, WS_TAB), ka->q_norm_g + L * HD, ka->k_norm_g + L * HD, WSP(float, WS_KMEAN), (LAS float*)(ldsl + RING_BYTES)}; \
            pg8::gemm_phase<pg8::EpiProj<KIND>, pg8::SubsetOrder, true, true>(ldsl + RING_OFF, g, S, E); }
        INPROJ_PART(2)
        INPROJ_PART(0)
        INPROJ_PART(1)
        {   KA ka = get_ka(); int bx = blockIdx.x; asm volatile("" : "+s"(bx)); const int G = gridDim.x;
            pg8::Gemm g{WSP(bf16, WS_PE), WSP(const bf16, WS_WPLE) + (size_t)L * DM * PLE, M, DM, PLE, PLE}; pg8::StaticOrder S; S.init(M, DM, G, bx);
            pg8::EpiE E{WSP(bf16, WS_EPRE), DM, WSP(float, WS_RSE)};
            pg8::gemm_phase<pg8::EpiE, pg8::StaticOrder, true, true>(ldsl + RING_OFF, g, S, E); }
        GRID_BAR();
        p2_kvsum_mfma(get_ka(), lds);
        p2b_gating_lists(get_ka(), lds);
        GRID_BAR();
        p3_scan(get_ka());
        p3_moba_sel(get_ka(), lds);
        GRID_BAR();
        p4_ret_mfma(get_ka(), L, lds);
        p4_moba_own(get_ka(), lds);
        GRID_BAR();
        {   KA ka = get_ka(); int bx = blockIdx.x; asm volatile("" : "+s"(bx)); const int G = gridDim.x;
            pg8::Gemm g{WSP(bf16, WS_PROJ), WSP(const bf16, WS_WOUT) + (size_t)L * DM * DM, M, DM, DM, INW}; pg8::StaticOrder S; S.init(M, DM, G, bx);
            pg8::EpiRes E{(L == 0) ? ka->x : (const float*)ka->out, ka->out, WSP(bf16, WS_PROJ) + C_X1B, WSP(float, WS_RSX1), DM, INW};
            pg8::gemm_phase<pg8::EpiRes, pg8::StaticOrder, true, true>(ldsl + RING_OFF, g, S, E); }
        GRID_BAR();
        {   KA ka = get_ka(); int bx = blockIdx.x; asm volatile("" : "+s"(bx)); const int G = gridDim.x;
            pg8::Gemm g{WSP(bf16, WS_PROJ) + C_X1B, WSP(const bf16, WS_WG) + (size_t)L * DM * DM, M, DM, DM, INW}; pg8::StaticOrder S; S.init(M, DM, G, bx);
            pg8::EpiGate E{ka->out, WSP(const bf16, WS_EPRE), WSP(const float, WS_RSX1), WSP(const float, WS_RSE), ka->ple_norm_g + L * DM, WSP(bf16, WS_XB), WSP(float, WS_RSX), DM};
            pg8::gemm_phase<pg8::EpiGate, pg8::StaticOrder, true, true>(ldsl + RING_OFF, g, S, E); }
        if (L + 1 < DEPTH) {
            {   KA ka = get_ka(); PHASE_IDS();
                const long gtid = (long)vcu * (NWAVES * 64) + tid, gthreads = (long)G * NWAVES * 64;
                cvt_f32_bf16(ka->p + (size_t)(L + 1) * M * PLE, WSP(bf16, WS_PE), (long)M * PLE / 8, gtid, gthreads); }
            GRID_BAR();
        }
    }
}

extern "C" void kernel_launch(void* const* d_in, const int* in_sizes, int n_in, void* d_out, int out_size, void* d_ws, size_t ws_size, hipStream_t stream) {
    static int grid = 0;
    if (grid == 0) {
        if (n_in != 12 || in_sizes[0] != M * DM || out_size != M * DM || ws_size < 512 * MiB) {
            fprintf(stderr, "kernel_launch: shape mismatch: n_in %d in0 %d out %d ws %zu (need >= %zu)\n", n_in, n_in > 0 ? in_sizes[0] : -1, out_size, ws_size, (size_t)(512 * MiB)); grid = -1; return; }
        int dev = 0, cus = 0, per_cu = 0;
        if (hipGetDevice(&dev) != hipSuccess || hipDeviceGetAttribute(&cus, hipDeviceAttributeMultiprocessorCount, dev) != hipSuccess) { fprintf(stderr, "kernel_launch: device query failed\n"); grid = -1; return; }
        if (hipFuncSetAttribute((const void*)hymba_fwd, hipFuncAttributeMaxDynamicSharedMemorySize, LDS_BYTES) != hipSuccess) { fprintf(stderr, "kernel_launch: hipFuncSetAttribute failed\n"); grid = -1; return; }
        if (hipOccupancyMaxActiveBlocksPerMultiprocessor(&per_cu, (const void*)hymba_fwd, NWAVES * 64, LDS_BYTES) != hipSuccess || per_cu < 1)
            fprintf(stderr, "kernel_launch: note: occupancy query reports %d workgroups per CU\n", per_cu);
        (void)hipGetLastError();
        grid = cus;
        fprintf(stderr, "kernel_launch: grid %d, ws %zu bytes\n", grid, ws_size);
    }
    if (grid < 0) return;
    if (hipMemsetAsync((char*)d_ws + WS_CTL, 0, CTL_ZERO_BYTES, stream) != hipSuccess) { fprintf(stderr, "kernel_launch: memset failed\n"); return; }
    Args a{};
    a.x = (const float*)d_in[0]; a.p = (const float*)d_in[1]; a.norm_g = (const float*)d_in[2]; a.w_in = (const float*)d_in[3]; a.ret_norm_g = (const float*)d_in[4];
    a.q_norm_g = (const float*)d_in[5]; a.k_norm_g = (const float*)d_in[6]; a.rel_bias = (const float*)d_in[7]; a.w_out = (const float*)d_in[8]; a.w_ple = (const float*)d_in[9];
    a.ple_norm_g = (const float*)d_in[10]; a.w_ple_gate = (const float*)d_in[11]; a.out = (float*)d_out; a.ws = (unsigned char*)d_ws;
    hipLaunchKernelGGL(hymba_fwd, dim3(grid), dim3(NWAVES * 64), LDS_BYTES, stream, a);
    const hipError_t le = hipPeekAtLastError();
    if (le != hipSuccess) fprintf(stderr, "kernel_launch: launch failed: %s\n", hipGetErrorName(le));
}
```

```cpp
#include <hip/hip_runtime.h>
#include <cstdio>
#include <cstdint>

namespace pg8 {
#define PG8_LAS __attribute__((address_space(3)))
typedef unsigned short bf16_t;
typedef short bf16x8 __attribute__((ext_vector_type(8)));
typedef float f32x4 __attribute__((ext_vector_type(4)));
typedef unsigned u32x4 __attribute__((ext_vector_type(4)));
typedef unsigned u32x2 __attribute__((ext_vector_type(2)));
constexpr int BM = 256, BK = 64, HALF = 128, HTB = HALF * BK * 2  , STAGE_BYTES = 8 * HTB, NXCD = 8, WGM = 8;

__host__ __device__ __forceinline__ int lds_byte(int r, int c) { const int st = (r >> 4) * 2 + (c >> 5), rr = r & 15, cc = c & 31, ob = rr * 64 + cc * 2; return st * 1024 + (ob ^ (((ob >> 9) & 1) << 5)); }
__host__ __device__ __forceinline__ void stage_rc(int b, int& R, int& C) { const int st = b / 1024, sb = b % 1024, swz = sb ^ (((sb >> 9) & 1) << 5); R = (st >> 1) * 16 + swz / 64; C = (st & 1) * 32 + (swz % 64) / 2; }
__host__ __device__ __forceinline__ int perm32(int rho) { const int n = rho >> 4, i = rho & 15; return 8 * (i >> 2) + 4 * n + (i & 3); }

struct Unit { int pm, pn; };
struct Gemm { const bf16_t* A; const bf16_t* Bt; int M, N, K, lda; };

struct StaticOrder {
    int nM, nN, nwg, G, c;
    __host__ __device__ __forceinline__ void init(int M, int N, int G_, int c_) { nM = M / BM; nN = N / BM; nwg = nM * nN; G = G_; c = c_; }
    __host__ __device__ __forceinline__ bool next(int i, Unit& u) const {
        const long L = (long)i * G + c; if (L >= nwg) return false;
        int wgid = (int)L; { const int q = nwg / NXCD, r = nwg % NXCD, xcd = wgid % NXCD, off = wgid / NXCD; wgid = (xcd < r ? xcd * (q + 1) : r * (q + 1) + (xcd - r) * q) + off; }
        const int nig = WGM * nN, gid = wgid / nig, fm = gid * WGM, gsz = (nM - fm) < WGM ? (nM - fm) : WGM;
        u.pm = fm + ((wgid % nig) % gsz); u.pn = (wgid % nig) / gsz; return true;
    }
    __device__ __forceinline__ void a_ready(const Unit&) const {}
    __device__ __forceinline__ void done(const Unit&) const {}
};

struct SubsetOrder {
    StaticOrder S; int kind;
    __host__ __device__ __forceinline__ void init(int M, int kind_, int G_, int c_) { kind = kind_; S.init(M, (kind_ >= 2 ? 8 : 4) * BM, G_, c_); }
    __host__ __device__ __forceinline__ bool next(int i, Unit& u) const {
        if (!S.next(i, u)) return false;
        const int p = u.pn; u.pn = (kind == 0) ? ((p & 1) + 4 * (p >> 1)) : (kind == 1) ? (2 + (p & 1) + 8 * (p >> 1)) : (kind == 2) ? (6 + p + 2 * (p >> 2)) : (p < 6 ? p : p + 4); return true;
    }
    __device__ __forceinline__ void a_ready(const Unit&) const {}
    __device__ __forceinline__ void done(const Unit&) const {}
};

typedef float f32x2 __attribute__((ext_vector_type(2)));
typedef __bf16 bf16x2_t __attribute__((ext_vector_type(2)));
__device__ __forceinline__ unsigned pk2(float lo, float hi) { f32x2 v = {lo, hi}; bf16x2_t b = __builtin_convertvector(v, bf16x2_t); return __builtin_bit_cast(unsigned, b); }
__device__ __forceinline__ float bflo(unsigned w) { return __uint_as_float(w << 16); }
__device__ __forceinline__ float bfhi(unsigned w) { return __uint_as_float(w & 0xffff0000u); }
__device__ __forceinline__ float sum16(const float* p) {
    const f32x4 a = *(const f32x4*)p, b = *(const f32x4*)(p + 4), c = *(const f32x4*)(p + 8), d = *(const f32x4*)(p + 12);
    return (((a[0] + a[1]) + (a[2] + a[3])) + ((b[0] + b[1]) + (b[2] + b[3]))) + (((c[0] + c[1]) + (c[2] + c[3])) + ((d[0] + d[1]) + (d[2] + d[3])));
}
constexpr float EPS = 1e-6f;
__device__ __forceinline__ float rowsum16(const float* p16, int fq) {
    const f32x4 a = *(const f32x4*)(p16 + 4 * fq); float s = (a[0] + a[1]) + (a[2] + a[3]);
    s += __shfl_xor(s, 16); s += __shfl_xor(s, 32); return s;
}

#ifndef ROT_UP_L
#define ROT_UP_L 3
#endif
template <int KIND  , bool LDSR  > struct EpiProj {
    static constexpr bool PERM = true, AFTER_DRAIN = false;
    bf16_t* O; int ldc; const float* rss; const float* tab  ; const float* qg; const float* kg; float* kmean  ; PG8_LAS float* xl; const PG8_LAS float* rl  ; bf16_t* kvc  ;
    bf16_t* qc;
    f32x4 f0, f1, f2, f3; PG8_LAS float* rw;
    __device__ __forceinline__ void after_stage(int) const {
        if constexpr (LDSR) { if (rw) { const float t = (((f0[0] + f0[1]) + (f0[2] + f0[3])) + ((f1[0] + f1[1]) + (f1[2] + f1[3]))) + (((f2[0] + f2[1]) + (f2[2] + f2[3])) + ((f3[0] + f3[1]) + (f3[2] + f3[3]))); *rw = 1.0f / sqrtf(t * (1.0f / 1024.0f) + EPS); } } }
    __device__ __forceinline__ void store8(bf16_t* p, const f32x4& v0, const f32x4& v1) const { u32x4 w; w.x = pk2(v0[0], v0[1]); w.y = pk2(v0[2], v0[3]); w.z = pk2(v1[0], v1[1]); w.w = pk2(v1[2], v1[3]); *(u32x4*)p = w; }
    __device__ __forceinline__ void operator()(const f32x4 (&acc)[2][2][4][2], const Unit& u, int wr, int wc, int fr, int fq) const {
        const int row0 = u.pm * BM + wr * 64 + fr, col0 = u.pn * BM + wc * 32 + 8 * fq;
        const int grp = u.pn >> 1;
        f32x4 T0[KIND == 0 ? 4 : 1][2], T1[KIND == 0 ? 4 : 1][2], g0, g1;
        if constexpr (KIND == 0) {
#pragma unroll
            for (int m = 0; m < 0; ++m)
#pragma unroll
                for (int ai = 0; ai < 2; ++ai) { const int pos = (row0 + ai * HALF + m * 16) & 8191; const f32x4* cs = (const f32x4*)(tab + ((size_t)pos * 64 + 16 * wc + 4 * fq) * 2); T0[m][ai] = cs[0]; T1[m][ai] = cs[1]; }
        }
        if constexpr (KIND == 1) { const float* gp = ((grp == 1) ? qg : kg) + wc * 32 + 8 * fq; g0 = *(const f32x4*)gp; g1 = *(const f32x4*)(gp + 4); }
        float rstd[2][4];
        if constexpr (LDSR) { const PG8_LAS float* rp = rl + ((u.pm >> 3) & 1) * 256 + wr * 64 + fr;
#pragma unroll
            for (int ai = 0; ai < 2; ++ai)
#pragma unroll
                for (int m = 0; m < 4; ++m) rstd[ai][m] = rp[ai * HALF + m * 16];
        } else {
#pragma unroll
            for (int ai = 0; ai < 2; ++ai)
#pragma unroll
                for (int m = 0; m < 4; ++m) rstd[ai][m] = 1.0f / sqrtf(rowsum16(rss + (size_t)(row0 + ai * HALF + m * 16) * 16, fq) * (1.0f / 1024.0f) + EPS);
        }
        asm volatile("" ::: "memory");
        if (KIND == 0 || (KIND == 3 && (grp == 0 || grp == 2))) {
            constexpr int ROT_UP = LDSR ? ROT_UP_L : 2;
            float lg2[2];
#pragma unroll
            for (int bj = 0; bj < 2; ++bj) lg2[bj] = log2f(1.0f - exp2f(-5.0f - (float)(2 * (u.pn & 1) + bj)));
            if constexpr (KIND == 0) {
#pragma unroll
                for (int m = 0; m < ROT_UP; ++m)
#pragma unroll
                    for (int ai = 0; ai < 2; ++ai) { const int pos = (row0 + ai * HALF + m * 16) & 8191; const f32x4* cs = (const f32x4*)(tab + ((size_t)pos * 64 + 16 * wc + 4 * fq) * 2); T0[m][ai] = cs[0]; T1[m][ai] = cs[1]; }
                asm volatile("" ::: "memory");
            }
#pragma unroll
            for (int m = 0; m < 4; ++m) { const float jf = (float)(wr * 64 + m * 16 + fr);
                float sc[2];
#pragma unroll
                for (int bj = 0; bj < 2; ++bj) sc[bj] = (grp == 0) ? exp2f(jf * lg2[bj]) : 0.08838834764831845f * exp2f(-jf * lg2[bj]);
#pragma unroll
                for (int ai = 0; ai < 2; ++ai) { const int row = row0 + ai * HALF + m * 16;
                    const f32x4 cs0 = T0[KIND == 0 ? m : 0][ai], cs1 = T1[KIND == 0 ? m : 0][ai];
                    bf16_t* rowp = O + (size_t)row * ldc + col0;
#pragma unroll
                    for (int bj = 0; bj < 2; ++bj) { const float r = rstd[ai][m]; const f32x4 a0 = acc[ai][bj][m][0] * r, a1 = acc[ai][bj][m][1] * r; const float s = sc[bj];
                        f32x4 v0, v1;
                        v0[0] = (a0[0] * cs0[0] - a0[1] * cs0[1]) * s; v0[1] = (a0[0] * cs0[1] + a0[1] * cs0[0]) * s; v0[2] = (a0[2] * cs0[2] - a0[3] * cs0[3]) * s; v0[3] = (a0[2] * cs0[3] + a0[3] * cs0[2]) * s;
                        v1[0] = (a1[0] * cs1[0] - a1[1] * cs1[1]) * s; v1[1] = (a1[0] * cs1[1] + a1[1] * cs1[0]) * s; v1[2] = (a1[2] * cs1[2] - a1[3] * cs1[3]) * s; v1[3] = (a1[2] * cs1[3] + a1[3] * cs1[2]) * s;
                        store8(rowp + bj * HALF, v0, v1); } }
                if (KIND == 0 && m + ROT_UP < 4) {
                    asm volatile("" ::: "memory");
#pragma unroll
                    for (int ai = 0; ai < 2; ++ai) { const int pos = (row0 + ai * HALF + (m + ROT_UP) * 16) & 8191; const f32x4* cs = (const f32x4*)(tab + ((size_t)pos * 64 + 16 * wc + 4 * fq) * 2); T0[KIND == 0 ? (m + ROT_UP) & 3 : 0][ai] = cs[0]; T1[KIND == 0 ? (m + ROT_UP) & 3 : 0][ai] = cs[1]; }
                    asm volatile("" ::: "memory"); } }
        } else if (KIND == 1 || KIND == 3) {
            PG8_LAS float* P = xl;
#pragma unroll
            for (int ai = 0; ai < 2; ++ai)
#pragma unroll
                for (int m = 0; m < 4; ++m)
#pragma unroll
                    for (int bj = 0; bj < 2; ++bj) { const float r = rstd[ai][m]; const f32x4 a0 = acc[ai][bj][m][0] * r, a1 = acc[ai][bj][m][1] * r;
                        float s = ((a0[0] * a0[0] + a0[1] * a0[1]) + (a0[2] * a0[2] + a0[3] * a0[3])) + ((a1[0] * a1[0] + a1[1] * a1[1]) + (a1[2] * a1[2] + a1[3] * a1[3]));
                        s += __shfl_xor(s, 16); s += __shfl_xor(s, 32);
                        if (fq == 0) P[((ai * HALF + wr * 64 + m * 16 + fr) * 2 + bj) * 4 + wc] = s; }
            asm volatile("s_waitcnt lgkmcnt(0)" ::: "memory"); __builtin_amdgcn_s_barrier(); asm volatile("" ::: "memory");
            const float qs = (grp == 1) ? 0.08838834764831845f : 1.0f;
            f32x4 cs0[2], cs1[2];
#pragma unroll
            for (int bj = 0; bj < 2; ++bj) { cs0[bj] = (f32x4){0.f, 0.f, 0.f, 0.f}; cs1[bj] = (f32x4){0.f, 0.f, 0.f, 0.f}; }
#pragma unroll
            for (int ai = 0; ai < 2; ++ai)
#pragma unroll
                for (int m = 0; m < 4; ++m) { const int row = row0 + ai * HALF + m * 16;
                    bf16_t* rowp = (LDSR && grp == 5) ? kvc + ((size_t)u.pm * 8 + 2 * (u.pn & 1)) * 32768 + (row & 255) * 128 + wc * 32 + 8 * fq
                                 : (LDSR && grp == 1) ? qc + ((size_t)((row >> 13) * 4 + 2 * (u.pn & 1)) * 8192 + (row & 8191)) * 128 + wc * 32 + 8 * fq
                                 : O + (size_t)row * ldc + col0;
                    const int bjs = (LDSR && grp == 5) ? 32768 : (LDSR && grp == 1) ? 8192 * 128 : HALF;
#pragma unroll
                    for (int bj = 0; bj < 2; ++bj) { const f32x4 pq = *(const PG8_LAS f32x4*)(P + ((ai * HALF + wr * 64 + m * 16 + fr) * 2 + bj) * 4);
                        const float tot = (pq[0] + pq[1]) + (pq[2] + pq[3]);
                        const float r = rstd[ai][m] * qs / sqrtf(tot * (1.0f / 128.0f) + EPS);
                        const f32x4 v0 = acc[ai][bj][m][0] * r * g0, v1 = acc[ai][bj][m][1] * r * g1;
                        if (grp == 5) { cs0[bj] += v0; cs1[bj] += v1; }
                        store8(rowp + bj * bjs, v0, v1); } }
            if (grp == 5) {
                PG8_LAS float* KS = xl + 2048;
#pragma unroll
                for (int bj = 0; bj < 2; ++bj)
#pragma unroll
                    for (int e = 0; e < 4; ++e) { float a = cs0[bj][e], b = cs1[bj][e];
                        a += __shfl_xor(a, 1); a += __shfl_xor(a, 2); a += __shfl_xor(a, 4); a += __shfl_xor(a, 8);
                        b += __shfl_xor(b, 1); b += __shfl_xor(b, 2); b += __shfl_xor(b, 4); b += __shfl_xor(b, 8);
                        if (fr == 0) { KS[wr * 256 + bj * HALF + wc * 32 + 8 * fq + e] = a; KS[wr * 256 + bj * HALF + wc * 32 + 8 * fq + 4 + e] = b; } }
                asm volatile("s_waitcnt lgkmcnt(0)" ::: "memory"); __builtin_amdgcn_s_barrier(); asm volatile("" ::: "memory");
                const int t = (wr * 4 + wc) * 64 + fq * 16 + fr;
                if (t < 256) { const int b = u.pm >> 5, blk = u.pm & 31, hh = 2 * (u.pn & 1) + (t >> 7);
                    kmean[((size_t)(b * 4 + hh) * 32 + blk) * 128 + (t & 127)] = (KS[t] + KS[256 + t]) * (1.0f / 256.0f); }
            }
            asm volatile("s_waitcnt lgkmcnt(0)" ::: "memory"); __builtin_amdgcn_s_barrier(); asm volatile("" ::: "memory");
        } else {
#pragma unroll
            for (int ai = 0; ai < 2; ++ai)
#pragma unroll
                for (int m = 0; m < 4; ++m) { const int row = row0 + ai * HALF + m * 16; const float r = rstd[ai][m];
                    bf16_t* rowp = (LDSR && grp == 6) ? kvc + ((size_t)u.pm * 8 + 4 + 2 * (u.pn & 1)) * 32768 + (row & 255) * 128 + wc * 32 + 8 * fq : O + (size_t)row * ldc + col0;
                    const int bjs = (LDSR && grp == 6) ? 32768 : HALF;
#pragma unroll
                    for (int bj = 0; bj < 2; ++bj) { const f32x4 v0 = acc[ai][bj][m][0] * r, v1 = acc[ai][bj][m][1] * r;
                        if (grp == 4 || grp == 7) { u32x4 w; w.x = pk2(v0[0], v0[1]); w.y = pk2(v0[2], v0[3]); w.z = pk2(v1[0], v1[1]); w.w = pk2(v1[2], v1[3]); __builtin_nontemporal_store(w, (u32x4*)(rowp + bj * HALF)); }
                        else store8(rowp + bj * bjs, v0, v1); } }
        }
    }
};
struct EpiE {
    static constexpr bool PERM = true, AFTER_DRAIN = false;
    __device__ __forceinline__ void after_stage(int) const {}
    bf16_t* O; int ldc; float* rs;
    __device__ __forceinline__ void operator()(const f32x4 (&acc)[2][2][4][2], const Unit& u, int wr, int wc, int fr, int fq) const {
        const int row0 = u.pm * BM + wr * 64 + fr, col0 = u.pn * BM + wc * 32 + 8 * fq;
#pragma unroll
        for (int ai = 0; ai < 2; ++ai)
#pragma unroll
            for (int m = 0; m < 4; ++m) { const int row = row0 + ai * HALF + m * 16; float s = 0.f;
                bf16_t* rowp = O + (size_t)row * ldc + col0;
#pragma unroll
                for (int bj = 0; bj < 2; ++bj) { const f32x4 v0 = acc[ai][bj][m][0], v1 = acc[ai][bj][m][1];
                    s += (v0[0] * v0[0] + v0[1] * v0[1]) + (v0[2] * v0[2] + v0[3] * v0[3]); s += (v1[0] * v1[0] + v1[1] * v1[1]) + (v1[2] * v1[2] + v1[3] * v1[3]);
                    u32x4 w; w.x = pk2(v0[0], v0[1]); w.y = pk2(v0[2], v0[3]); w.z = pk2(v1[0], v1[1]); w.w = pk2(v1[2], v1[3]);
                    *(u32x4*)(rowp + bj * HALF) = w; }
                s += __shfl_xor(s, 16); s += __shfl_xor(s, 32);
                if (fq == 0) rs[(size_t)row * 16 + u.pn * 4 + wc] = s; }
    }
};
template <bool BASE_BF16> struct EpiRes {
    static constexpr bool PERM = true, AFTER_DRAIN = false;
    __device__ __forceinline__ void after_stage(int) const {}
    const void* base; bf16_t* xb; float* rs; int ldc; int ldxb;
    __device__ __forceinline__ void operator()(const f32x4 (&acc)[2][2][4][2], const Unit& u, int wr, int wc, int fr, int fq) const {
#if defined(EXP_NOEPI_RES)
        if (acc[0][0][0][0][0] != 123456.789f) return;
#endif
        const int row0 = u.pm * BM + wr * 64 + fr, col0 = u.pn * BM + wc * 32 + 8 * fq;
        static_assert(BASE_BF16, "f32 base: not used");
        u32x4 bsh[2][4][2];
#pragma unroll
        for (int ai = 0; ai < 2; ++ai)
#pragma unroll
            for (int m = 0; m < 4; ++m) { const size_t off = (size_t)(row0 + ai * HALF + m * 16) * ldc + col0;
#pragma unroll
                for (int bj = 0; bj < 2; ++bj) bsh[ai][m][bj] = __builtin_nontemporal_load((const u32x4*)((const bf16_t*)base + off + bj * HALF)); }
        asm volatile("" ::: "memory");
#pragma unroll
        for (int ai = 0; ai < 2; ++ai) {
#pragma unroll
            for (int m = 0; m < 4; ++m) { const int row = row0 + ai * HALF + m * 16; float s = 0.f; const size_t offb = (size_t)row * ldxb + col0;
#pragma unroll
                for (int bj = 0; bj < 2; ++bj) { f32x4 b0, b1;
                    { const u32x4 w = bsh[ai][m][bj]; b0[0] = bflo(w.x); b0[1] = bfhi(w.x); b0[2] = bflo(w.y); b0[3] = bfhi(w.y); b1[0] = bflo(w.z); b1[1] = bfhi(w.z); b1[2] = bflo(w.w); b1[3] = bfhi(w.w); }
                    const f32x4 x0 = b0 + acc[ai][bj][m][0], x1 = b1 + acc[ai][bj][m][1];
                    s += ((x0[0] * x0[0] + x0[1] * x0[1]) + (x0[2] * x0[2] + x0[3] * x0[3])) + ((x1[0] * x1[0] + x1[1] * x1[1]) + (x1[2] * x1[2] + x1[3] * x1[3]));
                    u32x4 w; w.x = pk2(x0[0], x0[1]); w.y = pk2(x0[2], x0[3]); w.z = pk2(x1[0], x1[1]); w.w = pk2(x1[2], x1[3]); *(u32x4*)(xb + offb + bj * HALF) = w; }
                s += __shfl_xor(s, 16); s += __shfl_xor(s, 32);
                if (fq == 0) rs[(size_t)row * 16 + u.pn * 4 + wc] = s; }
            asm volatile("" ::: "memory");
        }
    }
};
#ifndef GATE_PIPE
#define GATE_PIPE 1
#endif
#ifndef GATE_L0
#define GATE_L0 3
#define GATE_L1 5
#endif
template <bool LAST, bool LDSR  > struct EpiGate {
    static constexpr bool PERM = true, AFTER_DRAIN = false;
    const bf16_t* x1b; int ldx1; const bf16_t* epre; const float* rs1; const float* rse; const float* pg; bf16_t* xb; float* rso; float* out; int ldc; const PG8_LAS float* r1l; const PG8_LAS float* rel; const PG8_LAS float* gl  ;
    f32x4 f1q[4], feq[4]; float gq; PG8_LAS float* rw;
    __device__ __forceinline__ void after_stage(int tid) const {
        if constexpr (LDSR) {
            const float t1 = (((f1q[0][0] + f1q[0][1]) + (f1q[0][2] + f1q[0][3])) + ((f1q[1][0] + f1q[1][1]) + (f1q[1][2] + f1q[1][3]))) + (((f1q[2][0] + f1q[2][1]) + (f1q[2][2] + f1q[2][3])) + ((f1q[3][0] + f1q[3][1]) + (f1q[3][2] + f1q[3][3])));
            const float te = (((feq[0][0] + feq[0][1]) + (feq[0][2] + feq[0][3])) + ((feq[1][0] + feq[1][1]) + (feq[1][2] + feq[1][3]))) + (((feq[2][0] + feq[2][1]) + (feq[2][2] + feq[2][3])) + ((feq[3][0] + feq[3][1]) + (feq[3][2] + feq[3][3])));
            rw[0] = 1.0f / sqrtf(t1 * (1.0f / 1024.0f) + EPS); rw[512] = 1.0f / sqrtf(te * (1.0f / 1024.0f) + EPS); if (tid < 256) rw[1024] = gq; } }
    template <int R0, int RG> __device__ __forceinline__ void issue(u32x4 (&xw)[RG][2], u32x4 (&ew)[RG][2], f32x4 (&q1)[LDSR ? 1 : RG], f32x4 (&qe)[LDSR ? 1 : RG], int row0, int col0, int fq) const {
        if constexpr (!LDSR) {
#pragma unroll
            for (int mm = 0; mm < RG; ++mm) { const int ai = (R0 + mm) >> 2, m = (R0 + mm) & 3; const size_t r16 = (size_t)(row0 + ai * HALF + m * 16) * 16 + 4 * fq; q1[mm] = *(const f32x4*)(rs1 + r16); qe[mm] = *(const f32x4*)(rse + r16); } }
#pragma unroll
        for (int mm = 0; mm < RG; ++mm) { const int ai = (R0 + mm) >> 2, m = (R0 + mm) & 3; const int row = row0 + ai * HALF + m * 16;
#pragma unroll
            for (int bj = 0; bj < 2; ++bj) { xw[mm][bj] = *(const u32x4*)(x1b + (size_t)row * ldx1 + col0 + bj * HALF); ew[mm][bj] = __builtin_nontemporal_load((const u32x4*)(epre + (size_t)row * ldc + col0 + bj * HALF)); } }
        asm volatile("" ::: "memory");
    }
    template <int R0, int RG> __device__ __forceinline__ void finish(const f32x4 (&acc)[2][2][4][2], const f32x4 (&g)[2][2], const u32x4 (&xw)[RG][2], const u32x4 (&ew)[RG][2], const f32x4 (&q1)[LDSR ? 1 : RG], const f32x4 (&qe)[LDSR ? 1 : RG],
                                                              const Unit& u, int row0, int col0, int wc, int fq) const {
        float r1[RG], re[RG];
#pragma unroll
        for (int mm = 0; mm < RG; ++mm) {
            if constexpr (LDSR) { const int ai = (R0 + mm) >> 2, m = (R0 + mm) & 3; const int li = ((u.pm >> 3) & 1) * 256 + (row0 & 255) + ai * HALF + m * 16; r1[mm] = r1l[li]; re[mm] = rel[li]; }
            else { float s1 = (q1[mm][0] + q1[mm][1]) + (q1[mm][2] + q1[mm][3]), se = (qe[mm][0] + qe[mm][1]) + (qe[mm][2] + qe[mm][3]);
                s1 += __shfl_xor(s1, 16); s1 += __shfl_xor(s1, 32); se += __shfl_xor(se, 16); se += __shfl_xor(se, 32);
                r1[mm] = 1.0f / sqrtf(s1 * (1.0f / 1024.0f) + EPS); re[mm] = 1.0f / sqrtf(se * (1.0f / 1024.0f) + EPS); } }
#pragma unroll
        for (int mm = 0; mm < RG; ++mm) { const int ai = (R0 + mm) >> 2, m = (R0 + mm) & 3; const int row = row0 + ai * HALF + m * 16; float s = 0.f; const size_t off = (size_t)row * ldc + col0;
#pragma unroll
            for (int bj = 0; bj < 2; ++bj) { const size_t o = off + bj * HALF; const u32x4 e4 = ew[mm][bj], x4 = xw[mm][bj];
                f32x4 xo[2];
#pragma unroll
                for (int n = 0; n < 2; ++n) { const f32x4 a = acc[ai][bj][m][n] * r1[mm]; const unsigned e_lo = n ? e4.z : e4.x, e_hi = n ? e4.w : e4.y, x_lo = n ? x4.z : x4.x, x_hi = n ? x4.w : x4.y;
                    f32x4 gg; if constexpr (LDSR) gg = *(const PG8_LAS f32x4*)(gl + (col0 & 255) + bj * HALF + n * 4); else gg = g[bj][n];
                    f32x4 e; e[0] = bflo(e_lo); e[1] = bfhi(e_lo); e[2] = bflo(e_hi); e[3] = bfhi(e_hi); e = e * re[mm] * gg;
                    f32x4 xr; xr[0] = bflo(x_lo); xr[1] = bfhi(x_lo); xr[2] = bflo(x_hi); xr[3] = bfhi(x_hi);
                    f32x4 sg; sg[0] = __builtin_amdgcn_rcpf(1.0f + __expf(-a[0])); sg[1] = __builtin_amdgcn_rcpf(1.0f + __expf(-a[1])); sg[2] = __builtin_amdgcn_rcpf(1.0f + __expf(-a[2])); sg[3] = __builtin_amdgcn_rcpf(1.0f + __expf(-a[3]));
                    xo[n] = xr + sg * e; }
                if constexpr (LAST) { __builtin_nontemporal_store(xo[0], (f32x4*)(out + o)); __builtin_nontemporal_store(xo[1], (f32x4*)(out + o + 4)); }
                else { s += ((xo[0][0] * xo[0][0] + xo[0][1] * xo[0][1]) + (xo[0][2] * xo[0][2] + xo[0][3] * xo[0][3])) + ((xo[1][0] * xo[1][0] + xo[1][1] * xo[1][1]) + (xo[1][2] * xo[1][2] + xo[1][3] * xo[1][3]));
                    u32x4 w; w.x = pk2(xo[0][0], xo[0][1]); w.y = pk2(xo[0][2], xo[0][3]); w.z = pk2(xo[1][0], xo[1][1]); w.w = pk2(xo[1][2], xo[1][3]); *(u32x4*)(xb + o) = w; } }
            if constexpr (!LAST) { s += __shfl_xor(s, 16); s += __shfl_xor(s, 32); if (fq == 0) rso[(size_t)row * 16 + u.pn * 4 + wc] = s; } }
        asm volatile("" ::: "memory");
    }
    template <int R0, int RG> __device__ __forceinline__ void batch(const f32x4 (&acc)[2][2][4][2], const f32x4 (&g)[2][2], const Unit& u, int row0, int col0, int wc, int fq) const {
        u32x4 xw[RG][2], ew[RG][2]; f32x4 q1[LDSR ? 1 : RG], qe[LDSR ? 1 : RG];
        issue<R0, RG>(xw, ew, q1, qe, row0, col0, fq); finish<R0, RG>(acc, g, xw, ew, q1, qe, u, row0, col0, wc, fq);
    }
    __device__ __forceinline__ void operator()(const f32x4 (&acc)[2][2][4][2], const Unit& u, int wr, int wc, int fr_, int fq_) const {
        int t_ = (int)__builtin_amdgcn_mbcnt_hi(~0u, __builtin_amdgcn_mbcnt_lo(~0u, 0u)); asm volatile("" : "+v"(t_));
        const int fr = t_ & 15, fq = t_ >> 4;
        const int row0 = u.pm * BM + wr * 64 + fr, col0 = u.pn * BM + wc * 32 + 8 * fq;
        f32x4 g[2][2];
        if constexpr (!LDSR) {
#pragma unroll
            for (int bj = 0; bj < 2; ++bj)
#pragma unroll
                for (int n = 0; n < 2; ++n) g[bj][n] = *(const f32x4*)(pg + col0 + bj * HALF + n * 4);
            asm volatile("" ::: "memory"); }
        if constexpr (LDSR && GATE_PIPE) {
            u32x4 x0[1][2], e0[1][2], x1_[1][2], e1[1][2], x2[1][2], e2[1][2]; f32x4 qd[1], qf[1];
            issue<0, 1>(x0, e0, qd, qf, row0, col0, fq); issue<1, 1>(x1_, e1, qd, qf, row0, col0, fq); issue<2, 1>(x2, e2, qd, qf, row0, col0, fq);
            finish<0, 1>(acc, g, x0, e0, qd, qf, u, row0, col0, wc, fq); issue<3, 1>(x0, e0, qd, qf, row0, col0, fq);
            finish<1, 1>(acc, g, x1_, e1, qd, qf, u, row0, col0, wc, fq); issue<4, 1>(x1_, e1, qd, qf, row0, col0, fq);
            finish<2, 1>(acc, g, x2, e2, qd, qf, u, row0, col0, wc, fq); issue<5, 1>(x2, e2, qd, qf, row0, col0, fq);
            finish<3, 1>(acc, g, x0, e0, qd, qf, u, row0, col0, wc, fq); issue<6, 1>(x0, e0, qd, qf, row0, col0, fq);
            finish<4, 1>(acc, g, x1_, e1, qd, qf, u, row0, col0, wc, fq); issue<7, 1>(x1_, e1, qd, qf, row0, col0, fq);
            finish<5, 1>(acc, g, x2, e2, qd, qf, u, row0, col0, wc, fq);
            finish<6, 1>(acc, g, x0, e0, qd, qf, u, row0, col0, wc, fq);
            finish<7, 1>(acc, g, x1_, e1, qd, qf, u, row0, col0, wc, fq);
        } else if constexpr (LDSR) {
            batch<0, GATE_L0>(acc, g, u, row0, col0, wc, fq);
            batch<GATE_L0, GATE_L1>(acc, g, u, row0, col0, wc, fq);
            if constexpr (GATE_L0 + GATE_L1 < 8) batch<GATE_L0 + GATE_L1, 8 - GATE_L0 - GATE_L1>(acc, g, u, row0, col0, wc, fq);
        } else { batch<0, 2>(acc, g, u, row0, col0, wc, fq); batch<2, 2>(acc, g, u, row0, col0, wc, fq); batch<4, 2>(acc, g, u, row0, col0, wc, fq); batch<6, 2>(acc, g, u, row0, col0, wc, fq); }
    }
};

template <class Epi, class Sched, bool ALIGN_EPI = false, bool SP2 = false, bool CHAIN = false>
__device__ __forceinline__ void gemm_phase(PG8_LAS unsigned char* lds, const Gemm g, const Sched& S, const Epi& E, const bool chain_in = false, const char* chainA = nullptr, const char* chainB = nullptr) {
    static_assert(!CHAIN || (ALIGN_EPI && SP2 && !Epi::AFTER_DRAIN), "CHAIN needs aligned epilogues");
    int tid = threadIdx.x; asm volatile("" : "+v"(tid));
    const int wid = __builtin_amdgcn_readfirstlane(tid >> 6), lane = tid & 63, wr = wid >> 2, wc = wid & 3, fr = lane & 15, fq = lane >> 4;
    const int K = g.K, lda = g.lda, nt = K / BK;
    unsigned voffA[2], voffB[2];
#pragma unroll
    for (int i = 0; i < 2; ++i) { int R, C; stage_rc(tid * 16 + i * 8192, R, C); const int Rb = Epi::PERM ? ((R & ~31) + perm32(R & 31)) : R;
        voffA[i] = (unsigned)(R * lda + C) * 2u; voffB[i] = (unsigned)(Rb * K + C) * 2u; }
    const size_t kstep = (size_t)(BK * 2);
    const size_t hstepB = (size_t)HALF * K * 2, hstepA = (size_t)HALF * lda * 2;
    const size_t tstepB = 2 * hstepB, tstepA = 2 * hstepA;
    const unsigned ldsw = (unsigned)wid * 1024u;
    const int aoff = lds_byte(wr * 64 + fr, fq * 8), boff = lds_byte(wc * 32 + fr, fq * 8);
#define PG8_SA(b, h) (((b) * 2 + (h)) * HTB)
#define PG8_SB(b, h) ((4 + (b) * 2 + (h)) * HTB)
#define PG8_STAGE(bufoff, gbase, voff) do { _Pragma("unroll") for (int _i = 0; _i < 2; ++_i) \
        __builtin_amdgcn_global_load_lds((const unsigned*)((const char*)(gbase) + (voff)[_i]), (PG8_LAS unsigned*)(lds + (bufoff) + ldsw + _i * 8192), 16, 0, 0); } while (0)
#define PG8_LDA(dst, b, h) do { _Pragma("unroll") for (int m = 0; m < 4; ++m) _Pragma("unroll") for (int k = 0; k < 2; ++k) dst[m][k] = *(const PG8_LAS bf16x8*)(lds + PG8_SA(b, h) + aoff + m * 2048 + k * 1024); } while (0)
#define PG8_LDB(dst, b, h) do { _Pragma("unroll") for (int n = 0; n < 2; ++n) _Pragma("unroll") for (int k = 0; k < 2; ++k) dst[n][k] = *(const PG8_LAS bf16x8*)(lds + PG8_SB(b, h) + boff + n * 2048 + k * 1024); } while (0)
#define PG8_MMA(ai, bj, At, Bt) do { __builtin_amdgcn_s_setprio(1); _Pragma("unroll") for (int m = 0; m < 4; ++m) _Pragma("unroll") for (int n = 0; n < 2; ++n) _Pragma("unroll") for (int k = 0; k < 2; ++k) \
        acc[ai][bj][m][n] = __builtin_amdgcn_mfma_f32_16x16x32_bf16(Bt[n][k], At[m][k], acc[ai][bj][m][n], 0, 0, 0); __builtin_amdgcn_s_setprio(0); } while (0)
#define PG8_WAIT_V(n) asm volatile("s_waitcnt vmcnt(" #n ")" ::: "memory")
#define PG8_WAIT_L(n) asm volatile("s_waitcnt lgkmcnt(" #n ")" ::: "memory")
#define PG8_BAR __builtin_amdgcn_s_barrier()
#define PG8_SCHED __builtin_amdgcn_sched_barrier(0)
    Unit cur, nxt; int ui = 0;
    if (!S.next(0, cur)) return;
    f32x4 acc[2][2][4][2];
#pragma unroll
    for (int a = 0; a < 2; ++a)
#pragma unroll
        for (int b = 0; b < 2; ++b)
#pragma unroll
            for (int m = 0; m < 4; ++m)
#pragma unroll
                for (int n = 0; n < 2; ++n) acc[a][b][m][n] = (f32x4){0.f, 0.f, 0.f, 0.f};
    bf16x8 At[4][2], B0[2][2], B1[2][2];
    const char* cA = (const char*)g.A + (size_t)cur.pm * tstepA; const char* cB = (const char*)g.Bt + (size_t)cur.pn * tstepB;
    S.a_ready(cur);
    if (CHAIN && chain_in) { if (wr == 1) PG8_BAR; }
    else if constexpr (SP2) {
        PG8_STAGE(PG8_SB(0, 0), cB, voffB); PG8_STAGE(PG8_SB(0, 1), cB + hstepB, voffB); PG8_STAGE(PG8_SA(0, 0), cA, voffA); PG8_STAGE(PG8_SA(0, 1), cA + hstepA, voffA);
        E.after_stage(tid);
        if (wr == 1) PG8_BAR;
        PG8_WAIT_V(2); PG8_BAR;
        PG8_STAGE(PG8_SB(1, 0), cB + kstep, voffB); PG8_STAGE(PG8_SA(1, 0), cA + kstep, voffA); PG8_STAGE(PG8_SB(1, 1), cB + hstepB + kstep, voffB);
        PG8_WAIT_V(6); PG8_BAR;
    } else {
        PG8_STAGE(PG8_SB(0, 0), cB, voffB); PG8_STAGE(PG8_SA(0, 0), cA, voffA); PG8_STAGE(PG8_SB(0, 1), cB + hstepB, voffB); PG8_STAGE(PG8_SA(0, 1), cA + hstepA, voffA);
        if (wr == 1) PG8_BAR;
        PG8_WAIT_V(4); PG8_BAR;
        PG8_STAGE(PG8_SB(1, 0), cB + kstep, voffB); PG8_STAGE(PG8_SA(1, 0), cA + kstep, voffA); PG8_STAGE(PG8_SB(1, 1), cB + hstepB + kstep, voffB);
        PG8_WAIT_V(6); PG8_BAR;
    }
    for (;;) {
        const bool has_next = S.next(ui + 1, nxt);
        const char* nA = has_next ? (const char*)g.A + (size_t)nxt.pm * tstepA : (CHAIN && chainA) ? chainA : cA; const char* nB = has_next ? (const char*)g.Bt + (size_t)nxt.pn * tstepB : (CHAIN && chainA) ? chainB : cB;
#if defined(EXP_KSTAMP)
        if (blockIdx.x == 0 && tid == 0) { volatile PG8_LAS unsigned* M_ = (volatile PG8_LAS unsigned*)(lds + 163136); const unsigned k_ = M_[31]; M_[32 + k_] = (unsigned)__builtin_amdgcn_s_memrealtime(); M_[31] = k_ + 1; }
#endif
#pragma nounroll
        for (int t = 0; t < nt; t += 2) {
            const bool last = (t == nt - 2);
            const char* a1 = cA + (size_t)(t + 1) * kstep;
            const char* a2 = last ? nA : cA + (size_t)(t + 2) * kstep; const char* b2 = last ? nB : cB + (size_t)(t + 2) * kstep;
            const char* a3 = a2 + kstep; const char* b3 = b2 + kstep;
            if (last && has_next) S.a_ready(nxt);
            if constexpr (SP2) {
            PG8_LDB(B0, 0, 0); PG8_LDB(B1, 0, 1); PG8_SCHED; PG8_LDA(At, 0, 0); PG8_STAGE(PG8_SA(1, 1), a1 + hstepA, voffA);
            PG8_WAIT_V(8); PG8_WAIT_L(0); PG8_BAR; PG8_MMA(0, 0, At, B0); PG8_MMA(0, 1, At, B1); PG8_BAR; PG8_SCHED;
            PG8_LDA(At, 0, 1); PG8_STAGE(PG8_SB(0, 0), b2, voffB); PG8_STAGE(PG8_SB(0, 1), b2 + hstepB, voffB); PG8_STAGE(PG8_SA(0, 0), a2, voffA);
            PG8_WAIT_V(8); PG8_WAIT_L(0); PG8_BAR; PG8_MMA(1, 0, At, B0); PG8_MMA(1, 1, At, B1); PG8_BAR; PG8_SCHED;
            PG8_LDB(B0, 1, 0); PG8_LDB(B1, 1, 1); PG8_SCHED; PG8_LDA(At, 1, 0); PG8_STAGE(PG8_SA(0, 1), a2 + hstepA, voffA);
            PG8_WAIT_V(8); PG8_WAIT_L(0); PG8_BAR; PG8_MMA(0, 0, At, B0); PG8_MMA(0, 1, At, B1); PG8_BAR; PG8_SCHED;
            PG8_LDA(At, 1, 1); PG8_STAGE(PG8_SB(1, 0), b3, voffB); PG8_STAGE(PG8_SB(1, 1), b3 + hstepB, voffB); PG8_STAGE(PG8_SA(1, 0), a3, voffA);
            PG8_WAIT_V(8); PG8_WAIT_L(0); PG8_BAR; PG8_MMA(1, 0, At, B0); PG8_MMA(1, 1, At, B1); PG8_BAR; PG8_SCHED;
            } else {
            PG8_LDB(B0, 0, 0); PG8_SCHED; PG8_LDA(At, 0, 0); PG8_STAGE(PG8_SA(1, 1), a1 + hstepA, voffA);
            PG8_WAIT_L(8); PG8_BAR; PG8_WAIT_L(0); PG8_MMA(0, 0, At, B0); PG8_BAR; PG8_SCHED;
            PG8_LDB(B1, 0, 1); PG8_STAGE(PG8_SB(0, 0), b2, voffB);
            PG8_BAR; PG8_WAIT_L(0); PG8_MMA(0, 1, At, B1); PG8_BAR;
            PG8_LDA(At, 0, 1); PG8_STAGE(PG8_SA(0, 0), a2, voffA);
            PG8_BAR; PG8_WAIT_L(0); PG8_MMA(1, 0, At, B0); PG8_BAR; PG8_SCHED;
            PG8_STAGE(PG8_SB(0, 1), b2 + hstepB, voffB);
            PG8_WAIT_V(6); PG8_BAR; PG8_MMA(1, 1, At, B1); PG8_BAR;
            PG8_LDB(B0, 1, 0); PG8_SCHED; PG8_LDA(At, 1, 0); PG8_STAGE(PG8_SA(0, 1), a2 + hstepA, voffA);
            PG8_WAIT_L(8); PG8_BAR; PG8_WAIT_L(0); PG8_MMA(0, 0, At, B0); PG8_BAR; PG8_SCHED;
            PG8_LDB(B1, 1, 1); PG8_STAGE(PG8_SB(1, 0), b3, voffB);
            PG8_BAR; PG8_WAIT_L(0); PG8_MMA(0, 1, At, B1); PG8_BAR;
            PG8_LDA(At, 1, 1); PG8_STAGE(PG8_SA(1, 0), a3, voffA);
            PG8_BAR; PG8_WAIT_L(0); PG8_MMA(1, 0, At, B0); PG8_BAR; PG8_SCHED;
            PG8_STAGE(PG8_SB(1, 1), b3 + hstepB, voffB);
            PG8_WAIT_V(6); PG8_BAR; PG8_MMA(1, 1, At, B1); PG8_BAR;
            }
        }
#if defined(EXP_KSTAMP)
        if (blockIdx.x == 0 && tid == 0) { volatile PG8_LAS unsigned* M_ = (volatile PG8_LAS unsigned*)(lds + 163136); const unsigned k_ = M_[31]; M_[32 + k_] = (unsigned)__builtin_amdgcn_s_memrealtime(); M_[31] = k_ + 1; }
#endif
        if constexpr (ALIGN_EPI) { if (wr == 0) PG8_BAR; }
#if defined(EXP_NOEPI)
        if constexpr (!Epi::AFTER_DRAIN) { if (acc[0][0][0][0][0] == 123456.789f) E(acc, cur, wr, wc, fr, fq); S.done(cur); }
#else
        if constexpr (!Epi::AFTER_DRAIN) { E(acc, cur, wr, wc, fr, fq); S.done(cur); }
#endif
        if (!has_next) break;
#pragma unroll
        for (int a = 0; a < 2; ++a)
#pragma unroll
            for (int b = 0; b < 2; ++b)
#pragma unroll
                for (int m = 0; m < 4; ++m)
#pragma unroll
                    for (int n = 0; n < 2; ++n) acc[a][b][m][n] = (f32x4){0.f, 0.f, 0.f, 0.f};
        cur = nxt; cA = nA; cB = nB; ++ui;
        if constexpr (ALIGN_EPI) { if (wr == 1) PG8_BAR; }
    }
    if (CHAIN && chainA) return;
    PG8_WAIT_V(0);
    if constexpr (!ALIGN_EPI) { if (wr == 0) PG8_BAR; }
    PG8_BAR;
    if constexpr (Epi::AFTER_DRAIN) { E.fused(acc, cur, wr, wc, fr, fq, lds, wid, lane); S.done(cur); }
#undef PG8_SA
#undef PG8_SB
#undef PG8_STAGE
#undef PG8_LDA
#undef PG8_LDB
#undef PG8_MMA
#undef PG8_WAIT_V
#undef PG8_WAIT_L
#undef PG8_BAR
#undef PG8_SCHED
}
}

constexpr int NWAVES = 8;
constexpr int DM = 1024, SEQ = 8192, NBATCH = 4, M = NBATCH * SEQ, INW = 4096, PLE = 256, DEPTH = 2, HD = 128, NH = 4, NBLK = 32  , NCH = 64  ;
constexpr int C_RQ = 0, C_MQ = 512, C_RK = 1024, C_RV = 1536, C_RZ = 2048, C_MK = 2560, C_MV = 3072, C_MZ = 3584;
constexpr int C_X1B = 1024;
constexpr float RSQRT_HD = 0.08838834764831845f;

constexpr size_t MiB = 1u << 20;
constexpr size_t WS_CTL = 0, CTL_ZERO_BYTES = 64 * 1024;
constexpr size_t WS_WIN = 1 * MiB;
constexpr size_t WS_WOUT = 17 * MiB;
constexpr size_t WS_WG = 21 * MiB;
constexpr size_t WS_WPLE = 25 * MiB;
constexpr size_t WS_TAB = 26 * MiB;
constexpr size_t WS_LUT = 30 * MiB;
constexpr size_t WS_KMEAN = 30 * MiB + 128 * 1024;
constexpr size_t WS_SEL = 30 * MiB + 512 * 1024;
constexpr size_t WS_RSX = 31 * MiB;
constexpr size_t WS_RSX1 = 33 * MiB;
constexpr size_t WS_RSE = 35 * MiB;
constexpr size_t WS_PE = 37 * MiB;
constexpr size_t WS_PE2 = 213 * MiB;
constexpr size_t WS_KV = 53 * MiB;
constexpr size_t WS_EPRE = 85 * MiB;
constexpr size_t WS_XB = 149 * MiB;
constexpr size_t WS_PROJ = 245 * MiB;
constexpr size_t WS_END = 501 * MiB;
constexpr int CW_BAR = 4096;
constexpr int CW_SCAN = 12288;
constexpr int CW_GRP = 10240;

constexpr int RING_OFF = 0, RING_BYTES = 131072;
constexpr int LDSCTL_OFF = 162816, MISC_OFF = LDSCTL_OFF + 320;
constexpr int LDS_RS_OFF = RING_BYTES + 12288;
constexpr int LDS_BYTES = 163840;

#define GAS __attribute__((address_space(1)))
#define LAS __attribute__((address_space(3)))
typedef unsigned short bf16;
typedef unsigned v4u __attribute__((ext_vector_type(4)));
typedef unsigned v2u __attribute__((ext_vector_type(2)));
typedef float f32x4 __attribute__((ext_vector_type(4)));
typedef float f32x2v __attribute__((ext_vector_type(2)));
typedef GAS unsigned gu32;
#define RLX_AGENT __ATOMIC_RELAXED, __HIP_MEMORY_SCOPE_AGENT
#define LDS_WAIT() asm volatile("s_waitcnt lgkmcnt(0)" ::: "memory")
#define VM_WAIT() asm volatile("s_waitcnt vmcnt(0)" ::: "memory")
using pg8::pk2; using pg8::bflo; using pg8::bfhi;
__device__ __forceinline__ float bf2f(unsigned short u) { return __uint_as_float(((unsigned)u) << 16); }

#if defined(PROBE_T0)
#define PSTAMP() do { if (blockIdx.x == 0 && threadIdx.x == 0) { extern __shared__ unsigned char l_probe_[]; volatile LAS unsigned* M_ = (volatile LAS unsigned*)((LAS unsigned char*)l_probe_ + MISC_OFF); const unsigned k_ = M_[31]; M_[32 + k_] = (unsigned)__builtin_amdgcn_s_memrealtime(); M_[31] = k_ + 1; } } while (0)
#else
#define PSTAMP() do { } while (0)
#endif
#define XB_TMO      128
#define XB_XCNT(j)  (256  + 64 * (j))
#define XB_XSUB(j)  (1280 + 64 * (j))
#define XB_XGEN(j)  (2304 + 64 * (j))
#define XB_TOP      3328
#define XB_TOPGEN   3392
#define XCD_BAR_WORDS 3456
#define XB_SPIN_CAP (1u << 18)

__device__ __forceinline__ unsigned xb_ld(unsigned* p)              { return __hip_atomic_load(p, __ATOMIC_RELAXED, __HIP_MEMORY_SCOPE_AGENT); }
__device__ __forceinline__ unsigned xb_add(unsigned* p, unsigned v) { return __hip_atomic_fetch_add(p, v, __ATOMIC_RELAXED, __HIP_MEMORY_SCOPE_AGENT); }
__device__ __forceinline__ unsigned xb_xcc_id() { return (unsigned)__builtin_amdgcn_s_getreg((3 << 11) | 20) & 0xFu; }
#define XB_SPIN(cond, bar) do { unsigned _sp = 0; while (cond) { __builtin_amdgcn_s_sleep(1); \
    if ((++_sp & 255u) == 0u) { if (xb_ld(&(bar)[XB_TMO])) break; if (_sp > XB_SPIN_CAP) { atomicAdd(&(bar)[XB_TMO], 1u); break; } } } } while (0)

struct XcdBarrier {
    unsigned* bar; unsigned x;
    volatile LAS unsigned* st;
};

__device__ __forceinline__ XcdBarrier xcd_barrier_post(unsigned* bar, volatile LAS unsigned* st) {
    XcdBarrier b; b.bar = bar; b.x = xb_xcc_id(); b.st = st;
    if (threadIdx.x == 0) (void)xb_add(&bar[XB_XCNT(b.x)], 1u);
    return b;
}
__device__ __forceinline__ void xcd_barrier_complete(unsigned* bar, unsigned x, unsigned& nloc, unsigned& nx, unsigned& xmask) {
    const unsigned G = gridDim.x * gridDim.y * gridDim.z;
    unsigned sum, cnt, mine, msk, sp = 0u;
    for (;;) {
        sum = 0u; cnt = 0u; mine = 0u; msk = 0u;
#pragma nounroll
        for (unsigned j = 0; j < 16; ++j) { const unsigned c = xb_ld(&bar[XB_XCNT(j)]); sum += c; cnt += (c > 0u) ? 1u : 0u; msk |= (c > 0u) ? (1u << j) : 0u; mine = (j == x) ? c : mine; }
        if (sum == G) break;
        __builtin_amdgcn_s_sleep(1);
        if ((++sp & 255u) == 0u) { if (xb_ld(&bar[XB_TMO])) break; if (sp > XB_SPIN_CAP) { atomicAdd(&bar[XB_TMO], 1u); break; } }
    }
    nloc = mine > 0u ? mine : 1u; nx = cnt > 0u ? cnt : 1u; xmask = msk;
}

__device__ __forceinline__ void xcd_barrier(const XcdBarrier& b) {
    asm volatile("s_waitcnt vmcnt(0)" ::: "memory");
    __syncthreads();
    if (threadIdx.x == 64) { asm volatile("buffer_inv sc1" ::: "memory"); asm volatile("s_waitcnt vmcnt(0)" ::: "memory"); }
    if (threadIdx.x == 0) {
        unsigned* bar = b.bar;
        __builtin_amdgcn_s_waitcnt(0);
        unsigned nloc = b.st[0], nx = b.st[1];
        if (nloc == 0u) { unsigned xm; xcd_barrier_complete(bar, b.x, nloc, nx, xm); b.st[0] = nloc; b.st[1] = nx; b.st[2] = xm; }
        const unsigned old = xb_add(&bar[XB_XSUB(b.x)], 1u);
        const unsigned gen = old / nloc;
        if (old + 1u == (gen + 1u) * nloc) {
            __builtin_amdgcn_fence(__ATOMIC_RELEASE, "agent");
            asm volatile("s_waitcnt vmcnt(0)" ::: "memory");
            const unsigned og = xb_add(&bar[XB_TOP], 1u);
            const unsigned tg = og / nx;
            if (og + 1u == (tg + 1u) * nx) {
                const unsigned xm = b.st[2];
#pragma nounroll
                for (unsigned j = 0; j < 16; ++j) if ((xm >> j) & 1u) xb_add(&bar[XB_XGEN(j)], 1u);
            } else XB_SPIN(xb_ld(&bar[XB_XGEN(b.x)]) == gen, bar);
            asm volatile("s_waitcnt vmcnt(0)" ::: "memory");
        } else {
            XB_SPIN(xb_ld(&bar[XB_XGEN(b.x)]) == gen, bar);
            asm volatile("s_waitcnt vmcnt(0)" ::: "memory");
            asm volatile("s_waitcnt vmcnt(0)" ::: "memory");
        }
    }
    __syncthreads();
}

__device__ __forceinline__ float wave_sum(float v) {
#pragma unroll
    for (int o = 1; o < 64; o <<= 1) v += __shfl_xor(v, o);
    return v;
}
__device__ __forceinline__ float wave_max(float v) {
#pragma unroll
    for (int o = 1; o < 64; o <<= 1) v = fmaxf(v, __shfl_xor(v, o));
    return v;
}
__device__ __forceinline__ float ret_log2g(int h) { return log2f(1.0f - exp2f(-5.0f - (float)h)); }

__device__ __forceinline__ int win_dst(int c) {
    const int g = c >> 9, w = c & 511, hd = w >> 7, i = w & 127;
    const int base = (g == 0) ? C_RQ : (g == 1) ? C_RK : (g == 2) ? C_RV : (g == 3) ? C_RZ : (g == 4) ? C_MQ : (g == 5) ? C_MK : (g == 6) ? C_MV : C_MZ;
    const int pos = (g <= 1) ? ((i < 64) ? 2 * i : 2 * (i - 64) + 1) : i;
    return base + hd * 128 + pos;
}
template <int MODE>
__device__ __forceinline__ void p0_transpose_item(const float* W, int K, int N, bf16* WT, const float* gk, LAS float* scr, int item, int lane) {
    const int nblk = N / 32, kb = item / nblk, nb = item % nblk, k0 = 64 * kb, n0 = 32 * nb;
    float wv[32];
#pragma unroll
    for (int i = 0; i < 32; ++i) { const int kk = 2 * i + (lane >> 5); wv[i] = __builtin_nontemporal_load(W + (size_t)(k0 + kk) * N + n0 + (lane & 31)); }
#pragma unroll
    for (int i = 0; i < 32; ++i) { const int kk = 2 * i + (lane >> 5); float v = wv[i]; if (MODE == 1) v *= gk[k0 + kk]; scr[kk * 33 + (lane & 31)] = v; }
    LDS_WAIT(); asm volatile("" ::: "memory");
    const int c = lane & 7;
#pragma unroll
    for (int j = 0; j < 4; ++j) { const int n = (lane >> 3) + 8 * j; const LAS float* s = scr + (8 * c) * 33 + n;
        v4u o; o.x = pk2(s[0 * 33], s[1 * 33]); o.y = pk2(s[2 * 33], s[3 * 33]); o.z = pk2(s[4 * 33], s[5 * 33]); o.w = pk2(s[6 * 33], s[7 * 33]);
        const int dst = (MODE == 1) ? win_dst(n0 + n) : (n0 + n);
        *(v4u*)(WT + (size_t)dst * K + k0 + 8 * c) = o; }
    LDS_WAIT(); asm volatile("" ::: "memory");
}
__device__ __forceinline__ void cvt_f32_bf16(const float* src, bf16* dst, long n8, long gtid, long gthreads) {
    long i = gtid;
    for (; i + 3 * gthreads < n8; i += 4 * gthreads) {
        f32x4 a[4], b[4];
#pragma unroll
        for (int k = 0; k < 4; ++k) { a[k] = __builtin_nontemporal_load((const f32x4*)(src + (i + k * gthreads) * 8)); b[k] = __builtin_nontemporal_load((const f32x4*)(src + (i + k * gthreads) * 8 + 4)); }
#pragma unroll
        for (int k = 0; k < 4; ++k) { v4u w; w.x = pk2(a[k][0], a[k][1]); w.y = pk2(a[k][2], a[k][3]); w.z = pk2(b[k][0], b[k][1]); w.w = pk2(b[k][2], b[k][3]); *(v4u*)(dst + (i + k * gthreads) * 8) = w; }
    }
    for (; i < n8; i += gthreads) {
        const f32x4 a = *(const f32x4*)(src + i * 8), b = *(const f32x4*)(src + i * 8 + 4);
        v4u w; w.x = pk2(a[0], a[1]); w.y = pk2(a[2], a[3]); w.z = pk2(b[0], b[1]); w.w = pk2(b[2], b[3]);
        *(v4u*)(dst + i * 8) = w; }
}
__device__ __forceinline__ void sincos_d(double a, double& s, double& c) {
    const double k = rint(a * 0.63661977236758134308);
    double r = fma(-k, 1.57079632679489655800e+00, a); r = fma(-k, 6.12323399573676603587e-17, r);
    const double r2 = r * r;
    double sp = 1.0 / 6227020800.0; sp = fma(sp, r2, -1.0 / 39916800.0); sp = fma(sp, r2, 1.0 / 362880.0); sp = fma(sp, r2, -1.0 / 5040.0); sp = fma(sp, r2, 1.0 / 120.0); sp = fma(sp, r2, -1.0 / 6.0); sp = fma(sp * r2, r, r);
    double cp = 1.0 / 87178291200.0; cp = fma(cp, r2, -1.0 / 479001600.0); cp = fma(cp, r2, 1.0 / 3628800.0); cp = fma(cp, r2, -1.0 / 40320.0); cp = fma(cp, r2, 1.0 / 720.0); cp = fma(cp, r2, -1.0 / 24.0); cp = fma(cp, r2, 0.5); cp = fma(-cp, r2, 1.0);
    const int q = ((int)k) & 3;
    s = (q == 0) ? sp : (q == 1) ? cp : (q == 2) ? -sp : -cp;
    c = (q == 0) ? cp : (q == 1) ? -sp : (q == 2) ? -cp : sp;
}
__device__ __forceinline__ int t5_bucket(int n) {
    if (n < 16) return n;
    const float v = logf((float)n * (1.0f / 16.0f)) / 4.852030263919617f * 16.0f;
    int b = 16 + (int)v; return b > 31 ? 31 : b;
}

struct Args {
    const float* x; const float* p; const float* norm_g; const float* w_in; const float* ret_norm_g; const float* q_norm_g; const float* k_norm_g; const float* rel_bias;
    const float* w_out; const float* w_ple; const float* ple_norm_g; const float* w_ple_gate; float* out; unsigned char* ws;
};
typedef const __attribute__((address_space(4))) Args* KA;
__device__ __forceinline__ KA get_ka() { KA p = (KA)__builtin_amdgcn_kernarg_segment_ptr(); asm volatile("" : "+s"(p)); return p; }
#define PHASE_IDS() int tid = threadIdx.x; asm volatile("" : "+v"(tid)); const int lane = tid & 63; const int wave = __builtin_amdgcn_readfirstlane(tid >> 6); \
    int bx_ = blockIdx.x; asm volatile("" : "+s"(bx_)); const int G = gridDim.x; const int vcu = (G % 8 == 0) ? (bx_ % 8) * (G / 8) + bx_ / 8 : bx_; (void)lane; (void)wave; (void)vcu

__device__ __forceinline__ void p0_prologue(KA A, LAS unsigned char* lds) {
    PHASE_IDS();
    unsigned char* ws = A->ws;
    LAS float* scr = (LAS float*)(lds + RING_OFF + wave * 16384);
    const int gw = vcu * NWAVES + wave, NGW = G * NWAVES;
    constexpr int I_IN = (DM / 64) * (INW / 32), I_O = (DM / 64) * (DM / 32), I_G = I_O, I_P = (PLE / 64) * (DM / 32), I_L = I_IN + I_O + I_G + I_P;
    for (int it = gw; it < DEPTH * I_L; it += NGW) {
        const int L = it / I_L; int r = it % I_L;
        if (r < I_IN) { p0_transpose_item<1>(A->w_in + (size_t)L * DM * INW, DM, INW, (bf16*)(ws + WS_WIN) + (size_t)L * INW * DM, A->norm_g + L * DM, scr, r, lane); continue; } r -= I_IN;
        if (r < I_O) { p0_transpose_item<0>(A->w_out + (size_t)L * DM * DM, DM, DM, (bf16*)(ws + WS_WOUT) + (size_t)L * DM * DM, nullptr, scr, r, lane); continue; } r -= I_O;
        if (r < I_G) { p0_transpose_item<0>(A->w_ple_gate + (size_t)L * DM * DM, DM, DM, (bf16*)(ws + WS_WG) + (size_t)L * DM * DM, nullptr, scr, r, lane); continue; } r -= I_G;
        p0_transpose_item<0>(A->w_ple + (size_t)L * PLE * DM, PLE, DM, (bf16*)(ws + WS_WPLE) + (size_t)L * DM * PLE, nullptr, scr, r, lane);
    }
#if defined(P0_STAMPS)
    PSTAMP();
#endif
    for (int m0 = gw * 4; m0 < M; m0 += NGW * 4) {
        f32x4 v[4][4]; float ss[4];
#pragma unroll
        for (int r = 0; r < 4; ++r) { const f32x4* xr = (const f32x4*)(A->x + (size_t)(m0 + r) * DM) + lane;
#pragma unroll
            for (int j = 0; j < 4; ++j) v[r][j] = __builtin_nontemporal_load(xr + 64 * j); }
#pragma unroll
        for (int r = 0; r < 4; ++r) { float t = 0.f;
#pragma unroll
            for (int j = 0; j < 4; ++j) t += (v[r][j][0] * v[r][j][0] + v[r][j][1] * v[r][j][1]) + (v[r][j][2] * v[r][j][2] + v[r][j][3] * v[r][j][3]);
            ss[r] = wave_sum(t); }
#pragma unroll
        for (int r = 0; r < 4; ++r) { v2u* o8 = (v2u*)((bf16*)(ws + WS_XB) + (size_t)(m0 + r) * DM) + lane;
#pragma unroll
            for (int j = 0; j < 4; ++j) { v2u w; w.x = pk2(v[r][j][0], v[r][j][1]); w.y = pk2(v[r][j][2], v[r][j][3]); o8[64 * j] = w; }
            if (lane < 16) ((float*)(ws + WS_RSX))[(size_t)(m0 + r) * 16 + lane] = (lane == 0) ? ss[r] : 0.f; }
    }
#if defined(P0_STAMPS)
    PSTAMP();
#endif
    const long gtid = (long)vcu * (NWAVES * 64) + tid, gthreads = (long)G * NWAVES * 64;
    cvt_f32_bf16(A->p, (bf16*)(ws + WS_PE), (long)M * PLE / 8, gtid, gthreads);
#if defined(P0_STAMPS)
    PSTAMP();
#endif
    for (long i = gtid; i < (long)SEQ * 64; i += gthreads) {
        const int pos = (int)(i >> 6), fi = (int)(i & 63);
        const float inv = (float)exp2(-(double)fi * (1.0 / 64.0) * 13.287712379549449);
        const float ang = (float)pos * inv;
        double s, c; sincos_d((double)ang, s, c);
        ((f32x2v*)(ws + WS_TAB))[i] = (f32x2v){(float)c, (float)s};
    }
    for (long i = gtid; i < (long)NH * SEQ; i += gthreads) {
        const int h = (int)(i >> 13), n = (int)(i & 8191);
        ((float*)(ws + WS_LUT))[i] = A->rel_bias[t5_bucket(n) * NH + h];
    }
#if defined(P0_STAMPS)
    PSTAMP();
#endif
}

template <bool DYN>
__device__ __forceinline__ void p3_scan(KA A, int L, volatile LAS unsigned* bc  ) {
    PHASE_IDS();
    unsigned* ST = (unsigned*)(A->ws + WS_KV);
    unsigned* ctr = (unsigned*)(A->ws + WS_CTL) + CW_SCAN + L * 32;
    for (int item = vcu; ; item += G) {
        if constexpr (DYN) {
            __syncthreads();
            if (tid == 0) *bc = __hip_atomic_fetch_add(ctr, 1u, __ATOMIC_RELAXED, __HIP_MEMORY_SCOPE_AGENT);
            __syncthreads();
            item = (int)*bc;
        }
        if (item >= 16 * 8192 / (NWAVES * 64)) break;
        const int idx = item * (NWAVES * 64) + tid;
        {
        const int bh = idx >> 13, pr = idx & 8191, h = bh & 3;
        const float lg2 = ret_log2g(h), g1 = exp2f(lg2), g127 = exp2f(127.f * lg2), g128 = exp2f(128.f * lg2);
        unsigned* p = ST + (size_t)bh * NCH * 8192 + pr;
        float s0 = 0.f, s1 = 0.f;
        unsigned w[NCH];
#pragma unroll
        for (int c = 0; c < NCH; ++c) w[c] = p[(size_t)c * 8192];
        asm volatile("" ::: "memory");
#pragma unroll
        for (int c = 0; c < NCH; ++c) {
            p[(size_t)c * 8192] = pk2(g1 * s0, g1 * s1);
            s0 = s0 * g128 + g127 * bflo(w[c]); s1 = s1 * g128 + g127 * bfhi(w[c]);
        }
    } }
}


constexpr size_t WS_PARTML = 501 * MiB;
constexpr size_t WS_LIST = 504 * MiB;
constexpr size_t WS_CNT = 508 * MiB;
constexpr int CW_TOT = 8192;
static_assert((size_t)M * NH * 3 * 128 * 2 <= (size_t)M * DM * 4 && WS_CNT + 16 * 32 * 32 * 4 <= 512 * MiB, "MoBA workspace");

namespace mb {
using bf16x8 = __attribute__((ext_vector_type(8))) short;
using s16x4  = __attribute__((ext_vector_type(4))) short;
using f32x16 = __attribute__((ext_vector_type(16))) float;
using u32x4  = __attribute__((ext_vector_type(4))) unsigned;
constexpr int KVBLK = 64, QBLK = 32;
constexpr int SHM_V = KVBLK * 128 * 2, SHM_K = KVBLK * 128 * 2;
#define MB_KSWZ(row, colB) ((row) * 256 + ((colB) ^ (((row) & 7) << 4)))
#define MB_SBAR() __builtin_amdgcn_sched_barrier(0)
__device__ __forceinline__ int crow(int r, int hi) { return (r & 3) + 8 * (r >> 2) + 4 * hi; }
__device__ __forceinline__ unsigned cvtpk(float lo, float hi) { unsigned r; asm volatile("v_cvt_pk_bf16_f32 %0, %1, %2" : "=v"(r) : "v"(lo), "v"(hi)); return r; }
constexpr float LOG2E = 1.4426950408889634f;
#if defined(EXP_THR)
constexpr float THR = EXP_THR;
#else
constexpr float THR = 4.f;
#endif

__device__ __forceinline__ void partialSM(f32x16& p0, f32x16& p1, float& m_reg, float& mn, float& alpha) {
  float pmax = p0[0];
#pragma unroll
  for (int r = 1; r < 16; ++r) pmax = fmaxf(pmax, p0[r]);
#pragma unroll
  for (int r = 0; r < 16; ++r) pmax = fmaxf(pmax, p1[r]);
  { auto rr = __builtin_amdgcn_permlane32_swap(__float_as_uint(pmax), __float_as_uint(pmax), false, false);
    pmax = fmaxf(__uint_as_float(rr[0]), __uint_as_float(rr[1])); }
  if (__builtin_expect(__all(pmax - m_reg <= THR), 1)) { mn = m_reg; alpha = 1.f; }
  else { mn = fmaxf(m_reg, pmax); alpha = __builtin_amdgcn_exp2f((m_reg - mn) * LOG2E); m_reg = mn; }
  const float mnC = -mn * LOG2E;
#pragma unroll
  for (int r = 0; r < 16; ++r) p0[r] = fmaf(p0[r], LOG2E, mnC);
#pragma unroll
  for (int r = 0; r < 16; ++r) p1[r] = fmaf(p1[r], LOG2E, mnC);
#pragma unroll
  for (int r = 0; r < 16; ++r) p0[r] = __builtin_amdgcn_exp2f(p0[r]);
}
__device__ __forceinline__ void finishSM(f32x16& p0, f32x16& p1, float alpha, float& l_reg, bf16x8& pa0, bf16x8& pa1, bf16x8& pa2, bf16x8& pa3) {
#pragma unroll
  for (int r = 0; r < 16; ++r) p1[r] = __builtin_amdgcn_exp2f(p1[r]);
  float ps = 0;
#pragma unroll
  for (int r = 0; r < 16; ++r) ps += p0[r];
#pragma unroll
  for (int r = 0; r < 16; ++r) ps += p1[r];
  { auto rr = __builtin_amdgcn_permlane32_swap(__float_as_uint(ps), __float_as_uint(ps), false, false);
    ps = __uint_as_float(rr[0]) + __uint_as_float(rr[1]); }
  l_reg = l_reg * alpha + ps;
#define MB_PK4(P, BASE, OUT) do { unsigned a0 = cvtpk(P[BASE + 0], P[BASE + 1]), a1 = cvtpk(P[BASE + 2], P[BASE + 3]);   \
    unsigned b0 = cvtpk(P[BASE + 4], P[BASE + 5]), b1 = cvtpk(P[BASE + 6], P[BASE + 7]);                              \
    auto r0 = __builtin_amdgcn_permlane32_swap(a0, b0, false, false); auto r1 = __builtin_amdgcn_permlane32_swap(a1, b1, false, false); \
    u32x4 w = {r0[0], r1[0], r0[1], r1[1]}; OUT = *reinterpret_cast<bf16x8*>(&w); } while (0)
  MB_PK4(p0, 0, pa0); MB_PK4(p0, 8, pa1); MB_PK4(p1, 0, pa2); MB_PK4(p1, 8, pa3);
#undef MB_PK4
}
__device__ __forceinline__ int v_st(int k, int c) { const int kk = (k & ~0xC) | ((k & 4) << 1) | ((k & 8) >> 1); return ((kk >> 3) * 4 + (c >> 5)) * 512 + ((kk & 7) * 32 + (c & 31)) * 2; }
__device__ __forceinline__ int v_rd_base(int lane) { return ((lane & 3) << 3) | (((lane >> 2) & 3) << 6) | (((lane >> 4) & 1) << 5) | (((lane >> 5) & 1) << 8); }
constexpr int v_rd_off(int d0, int ks, int half) { return d0 * 512 + ks * 4096 + half * 2048; }
}


namespace mb2 {
using mb::bf16x8; using mb::s16x4; using mb::f32x16; using mb::u32x4; using mb::crow; using mb::cvtpk; using mb::v_st; using mb::v_rd_base; using mb::v_rd_off; using mb::LOG2E; using mb::THR;
constexpr int L_K = 0, L_V = 65536, L_STG = 131072  , L_LUT = 147456  , L_WSC = 153856  , WSC_F = 192  , L_TAB = 160000  , L_END = 161024;
static_assert(L_END <= LDSCTL_OFF, "MoBA LDS map");
constexpr int LUT_N = 1600, DQ_CLAMP = LUT_N - 1;

typedef __attribute__((address_space(3))) const char* lds_cptr;
typedef short v4i16_t __attribute__((ext_vector_type(4)));
__device__ __forceinline__ s16x4 vtr(lds_cptr p) { return __builtin_bit_cast(s16x4, __builtin_amdgcn_ds_read_tr16_b64_v4i16((__attribute__((address_space(3))) v4i16_t*)p)); }

template <int IMAX>
__device__ __forceinline__ void qkt(f32x16& p0, f32x16& p1, const char* Ks, const bf16x8* qr, int r32, int hi, int dq, const float* lut) {
  const float* lb = lut + ((dq > IMAX ? IMAX : dq) - 63) - 4 * hi;
#pragma unroll
  for (int r = 0; r < 16; ++r) { p0[r] = lb[63 - crow(r, 0)]; p1[r] = lb[31 - crow(r, 0)]; }
#pragma unroll
  for (int d0 = 0; d0 < 8; ++d0) { const int cb = (d0 * 16 + hi * 8) * 2;
    const bf16x8 b0 = *reinterpret_cast<const bf16x8*>(Ks + MB_KSWZ(r32, cb));
    const bf16x8 b1 = *reinterpret_cast<const bf16x8*>(Ks + MB_KSWZ(32 + r32, cb));
    p0 = __builtin_amdgcn_mfma_f32_32x32x16_bf16(b0, qr[d0], p0, 0, 0, 0);
    p1 = __builtin_amdgcn_mfma_f32_32x32x16_bf16(b1, qr[d0], p1, 0, 0, 0); }
}
__device__ __forceinline__ void pv(f32x16* o, lds_cptr vb, bf16x8 pa0, bf16x8 pa1, bf16x8 pa2, bf16x8 pa3) {
  s16x4 l[2][4], h[2][4];
#pragma unroll
  for (int ks = 0; ks < 4; ++ks) { l[0][ks] = vtr(vb + v_rd_off(0, ks, 0)); h[0][ks] = vtr(vb + v_rd_off(0, ks, 1)); }
#pragma unroll
  for (int d0 = 0; d0 < 4; ++d0) { const int c = d0 & 1, n = c ^ 1;
    if (d0 < 3) {
#pragma unroll
      for (int ks = 0; ks < 4; ++ks) { l[n][ks] = vtr(vb + v_rd_off(d0 + 1, ks, 0)); h[n][ks] = vtr(vb + v_rd_off(d0 + 1, ks, 1)); } }
#define MB2_PK(k) (bf16x8){l[c][k][0], l[c][k][1], l[c][k][2], l[c][k][3], h[c][k][0], h[c][k][1], h[c][k][2], h[c][k][3]}
    o[d0] = __builtin_amdgcn_mfma_f32_32x32x16_bf16(pa0, MB2_PK(0), o[d0], 0, 0, 0);
    o[d0] = __builtin_amdgcn_mfma_f32_32x32x16_bf16(pa1, MB2_PK(1), o[d0], 0, 0, 0);
    o[d0] = __builtin_amdgcn_mfma_f32_32x32x16_bf16(pa2, MB2_PK(2), o[d0], 0, 0, 0);
    o[d0] = __builtin_amdgcn_mfma_f32_32x32x16_bf16(pa3, MB2_PK(3), o[d0], 0, 0, 0);
#undef MB2_PK
  }
}
template <bool OWN, int QRS  >
__device__ __forceinline__ void attend_wave(const bf16* __restrict__ Qseq, int qp, int kpos0, int nt, char* lds, float* wsf, f32x16 (&o)[4], float& m_out, float& l_out, int lane) {
  const int r32 = lane & 31, hi = lane >> 5;
  const char* K_lds = lds + L_K; const lds_cptr vb0 = (lds_cptr)lds + L_V + v_rd_base(lane);
  float* al_l = wsf + 32; const float* lut = (const float*)(lds + L_LUT);
  float m_reg = -1e30f, l_reg = 0; bf16x8 qr[8];
  const bf16* Qw = Qseq + (size_t)qp * QRS + hi * 8;
#pragma unroll
  for (int d0 = 0; d0 < 8; ++d0) qr[d0] = *reinterpret_cast<const bf16x8*>(Qw + d0 * 16);
#pragma unroll
  for (int d = 0; d < 4; ++d) o[d] = f32x16{};
  const int dq0 = qp - kpos0 + (OWN ? 256 : 0); constexpr int IMAX = OWN ? 511 : DQ_CLAMP;
#define MB2_RESC(a) do { if (__any((a) < 1.f)) { if (hi == 0) al_l[r32] = (a); asm volatile("s_waitcnt lgkmcnt(0)" ::: "memory"); \
    _Pragma("unroll") for (int d = 0; d < 4; ++d) _Pragma("unroll") for (int r = 0; r < 16; ++r) o[d][r] *= al_l[crow(r, hi)]; } } while (0)
#pragma nounroll
  for (int t = 0; t < nt; ++t) {
    f32x16 p0, p1; float mn, al; bf16x8 pa0, pa1, pa2, pa3;
    qkt<IMAX>(p0, p1, K_lds + t * 16384, qr, r32, hi, dq0 - 64 * t, lut);
    mb::partialSM(p0, p1, m_reg, mn, al);
    MB2_RESC(al);
    mb::finishSM(p0, p1, al, l_reg, pa0, pa1, pa2, pa3);
    pv(o, vb0 + t * 16384, pa0, pa1, pa2, pa3);
  }
  m_out = m_reg; l_out = l_reg;
#undef MB2_RESC
}
template <int QRS = INW  >
__device__ __forceinline__ void load_q(bf16x8 (&qr)[8], const bf16* __restrict__ Qseq, int qp, int hi) {
  const bf16* Qw = Qseq + (size_t)qp * QRS + hi * 8;
#pragma unroll
  for (int d0 = 0; d0 < 8; ++d0) qr[d0] = *reinterpret_cast<const bf16x8*>(Qw + d0 * 16);
}
template <bool OWN>
__device__ __forceinline__ void attend_wave4(const bf16x8 (&qr)[8], int qp, int kpos0, char* lds, float* wsf, f32x16 (&o)[4], float& m_out, float& l_out, int lane) {
  const int r32 = lane & 31, hi = lane >> 5;
  const char* K_lds = lds + L_K; const lds_cptr vb0 = (lds_cptr)lds + L_V + v_rd_base(lane);
  float* al_l = wsf + 32; const float* lut = (const float*)(lds + L_LUT);
  float m_reg = -1e30f, l_reg = 0;
#pragma unroll
  for (int d = 0; d < 4; ++d) o[d] = f32x16{};
  const int dq0 = qp - kpos0 + (OWN ? 256 : 0); constexpr int IMAX = OWN ? 511 : DQ_CLAMP;
#define MB2_RESC(a) do { if (__any((a) < 1.f)) { if (hi == 0) al_l[r32] = (a); asm volatile("s_waitcnt lgkmcnt(0)" ::: "memory"); \
    _Pragma("unroll") for (int d = 0; d < 4; ++d) _Pragma("unroll") for (int r = 0; r < 16; ++r) o[d][r] *= al_l[crow(r, hi)]; } } while (0)
  f32x16 pA0, pA1, pB0, pB1; float mnA, mnB, alA, alB; bf16x8 pa0, pa1, pa2, pa3;
  qkt<IMAX>(pA0, pA1, K_lds, qr, r32, hi, dq0, lut); mb::partialSM(pA0, pA1, m_reg, mnA, alA);
  MB_SBAR(); qkt<IMAX>(pB0, pB1, K_lds + 16384, qr, r32, hi, dq0 - 64, lut);
  mb::finishSM(pA0, pA1, alA, l_reg, pa0, pa1, pa2, pa3); MB_SBAR();
  pv(o, vb0, pa0, pa1, pa2, pa3); mb::partialSM(pB0, pB1, m_reg, mnB, alB); MB_SBAR(); MB2_RESC(alB);
  MB_SBAR(); qkt<IMAX>(pA0, pA1, K_lds + 2 * 16384, qr, r32, hi, dq0 - 128, lut);
  mb::finishSM(pB0, pB1, alB, l_reg, pa0, pa1, pa2, pa3); MB_SBAR();
  pv(o, vb0 + 16384, pa0, pa1, pa2, pa3); mb::partialSM(pA0, pA1, m_reg, mnA, alA); MB_SBAR(); MB2_RESC(alA);
  MB_SBAR(); qkt<IMAX>(pB0, pB1, K_lds + 3 * 16384, qr, r32, hi, dq0 - 192, lut);
  mb::finishSM(pA0, pA1, alA, l_reg, pa0, pa1, pa2, pa3); MB_SBAR();
  pv(o, vb0 + 2 * 16384, pa0, pa1, pa2, pa3); mb::partialSM(pB0, pB1, m_reg, mnB, alB); MB_SBAR(); MB2_RESC(alB);
  mb::finishSM(pB0, pB1, alB, l_reg, pa0, pa1, pa2, pa3); MB_SBAR();
  pv(o, vb0 + 3 * 16384, pa0, pa1, pa2, pa3);
  m_out = m_reg; l_out = l_reg;
#undef MB2_RESC
}
struct BlockHalf { v4u kk[4], vv[4]; };
template <bool HM  >
__device__ __forceinline__ void block_issue(BlockHalf& B, int half, const bf16* __restrict__ Kh, const bf16* __restrict__ Vh, int tid) {
  constexpr int RS = HM ? 128 : INW;
#pragma unroll
  for (int i = 0; i < 4; ++i) { const int ch = tid + (half * 4 + i) * 512, row = ch >> 4, c16 = ch & 15; B.kk[i] = __builtin_nontemporal_load((const v4u*)(Kh + (size_t)row * RS + c16 * 8)); B.vv[i] = __builtin_nontemporal_load((const v4u*)(Vh + (size_t)row * RS + c16 * 8)); }
}
__device__ __forceinline__ void block_store(const BlockHalf& B, int half, char* lds, int tid) {
#pragma unroll
  for (int i = 0; i < 4; ++i) { const int ch = tid + (half * 4 + i) * 512, row = ch >> 4, c16 = ch & 15;
    *(v4u*)(lds + L_K + (row >> 6) * 16384 + MB_KSWZ(row & 63, c16 * 16)) = B.kk[i];
    *(v4u*)(lds + L_V + (row >> 6) * 16384 + v_st(row & 63, c16 * 8)) = B.vv[i]; }
}
template <bool HM>
__device__ __forceinline__ void load_block(const bf16* __restrict__ Kh, const bf16* __restrict__ Vh, char* lds, int tid) {
  BlockHalf A, B; block_issue<HM>(A, 0, Kh, Vh, tid); block_issue<HM>(B, 1, Kh, Vh, tid); block_store(A, 0, lds, tid); block_store(B, 1, lds, tid);
}
template <class F>
__device__ __forceinline__ void emit_rows(const f32x16 (&o)[4], const float* rowscale, char* stg, int lane, F f) {
  const int r32 = lane & 31, hi = lane >> 5;
#pragma unroll
  for (int g = 0; g < 4; ++g) {
#pragma unroll
    for (int rr = 0; rr < 4; ++rr) { const int r = 4 * g + rr; const int row = 4 * hi + rr; const float s = rowscale[8 * g + row];
#pragma unroll
      for (int d0 = 0; d0 < 4; ++d0) *(unsigned short*)(stg + row * 256 + (d0 * 32 + r32) * 2) = (unsigned short)(cvtpk(o[d0][r] * s, 0.f) & 0xffffu); }
    asm volatile("s_waitcnt lgkmcnt(0)" ::: "memory");
#pragma unroll
    for (int c = 0; c < 2; ++c) { const int row = lane >> 3, ch = (lane & 7) + 8 * c; const v4u val = *(const v4u*)(stg + row * 256 + ch * 16); f(g, row, ch, val); }
    asm volatile("s_waitcnt lgkmcnt(0)" ::: "memory");
  }
}
template <bool HM> __device__ __forceinline__ const bf16* kv_block(const unsigned char* ws, int b, int blk, int h, int kv) {
  if constexpr (HM) return (const bf16*)(ws + WS_EPRE) + ((size_t)(b * 32 + blk) * 8 + kv * 4 + h) * 32768;
  else return (const bf16*)(ws + WS_PROJ) + ((size_t)b * SEQ + blk * 256) * INW + (kv ? C_MV : C_MK) + h * HD;
}
template <bool HM> __device__ __forceinline__ const bf16* q_rows(const unsigned char* ws, const float* out, int b, int h) {
  if constexpr (HM) return (const bf16*)((const unsigned char*)out + 96 * MiB) + (size_t)(b * 4 + h) * SEQ * 128;
  else return (const bf16*)(ws + WS_PROJ) + (size_t)b * SEQ * INW + C_MQ + h * HD;
}
}

template <bool HM>
__device__ __forceinline__ void p3_moba_sel2(KA A, int L, unsigned char* ldsu) {
    PHASE_IDS();
    char* lds = (char*)ldsu;
    unsigned char* ws = A->ws; const bf16* PROJ = (const bf16*)(ws + WS_PROJ); const unsigned* SEL = (const unsigned*)(ws + WS_SEL);
    const unsigned char* LIST = ws + WS_LIST; const unsigned* CNT = (const unsigned*)(ws + WS_CNT); unsigned* TOT = (unsigned*)(ws + WS_CTL) + CW_TOT + L * 512;
    bf16* PARTO = (bf16*)A->out; float* PARTML = (float*)(ws + WS_PARTML);
    constexpr int LOADEQ = 12;
    unsigned short* tab = (unsigned short*)(lds + mb2::L_TAB);
    volatile LAS unsigned* ctr = (volatile LAS unsigned*)((LAS unsigned char*)ldsu + MISC_OFF) + 16;
    if (wave == 0) {
        int c[8]; int s = 0;
#pragma unroll
        for (int k = 0; k < 8; ++k) { const int e = lane * 8 + k; int n = 0; if (e < 496) { const int bh = e / 31, j = e % 31; n = (int)((__hip_atomic_load(&TOT[bh * 32 + j], __ATOMIC_RELAXED, __HIP_MEMORY_SCOPE_AGENT) + 31u) >> 5); if (n > 0) n += LOADEQ; } c[k] = s; s += n; }
        int incl = s;
#pragma unroll
        for (int o = 1; o < 64; o <<= 1) { const int v = __shfl_up(incl, o); if (lane >= o) incl += v; }
        const int excl = incl - s;
#pragma unroll
        for (int k = 0; k < 8; ++k) { const int e = lane * 8 + k; if (e <= 496) tab[e] = (unsigned short)(excl + c[k]); }
    }
    __syncthreads();
    const int WT = tab[496]; PSTAMP();     bool first_ = true;
    const int w_lo = (int)(((long)vcu * WT) / G), w_hi = (int)(((long)(vcu + 1) * WT) / G);
    int cpos = w_lo, cur_h = -1;
    int e_pf = -1, ncnt_pf = 0;
    while (cpos < w_hi) {
        int lo = 0, hi_ = 495;
        while (lo < hi_) { const int mid = (lo + hi_ + 1) >> 1; if ((int)tab[mid] <= cpos) lo = mid; else hi_ = mid - 1; }
        const int e = lo, bh = e / 31, j = e % 31, b = bh >> 2, h = bh & 3, T_e = tab[e], T_n = tab[e + 1];
        const int n_e = T_n - T_e - LOADEQ;
        int cur = cpos - T_e - LOADEQ; if (cur < 0) cur = 0;
        int p_hi = w_hi - T_e - LOADEQ; if (p_hi > n_e) p_hi = n_e;
        cpos = T_n;
        if (p_hi <= cur) continue;
        constexpr int t0 = 0;
        int tid_p = threadIdx.x; asm volatile("" : "+v"(tid_p));
        const bf16* Kh = mb2::kv_block<HM>(ws, b, j, h, 0); const bf16* Vh = mb2::kv_block<HM>(ws, b, j, h, 1);
        int ncnt = 0;
        if (e_pf == e) ncnt = ncnt_pf; else if (lane > j && lane < 32) ncnt = (int)CNT[(size_t)(bh * 32 + j) * 32 + lane];
        if (T_n < w_hi && e + 1 < 496) { const int bh_n = (e + 1) / 31, j_n = (e + 1) % 31; e_pf = e + 1; ncnt_pf = 0; if (lane > j_n && lane < 32) ncnt_pf = (int)CNT[(size_t)(bh_n * 32 + j_n) * 32 + lane]; }
        mb2::BlockHalf BA, BB; mb2::block_issue<HM>(BA, 0, Kh, Vh, tid_p); mb2::block_issue<HM>(BB, 1, Kh, Vh, tid_p);
        int segE, segT;
        { int incl = ncnt;
#pragma unroll
          for (int o = 1; o < 32; o <<= 1) { const int v = __shfl_up(incl, o); if (lane >= o) incl += v; }
          segE = incl - ncnt; segT = __shfl(incl, 31); }
        const bf16* Qseq = mb2::q_rows<HM>(ws, A->out, b, h); constexpr int QRS = HM ? 128 : INW;
        float* wsf = (float*)(lds + mb2::L_WSC) + wave * mb2::WSC_F; char* stg = lds + mb2::L_STG + wave * 2048;
        const unsigned char* LISTp = LIST + (size_t)(bh * 32 + j) * 32 * 256;
        auto meta = [&](int u, int& qbo, unsigned& raw, bool& valid) {
            const int s = (u - t0) * 32 + (lane & 31); valid = s < segT;
            int qb = j + 1;
            for (int q = j + 2; q < 32; ++q) { const int v = __builtin_amdgcn_readlane(segE, q); qb += (v <= s) ? 1 : 0; }
            const int idx = s - __shfl(segE, qb);
            qbo = qb; raw = 0u; if (valid) raw = LISTp[(size_t)qb * 256 + idx]; };
        int u = cur + wave;
        int pos = (j + 1) * 256, slot = 0; bool valid = false; mb::bf16x8 qr[8];
        int qb0 = j + 1; unsigned raw0 = 0u;
        if (u < p_hi) meta(u, qb0, raw0, valid);
        mb2::block_store(BA, 0, lds, tid_p);
        if (u < p_hi) { if (valid) pos = qb0 * 256 + (int)raw0;
            const unsigned msk = SEL[((size_t)b * SEQ + pos) * NH + h]; slot = __popc(msk & ((1u << j) - 1u)); mb2::load_q<QRS>(qr, Qseq, pos, lane >> 5); }
        mb2::block_store(BB, 1, lds, tid_p);
        if (cur_h != h) { cur_h = h; const float* src = (const float*)(ws + WS_LUT) + h * SEQ; float* dst = (float*)(lds + mb2::L_LUT);
#pragma unroll
            for (int i = 0; i < 4; ++i) { const int k = tid_p + i * 512; if (k < mb2::LUT_N) dst[k] = src[k]; } }
        __syncthreads();
        if (first_) PSTAMP();
        while (u < p_hi) {
            const int u2 = u + 8; const bool has2 = u2 < p_hi;
            int qb2 = j + 1; unsigned raw2 = 0u; bool valid2 = false;
            if (has2) meta(u2, qb2, raw2, valid2);
            mb::f32x16 o[4]; float m_reg, l_reg;
            mb2::attend_wave4<false>(qr, pos, j * 256, lds, wsf, o, m_reg, l_reg, lane);
            if (first_) PSTAMP();
            int lane_e = lane; asm volatile("" : "+v"(lane_e), "+v"(raw2));
            int pos2 = (j + 1) * 256; unsigned msk2 = 0u;
            if (has2) { if (valid2) pos2 = qb2 * 256 + (int)raw2; msk2 = SEL[((size_t)b * SEQ + pos2) * NH + h]; mb2::load_q<QRS>(qr, Qseq, pos2, lane_e >> 5); }
            const int r32e = lane_e & 31, hie = lane_e >> 5;
            const size_t trow = (size_t)b * SEQ + pos;
            if (hie == 0) { wsf[r32e] = 1.0f / l_reg; if (valid) { float* ml = PARTML + ((trow * NH + h) * 3 + slot) * 2; ml[0] = m_reg; ml[1] = l_reg; } }
            asm volatile("s_waitcnt lgkmcnt(0)" ::: "memory");
            const int code = valid ? (int)(pos | (slot << 16)) : -1;
            mb2::emit_rows(o, wsf, stg, lane_e, [&](int g, int row, int ch, const v4u& val) {
                const int cd = __shfl(code, 8 * g + row);
                if (cd >= 0) { const size_t tr = (size_t)b * SEQ + (cd & 0xffff); const int sl = cd >> 16;
                    *(v4u*)(PARTO + ((tr * NH + h) * 3 + sl) * 128 + ch * 8) = val; } });
            if (first_) { PSTAMP(); first_ = false; }
            pos = pos2; valid = valid2; slot = __popc(msk2 & ((1u << j) - 1u)); u = u2;
        }
        __syncthreads();
    }
    PSTAMP();
}

template <bool HM  >
__device__ __forceinline__ void p4_moba_own2(KA A, unsigned char* ldsu) {
    PHASE_IDS();
    char* lds = (char*)ldsu;
    unsigned char* ws = A->ws; bf16* PROJ = (bf16*)(ws + WS_PROJ); const unsigned* SEL = (const unsigned*)(ws + WS_SEL);
    const bf16* PARTO = (const bf16*)A->out; const float* PARTML = (const float*)(ws + WS_PARTML);
    const int qblk = (wave < 4) ? wave : 11 - wave;
    auto item = [&](int j) -> int { if constexpr (HM) { const int p_ = 16 * (bx_ & 7) + ((bx_ >> 3) & 7) + 8 * j; return ((p_ >> 5) * 4 + (bx_ >> 6)) * 32 + (p_ & 31); } else return vcu + j * G; };
    const int nit = HM ? 2 : (vcu < 16 * NBLK ? (16 * NBLK - vcu + G - 1) / G : 0);
    if (nit > 0) { const int it0 = item(0); const int bh = it0 >> 5, qb = it0 & 31, b = bh >> 2, h = bh & 3;
        mb2::load_block<HM>(mb2::kv_block<HM>(ws, b, qb, h, 0), mb2::kv_block<HM>(ws, b, qb, h, 1), lds, tid);
        const float* src = (const float*)(ws + WS_LUT) + h * SEQ; float* dst = (float*)(lds + mb2::L_LUT);
        dst[tid] = (tid < 256) ? -1e30f : src[tid - 256]; }
    __syncthreads();
    for (int j = 0; j < nit; ++j) { const int it = item(j);
        const int bh = it >> 5, qb = it & 31, b = bh >> 2, h = bh & 3;
        const bf16* Qseq = mb2::q_rows<HM>(ws, A->out, b, h);
        float* wsf = (float*)(lds + mb2::L_WSC) + wave * mb2::WSC_F; float* coef = wsf + 64; char* stg = lds + mb2::L_STG + wave * 2048;
        const int pos = qb * 256 + qblk * 32 + (lane & 31);
        unsigned msk_pf = 0u; f32x2v ml_pf[3] = {{0.f, 0.f}, {0.f, 0.f}, {0.f, 0.f}};
        if ((lane >> 5) == 0) { const size_t tr = (size_t)b * SEQ + pos; msk_pf = SEL[tr * NH + h]; const f32x2v* ml2 = (const f32x2v*)(PARTML + (tr * NH + h) * 6); ml_pf[0] = ml2[0]; ml_pf[1] = ml2[1]; ml_pf[2] = ml2[2]; }
        mb::f32x16 o[4]; float m_reg, l_reg;
        mb2::attend_wave<true, (HM ? 128 : INW)>(Qseq, pos, qb * 256, (qblk >> 1) + 1, lds, wsf, o, m_reg, l_reg, lane);
        __syncthreads();
        const bool has2 = j + 1 < nit; const int it2 = has2 ? item(j + 1) : it;
        mb2::BlockHalf BA;
        if (has2) { const int bh2 = it2 >> 5, qb2 = it2 & 31, b2 = bh2 >> 2, h2 = bh2 & 3; int tid_n = threadIdx.x; asm volatile("" : "+v"(tid_n));
            const bf16* Kh2 = mb2::kv_block<HM>(ws, b2, qb2, h2, 0); const bf16* Vh2 = mb2::kv_block<HM>(ws, b2, qb2, h2, 1);
            mb2::block_issue<HM>(BA, 0, Kh2, Vh2, tid_n); }
        int lane_e = lane; asm volatile("" : "+v"(lane_e));
        const int r32 = lane_e & 31, hi = lane_e >> 5;
        const size_t trow0 = (size_t)b * SEQ + qb * 256 + qblk * 32;
        if (hi == 0) {
            const int ns = __popc(msk_pf);
            float pm[3], pl[3]; float mx = m_reg;
#pragma unroll
            for (int i = 0; i < 3; ++i) { pm[i] = (i < ns) ? ml_pf[i][0] : -1e30f; pl[i] = (i < ns) ? ml_pf[i][1] : 0.f; mx = fmaxf(mx, pm[i]); }
            const float wo = __expf(m_reg - mx); float den = wo * l_reg; float w[3];
#pragma unroll
            for (int i = 0; i < 3; ++i) { w[i] = (i < ns) ? pl[i] * __expf(pm[i] - mx) : 0.f; den += w[i]; }
            const float inv = 1.0f / den;
            coef[r32] = wo * inv; coef[32 + r32] = w[0] * inv; coef[64 + r32] = w[1] * inv; coef[96 + r32] = w[2] * inv;
        }
        asm volatile("s_waitcnt lgkmcnt(0)" ::: "memory");
        {   struct Cell { v4u p[3]; v4u z; float cf[3]; };
            const int erow = lane_e >> 3, ech = lane_e & 7;
            auto issue = [&](int g, Cell (&C)[2]) {
#pragma unroll
                for (int c = 0; c < 2; ++c) { const int rw = 8 * g + erow, ch = ech + 8 * c; const size_t tr = trow0 + rw;
#pragma unroll
                    for (int k = 0; k < 3; ++k) { const float cf = coef[32 * (k + 1) + rw]; C[c].cf[k] = cf; C[c].p[k] = (v4u){0u, 0u, 0u, 0u};
                        if (cf != 0.f) C[c].p[k] = __builtin_nontemporal_load((const v4u*)(PARTO + ((tr * NH + h) * 3 + k) * 128 + ch * 8)); }
                    C[c].z = __builtin_nontemporal_load((const v4u*)(PROJ + tr * INW + C_MZ + h * HD + ch * 8)); } };
            auto finish = [&](int g, const Cell (&C)[2]) {
#pragma unroll
                for (int rr = 0; rr < 4; ++rr) { const int r = 4 * g + rr; const int row = 4 * hi + rr; const float sc = coef[8 * g + row];
#pragma unroll
                    for (int d0 = 0; d0 < 4; ++d0) *(unsigned short*)(stg + row * 256 + (d0 * 32 + r32) * 2) = (unsigned short)(mb::cvtpk(o[d0][r] * sc, 0.f) & 0xffffu); }
                asm volatile("s_waitcnt lgkmcnt(0)" ::: "memory");
#pragma unroll
                for (int c = 0; c < 2; ++c) { const int rw = 8 * g + erow, ch = ech + 8 * c; const size_t tr = trow0 + rw;
                    const v4u ow = *(const v4u*)(stg + erow * 256 + ch * 16);
                    float acc[8] = {bflo(ow.x), bfhi(ow.x), bflo(ow.y), bfhi(ow.y), bflo(ow.z), bfhi(ow.z), bflo(ow.w), bfhi(ow.w)};
#pragma unroll
                    for (int k = 0; k < 3; ++k) { const float cf = C[c].cf[k]; const v4u pw = C[c].p[k];
                        acc[0] += cf * bflo(pw.x); acc[1] += cf * bfhi(pw.x); acc[2] += cf * bflo(pw.y); acc[3] += cf * bfhi(pw.y); acc[4] += cf * bflo(pw.z); acc[5] += cf * bfhi(pw.z); acc[6] += cf * bflo(pw.w); acc[7] += cf * bfhi(pw.w); }
                    const v4u zw = C[c].z;
                    const float z[8] = {bflo(zw.x), bfhi(zw.x), bflo(zw.y), bfhi(zw.y), bflo(zw.z), bfhi(zw.z), bflo(zw.w), bfhi(zw.w)};
#pragma unroll
                    for (int e2 = 0; e2 < 8; ++e2) acc[e2] *= z[e2] / (1.0f + __expf(-z[e2]));
                    v4u w; w.x = pk2(acc[0], acc[1]); w.y = pk2(acc[2], acc[3]); w.z = pk2(acc[4], acc[5]); w.w = pk2(acc[6], acc[7]);
                    *(v4u*)(PROJ + tr * INW + C_MQ + h * HD + ch * 8) = w; }
                asm volatile("s_waitcnt lgkmcnt(0)" ::: "memory"); };
            Cell CA[2], CB[2];
            issue(0, CA);
            issue(1, CB); finish(0, CA);
            issue(2, CA); finish(1, CB);
            issue(3, CB); finish(2, CA);
            finish(3, CB);
        }
        if (has2) { const int bh2 = it2 >> 5, qb2 = it2 & 31, b2 = bh2 >> 2, h2 = bh2 & 3; int tid_n = threadIdx.x; asm volatile("" : "+v"(tid_n));
            const bf16* Kh2 = mb2::kv_block<HM>(ws, b2, qb2, h2, 0); const bf16* Vh2 = mb2::kv_block<HM>(ws, b2, qb2, h2, 1);
            mb2::BlockHalf BB; mb2::block_issue<HM>(BB, 1, Kh2, Vh2, tid_n); mb2::block_store(BA, 0, lds, tid_n); mb2::block_store(BB, 1, lds, tid_n); }
        __syncthreads();
    }
}

template <bool HM>
__device__ __forceinline__ void p2b_gating_mfma(KA A, int L, unsigned char* ldsu) {
    PHASE_IDS();
    char* lds = (char*)ldsu;
    unsigned char* ws = A->ws; const bf16* PROJ = (const bf16*)(ws + WS_PROJ); const float* KM = (const float*)(ws + WS_KMEAN); unsigned* SEL = (unsigned*)(ws + WS_SEL);
    unsigned char* LIST = ws + WS_LIST; unsigned* CNT = (unsigned*)(ws + WS_CNT); unsigned* TOT = (unsigned*)(ws + WS_CTL) + CW_TOT + L * 512;
    char* KH = lds; char* KL = lds + 8192; int* wc = (int*)(lds + 16384);
    const int r32 = lane & 31, hi = lane >> 5;
    int kk = 0;
    f32x4 a_n = {0.f, 0.f, 0.f, 0.f}, c_n = {0.f, 0.f, 0.f, 0.f}; mb::bf16x8 q_n[8];
    auto fetch = [&](int it2, int kk2) { const int bh2 = it2 >> 5, qb2 = (kk2 & 1) ? 31 - (it2 & 31) : (it2 & 31), b2 = bh2 >> 2, h2 = bh2 & 3; const int row = tid >> 4, c8 = (tid & 15) * 8;
        a_n = (f32x4){0.f, 0.f, 0.f, 0.f}; c_n = a_n;
        if (row < qb2) { const float* src = KM + ((size_t)bh2 * NBLK + row) * HD + c8; a_n = *(const f32x4*)src; c_n = *(const f32x4*)(src + 4); }
        mb2::load_q<(HM ? 128 : INW)>(q_n, mb2::q_rows<HM>(ws, A->out, b2, h2), qb2 * 256 + wave * 32 + (lane & 31), lane >> 5); };
    if (vcu < 16 * NBLK) fetch(vcu, 0);
    for (int it = vcu; it < 16 * NBLK; it += G, ++kk) {
        const int bh = it >> 5, qb = (kk & 1) ? 31 - (it & 31) : (it & 31), b = bh >> 2, h = bh & 3;
        { const int row = tid >> 4, c8 = (tid & 15) * 8; const f32x4 a = a_n, c = c_n;
          v4u wh, wl;
          wh.x = pk2(a[0], a[1]); wh.y = pk2(a[2], a[3]); wh.z = pk2(c[0], c[1]); wh.w = pk2(c[2], c[3]);
          wl.x = pk2(a[0] - bflo(wh.x), a[1] - bfhi(wh.x)); wl.y = pk2(a[2] - bflo(wh.y), a[3] - bfhi(wh.y)); wl.z = pk2(c[0] - bflo(wh.z), c[1] - bfhi(wh.z)); wl.w = pk2(c[2] - bflo(wh.w), c[3] - bfhi(wh.w));
          *(v4u*)(KH + MB_KSWZ(row, c8 * 2)) = wh; *(v4u*)(KL + MB_KSWZ(row, c8 * 2)) = wl; }
        const int q = wave * 32 + r32;
        const size_t t = (size_t)b * SEQ + qb * 256 + q;
        mb::bf16x8 qr[8];
#pragma unroll
        for (int d0 = 0; d0 < 8; ++d0) qr[d0] = q_n[d0];
        __syncthreads();
        mb::f32x16 p = mb::f32x16{};
#pragma unroll
        for (int d0 = 0; d0 < 8; ++d0) { const int cb = (d0 * 16 + hi * 8) * 2;
            const mb::bf16x8 ah = *reinterpret_cast<const mb::bf16x8*>(KH + MB_KSWZ(r32, cb)), al = *reinterpret_cast<const mb::bf16x8*>(KL + MB_KSWZ(r32, cb));
            p = __builtin_amdgcn_mfma_f32_32x32x16_bf16(ah, qr[d0], p, 0, 0, 0);
            p = __builtin_amdgcn_mfma_f32_32x32x16_bf16(al, qr[d0], p, 0, 0, 0); }
        if (it + G < 16 * NBLK) fetch(it + G, kk + 1);
        float v0 = -3e38f, v1 = -3e38f, v2 = -3e38f; int i0 = -1, i1 = -1, i2 = -1;
#pragma unroll
        for (int r = 0; r < 16; ++r) { const int n = mb::crow(r, hi); const float d = p[r];
            if (n < qb) {
                if (d > v0) { v2 = v1; i2 = i1; v1 = v0; i1 = i0; v0 = d; i0 = n; }
                else if (d > v1) { v2 = v1; i2 = i1; v1 = d; i1 = n; }
                else if (d > v2) { v2 = d; i2 = n; } } }
        { const float w0 = __shfl_xor(v0, 32), w1 = __shfl_xor(v1, 32), w2 = __shfl_xor(v2, 32); const int j0 = __shfl_xor(i0, 32), j1 = __shfl_xor(i1, 32), j2 = __shfl_xor(i2, 32);
          const float wv[3] = {w0, w1, w2}; const int wi[3] = {j0, j1, j2};
#pragma unroll
          for (int k = 0; k < 3; ++k) { const float d = wv[k]; const int n = wi[k];
              if (n >= 0) {
                  if (d > v0 || (d == v0 && n < i0)) { v2 = v1; i2 = i1; v1 = v0; i1 = i0; v0 = d; i0 = n; }
                  else if (d > v1 || (d == v1 && n < i1)) { v2 = v1; i2 = i1; v1 = d; i1 = n; }
                  else if (d > v2 || (d == v2 && n < i2)) { v2 = d; i2 = n; } } } }
        unsigned mask = 0u;
        if (i0 >= 0) mask |= 1u << i0; if (i1 >= 0) mask |= 1u << i1; if (i2 >= 0) mask |= 1u << i2;
        if (hi == 0) SEL[t * NH + h] = mask;
        for (int j = 0; j < qb; ++j) { const unsigned long long bal = __ballot(hi == 0 && ((mask >> j) & 1u)); if (lane == 0) wc[j * 8 + wave] = __popcll(bal); }
        __syncthreads();
        for (int j = 0; j < qb; ++j) {
            const bool f = (hi == 0) && ((mask >> j) & 1u);
            const unsigned long long bal = __ballot(f);
            int off = __popcll(bal & ((1ull << lane) - 1ull));
            int tot = 0;
#pragma unroll
            for (int w = 0; w < 8; ++w) { const int c = wc[j * 8 + w]; off += (w < wave) ? c : 0; tot += c; }
            const size_t seg = ((size_t)(bh * 32 + j) * 32 + qb);
            if (f) LIST[seg * 256 + off] = (unsigned char)q;
            if (tid == 0) { CNT[seg] = (unsigned)tot; atomicAdd(&TOT[bh * 32 + j], (unsigned)tot); }
        }
        __syncthreads();
    }
}

namespace rt {
using mb::bf16x8; using mb::s16x4; using mb::f32x16; using mb::u32x4; using mb::crow; using mb::cvtpk; using mb::v_st; using mb::v_rd_base; using mb::v_rd_off;
typedef short v4i16_t __attribute__((ext_vector_type(4)));
typedef __attribute__((address_space(3))) const char* lds_cptr;
__device__ __forceinline__ s16x4 vtr(lds_cptr p) { return __builtin_bit_cast(s16x4, __builtin_amdgcn_ds_read_tr16_b64_v4i16((__attribute__((address_space(3))) v4i16_t*)p)); }
__device__ __forceinline__ bf16x8 tr_frag(lds_cptr base, int d0, int ks) {
  const s16x4 l = vtr(base + v_rd_off(d0, ks, 0)), h = vtr(base + v_rd_off(d0, ks, 1));
  return (bf16x8){l[0], l[1], l[2], l[3], h[0], h[1], h[2], h[3]};
}
__device__ __forceinline__ void pack32(const f32x16& p, bf16x8& pa0, bf16x8& pa1) {
#define RT_PK4(P, BASE, OUT) do { unsigned a0 = pk2(P[BASE + 0], P[BASE + 1]), a1 = pk2(P[BASE + 2], P[BASE + 3]);     \
    unsigned b0 = pk2(P[BASE + 4], P[BASE + 5]), b1 = pk2(P[BASE + 6], P[BASE + 7]);                              \
    auto r0 = __builtin_amdgcn_permlane32_swap(a0, b0, false, false); auto r1 = __builtin_amdgcn_permlane32_swap(a1, b1, false, false); \
    u32x4 w = {r0[0], r1[0], r0[1], r1[1]}; OUT = *reinterpret_cast<bf16x8*>(&w); } while (0)
  RT_PK4(p, 0, pa0); RT_PK4(p, 8, pa1);
#undef RT_PK4
}
constexpr int SROW = 528;
constexpr int SBLK = 32 * SROW;
}

__device__ __forceinline__ void p2_kvsum_mfma(KA A, unsigned char* ldsu) {
    PHASE_IDS();
    char* lds = (char*)ldsu;
    unsigned char* ws = A->ws; const bf16* PROJ = (const bf16*)(ws + WS_PROJ); bf16* ST = (bf16*)(ws + WS_KV);
    const int r32 = lane & 31, hi = lane >> 5, eb = wave >> 1, db0 = 2 * (wave & 1);
    const rt::lds_cptr kb_ = (rt::lds_cptr)lds + mb::v_rd_base(lane), vb_ = (rt::lds_cptr)lds + 32768 + mb::v_rd_base(lane);
    v4u pk[4], pv[4];
    auto fetch = [&](int it) { const int bh = it >> 6, c = it & 63, b = bh >> 2, h = bh & 3; const size_t t0 = (size_t)b * SEQ + c * 128;
#pragma unroll
        for (int i = 0; i < 4; ++i) { const int ch = tid + i * 512, r = ch >> 4, c16 = ch & 15;
            pk[i] = *(const v4u*)(PROJ + (t0 + r) * INW + C_RK + h * HD + c16 * 8); pv[i] = *(const v4u*)(PROJ + (t0 + r) * INW + C_RV + h * HD + c16 * 8); } };
    if (vcu < 16 * NCH) fetch(vcu);
    for (int it = vcu; it < 16 * NCH; it += G) {
#pragma unroll
        for (int i = 0; i < 4; ++i) { const int ch = tid + i * 512, r = ch >> 4, c16 = ch & 15; const int dst = (r >> 6) * 16384 + mb::v_st(r & 63, c16 * 8);
            *(v4u*)(lds + dst) = pk[i]; *(v4u*)(lds + 32768 + dst) = pv[i]; }
        __syncthreads();
        if (it + G < 16 * NCH) fetch(it + G);
        rt::f32x16 acc[2]; acc[0] = rt::f32x16{}; acc[1] = rt::f32x16{};
#pragma unroll
        for (int k8 = 0; k8 < 8; ++k8) { const int buf = (k8 >> 2) * 16384, ks = k8 & 3;
            const rt::bf16x8 af = rt::tr_frag(vb_ + buf, eb, ks);
#pragma unroll
            for (int dd = 0; dd < 2; ++dd) { const rt::bf16x8 bf_ = rt::tr_frag(kb_ + buf, db0 + dd, ks);
                acc[dd] = __builtin_amdgcn_mfma_f32_32x32x16_bf16(af, bf_, acc[dd], 0, 0, 0); } }
        bf16* o = ST + (size_t)it * 16384;
#pragma unroll
        for (int dd = 0; dd < 2; ++dd)
#pragma unroll
            for (int r = 0; r < 16; ++r) o[(32 * eb + rt::crow(r, hi)) * 128 + 32 * (db0 + dd) + r32] = (bf16)(pk2(acc[dd][r], 0.f) & 0xffffu);
        __syncthreads();
    }
}

template <bool PL>
__device__ __forceinline__ void p4_ret_mfma(KA A, int L, unsigned char* ldsu) {
    PHASE_IDS();
    char* lds = (char*)ldsu;
    unsigned char* ws = A->ws; bf16* PROJ = (bf16*)(ws + WS_PROJ); const bf16* ST = (const bf16*)(ws + WS_KV);
    const int r32 = lane & 31, hi = lane >> 5, wq = wave & 3, eh = wave >> 2;
    char* Ks = lds; char* Ss = lds + 65536;
    const rt::lds_cptr vb_ = (rt::lds_cptr)lds + 32768 + mb::v_rd_base(lane);
    v4u pk[4], pv[4], ps[4]; rt::bf16x8 qn[8];
    auto fetch = [&](int it) { const int bh = it >> 6, c = it & 63, b = bh >> 2, h = bh & 3; const size_t t0 = (size_t)b * SEQ + c * 128;
        const bf16* Qw = PROJ + (t0 + 32 * wq + r32) * INW + C_RQ + h * HD + hi * 8;
#pragma unroll
        for (int d0 = 0; d0 < 8; ++d0) qn[d0] = *reinterpret_cast<const rt::bf16x8*>(Qw + d0 * 16);
#pragma unroll
        for (int i = 0; i < 4; ++i) { const int ch = tid + i * 512, r = ch >> 4, c16 = ch & 15;
            pk[i] = *(const v4u*)(PROJ + (t0 + r) * INW + C_RK + h * HD + c16 * 8); pv[i] = *(const v4u*)(PROJ + (t0 + r) * INW + C_RV + h * HD + c16 * 8);
            ps[i] = __builtin_nontemporal_load((const v4u*)(ST + (size_t)it * 16384 + r * 128 + c16 * 8)); } };
    auto item = [&](int j) -> int { if constexpr (PL) { const int p_ = 16 * (bx_ & 7) + ((bx_ >> 3) & 7) + 8 * (j >> 1); return ((p_ >> 5) * 4 + (bx_ >> 6)) * 64 + 2 * (p_ & 31) + (j & 1); } else return vcu + j * G; };
    const int nit = PL ? 4 : (vcu < 16 * NCH ? (16 * NCH - vcu + G - 1) / G : 0);
    if (nit > 0) fetch(item(0));
    for (int j = 0; j < nit; ++j) { const int it = item(j);
        const int bh = it >> 6, c = it & 63, b = bh >> 2, h = bh & 3;
        const size_t t0 = (size_t)b * SEQ + c * 128;
        rt::bf16x8 qr[8];
#pragma unroll
        for (int d0 = 0; d0 < 8; ++d0) qr[d0] = qn[d0];
#pragma unroll
        for (int i = 0; i < 4; ++i) { const int ch = tid + i * 512, r = ch >> 4, c16 = ch & 15;
            *(v4u*)(Ks + MB_KSWZ(r, c16 * 16)) = pk[i];
            *(v4u*)(lds + 32768 + (r >> 6) * 16384 + mb::v_st(r & 63, c16 * 8)) = pv[i];
            *(v4u*)(Ss + MB_KSWZ(r, c16 * 16)) = ps[i]; }
        __syncthreads();
        if (j + 1 < nit) fetch(item(j + 1));
        rt::f32x16 o[2]; o[0] = rt::f32x16{}; o[1] = rt::f32x16{};
#pragma unroll
        for (int kb = 0; kb < 4; ++kb) {
            if (kb <= wq) {
                rt::f32x16 p = rt::f32x16{};
#pragma unroll
                for (int d0 = 0; d0 < 8; ++d0) { const rt::bf16x8 kf = *reinterpret_cast<const rt::bf16x8*>(Ks + MB_KSWZ(32 * kb + r32, (d0 * 16 + hi * 8) * 2));
                    p = __builtin_amdgcn_mfma_f32_32x32x16_bf16(kf, qr[d0], p, 0, 0, 0); }
                if (kb == wq) {
#pragma unroll
                    for (int r = 0; r < 16; ++r) p[r] = (rt::crow(r, hi) <= r32) ? p[r] : 0.f; }
                rt::bf16x8 pa0, pa1; rt::pack32(p, pa0, pa1);
                const int buf = (kb >> 1) * 16384, ks0 = 2 * (kb & 1);
#pragma unroll
                for (int dd = 0; dd < 2; ++dd) { const rt::bf16x8 v0 = rt::tr_frag(vb_ + buf, 2 * eh + dd, ks0), v1 = rt::tr_frag(vb_ + buf, 2 * eh + dd, ks0 + 1);
                    o[dd] = __builtin_amdgcn_mfma_f32_32x32x16_bf16(pa0, v0, o[dd], 0, 0, 0);
                    o[dd] = __builtin_amdgcn_mfma_f32_32x32x16_bf16(pa1, v1, o[dd], 0, 0, 0); }
            }
        }
#pragma unroll
        for (int dd = 0; dd < 2; ++dd)
#pragma unroll
            for (int s = 0; s < 8; ++s) { const rt::bf16x8 sf = *reinterpret_cast<const rt::bf16x8*>(Ss + MB_KSWZ(32 * (2 * eh + dd) + r32, (s * 16 + hi * 8) * 2));
                o[dd] = __builtin_amdgcn_mfma_f32_32x32x16_bf16(qr[s], sf, o[dd], 0, 0, 0); }
        __syncthreads();
        { char* stg = lds + wq * rt::SBLK;
#pragma unroll
          for (int dd = 0; dd < 2; ++dd)
#pragma unroll
              for (int r = 0; r < 16; ++r) *(float*)(stg + rt::crow(r, hi) * rt::SROW + (32 * (2 * eh + dd) + r32) * 4) = o[dd][r]; }
        __syncthreads();
        {   int tid_e = tid; asm volatile("" : "+v"(tid_e));
            const int n = tid_e >> 2, part = tid_e & 3;
            const char* src = lds + (n >> 5) * rt::SBLK + (n & 31) * rt::SROW + part * 128;
            float ov[32];
#pragma unroll
            for (int q = 0; q < 8; ++q) { const f32x4 v = *(const f32x4*)(src + q * 16); ov[q * 4 + 0] = v[0]; ov[q * 4 + 1] = v[1]; ov[q * 4 + 2] = v[2]; ov[q * 4 + 3] = v[3]; }
            float sm = 0.f;
#pragma unroll
            for (int i = 0; i < 32; ++i) sm += ov[i];
            sm += __shfl_xor(sm, 1); sm += __shfl_xor(sm, 2);
            const float mean = sm * (1.0f / 128.0f);
            float vr = 0.f;
#pragma unroll
            for (int i = 0; i < 32; ++i) { const float dlt = ov[i] - mean; vr += dlt * dlt; }
            vr += __shfl_xor(vr, 1); vr += __shfl_xor(vr, 2);
            const float rstd = 1.0f / sqrtf(vr * (1.0f / 128.0f) + pg8::EPS);
            const float* gn = A->ret_norm_g + L * 512 + h * HD + part * 32;
            const bf16* zrow = PROJ + (t0 + n) * INW + C_RZ + h * HD + part * 32;
            bf16* orow = PROJ + (t0 + n) * INW + C_RQ + h * HD + part * 32;
#pragma unroll
            for (int q = 0; q < 4; ++q) { const v4u zw = __builtin_nontemporal_load((const v4u*)(zrow + q * 8)); const f32x4 g0 = *(const f32x4*)(gn + q * 8), g1 = *(const f32x4*)(gn + q * 8 + 4);
                const float z[8] = {bflo(zw.x), bfhi(zw.x), bflo(zw.y), bfhi(zw.y), bflo(zw.z), bfhi(zw.z), bflo(zw.w), bfhi(zw.w)};
                float r[8];
#pragma unroll
                for (int e = 0; e < 8; ++e) { const float gg = (e < 4) ? g0[e & 3] : g1[e & 3]; r[e] = (ov[q * 8 + e] - mean) * rstd * gg * (z[e] / (1.0f + __expf(-z[e]))); }
                v4u w; w.x = pk2(r[0], r[1]); w.y = pk2(r[2], r[3]); w.z = pk2(r[4], r[5]); w.w = pk2(r[6], r[7]);
                *(v4u*)(orow + q * 8) = w; }
        }
        __syncthreads();
    }
}


template <bool G256> __global__ void __launch_bounds__(NWAVES * 64, 2) hymba_fwd(Args args_unused) {
    extern __shared__ __attribute__((aligned(16))) unsigned char lds[];
    LAS unsigned char* ldsl = (LAS unsigned char*)lds;
    volatile LAS unsigned* MISC = (volatile LAS unsigned*)(ldsl + MISC_OFF);
    { const int tid = threadIdx.x; for (int u = tid; u < (LDS_BYTES - LDSCTL_OFF) / 4; u += NWAVES * 64) ((LAS unsigned*)(ldsl + LDSCTL_OFF))[u] = 0u; }
    __syncthreads();
    (void)xcd_barrier_post((unsigned*)(get_ka()->ws + WS_CTL) + CW_BAR, MISC + 8);
    { int bx_ = blockIdx.x; asm volatile("" : "+s"(bx_)); unsigned* gx_ = (unsigned*)(get_ka()->ws + WS_CTL) + CW_GRP + (bx_ & 63) * 32 + 1; const unsigned xbit_ = 1u << xb_xcc_id(); if (threadIdx.x == 0) (void)__hip_atomic_fetch_or(gx_, xbit_, __ATOMIC_RELAXED, __HIP_MEMORY_SCOPE_AGENT); }
#define GRID_BAR() do { XcdBarrier b_; b_.bar = (unsigned*)(get_ka()->ws + WS_CTL) + CW_BAR; b_.x = xb_xcc_id(); b_.st = (volatile LAS unsigned*)((LAS unsigned char*)lds + MISC_OFF) + 8; xcd_barrier(b_); } while (0)
#define WSP(T, off) ((T*)(ka->ws + (off)))
#define WSPK(T, off) ((T*)(get_ka()->ws + (off)))
#define GROUP_BAR(k) do { if constexpr (!G256) { GRID_BAR(); } else { \
        asm volatile("s_waitcnt vmcnt(0)" ::: "memory"); __syncthreads(); \
        if (threadIdx.x == 64) { asm volatile("buffer_inv sc1" ::: "memory"); asm volatile("s_waitcnt vmcnt(0)" ::: "memory"); }     \
        if (threadIdx.x == 0) { unsigned* bar_ = (unsigned*)(get_ka()->ws + WS_CTL) + CW_BAR; unsigned* cnt_ = (unsigned*)(get_ka()->ws + WS_CTL) + CW_GRP + (blockIdx.x & 63) * 32; \
            __builtin_amdgcn_s_waitcnt(0); \
            { const unsigned xm_ = (unsigned)__builtin_amdgcn_readfirstlane((int)xb_ld(cnt_ + 1)); if (xm_ & (xm_ - 1u)) { __builtin_amdgcn_fence(__ATOMIC_RELEASE, "agent"); asm volatile("s_waitcnt vmcnt(0)" ::: "memory"); } }     \
            (void)xb_add(cnt_, 1u); XB_SPIN(xb_ld(cnt_) < 4u * (k), bar_); \
            asm volatile("s_waitcnt vmcnt(0)" ::: "memory"); } \
        __syncthreads(); } } while (0)

#if defined(PROBE_T0)
#define STAMP() do { if (blockIdx.x == 0 && threadIdx.x == 0) { const unsigned k_ = MISC[31]; MISC[32 + k_] = (unsigned)__builtin_amdgcn_s_memrealtime(); MISC[31] = k_ + 1; } } while (0)
#else
#define STAMP() do { } while (0)
#endif
    STAMP();
    p0_prologue(get_ka(), ldsl);
    GRID_BAR(); STAMP();

    for (int L = 0; L < DEPTH; ++L) {
#if defined(PROBE_T0)
#define INPROJ_CHAIN false
#else
#define INPROJ_CHAIN true
#endif
#define INPROJ_PART(KIND, CIN, NEXTKIND) {   KA ka = get_ka(); int bx = blockIdx.x; asm volatile("" : "+s"(bx)); const int G = gridDim.x; \
            pg8::Gemm g{WSP(bf16, WS_XB), WSP(const bf16, WS_WIN) + (size_t)L * INW * DM, M, INW, DM, DM}; pg8::SubsetOrder S; S.init(M, KIND, G, bx); \
            const char* chA = nullptr; const char* chB = nullptr; bool cin = false; pg8::Unit u0, u1; \
            if (CIN >= 0) { pg8::SubsetOrder Sp; Sp.init(M, CIN, G, bx); cin = Sp.next(0, u1) && S.next(0, u0); } \
            if (NEXTKIND >= 0) { pg8::SubsetOrder Sn; Sn.init(M, NEXTKIND, G, bx); if (S.next(0, u1) && Sn.next(0, u0)) { chA = (const char*)g.A + (size_t)u0.pm * (256 * DM * 2); chB = (const char*)g.Bt + (size_t)u0.pn * (256 * DM * 2); } } \
            pg8::EpiProj<KIND, G256> E{WSP(bf16, WS_PROJ), INW, WSP(float, WS_RSX), WSP(const float, WS_TAB), ka->q_norm_g + L * HD, ka->k_norm_g + L * HD, WSP(float, WS_KMEAN), (LAS float*)(ldsl + RING_BYTES), (const LAS float*)(ldsl + LDS_RS_OFF), WSP(bf16, WS_EPRE)}; E.rw = nullptr; E.qc = (bf16*)((unsigned char*)ka->out + 96 * MiB); \
            if constexpr (G256) { if (CIN < 0) { int t_ = threadIdx.x; asm volatile("" : "+v"(t_)); const f32x4* p_ = (const f32x4*)(WSP(const float, WS_RSX) + ((size_t)(16 * (bx & 7) + ((bx >> 3) & 7) + 8 * (t_ >> 8)) * 256 + (t_ & 255)) * 16); \
                E.f0 = p_[0]; E.f1 = p_[1]; E.f2 = p_[2]; E.f3 = p_[3]; E.rw = (LAS float*)(ldsl + LDS_RS_OFF) + t_; } } \
            pg8::gemm_phase<pg8::EpiProj<KIND, G256>, pg8::SubsetOrder, true, true, INPROJ_CHAIN>(ldsl + RING_OFF, g, S, E, cin, chA, chB); }
        INPROJ_PART(2, -1, 0)
        INPROJ_PART(0, 2, 1)
        INPROJ_PART(1, 0, -1)
        GRID_BAR(); STAMP();
        p2_kvsum_mfma(get_ka(), lds); STAMP();
        p2b_gating_mfma<G256>(get_ka(), L, lds);
        GRID_BAR(); STAMP();
        if constexpr (G256) { p3_moba_sel2<G256>(get_ka(), L, lds); STAMP(); p3_scan<true>(get_ka(), L, MISC + 20); }
        else { p3_scan<false>(get_ka(), L, MISC + 20); STAMP(); p3_moba_sel2<G256>(get_ka(), L, lds); }
        GRID_BAR(); STAMP();
        p4_ret_mfma<G256>(get_ka(), L, lds); STAMP();
        p4_moba_own2<G256>(get_ka(), lds);
        if (G256 && L + 1 < DEPTH) { GROUP_BAR(3 * L + 1); } else { GRID_BAR(); }
        STAMP();
        {   KA ka = get_ka(); int bx = blockIdx.x; asm volatile("" : "+s"(bx)); const int G = gridDim.x;
            pg8::Gemm g{WSP(bf16, WS_PROJ), WSP(const bf16, WS_WOUT) + (size_t)L * DM * DM, M, DM, DM, INW}; pg8::StaticOrder S; S.init(M, DM, G, bx);
            pg8::EpiRes<true> E{WSP(const bf16, WS_XB), WSP(bf16, WS_PROJ) + C_X1B, WSP(float, WS_RSX1), DM, INW};
            pg8::gemm_phase<pg8::EpiRes<true>, pg8::StaticOrder, true, true>(ldsl + RING_OFF, g, S, E); }
        {   KA ka = get_ka(); int bx = blockIdx.x; asm volatile("" : "+s"(bx)); const int G = gridDim.x;
            pg8::Gemm g{WSP(bf16, L == 0 ? WS_PE : WS_PE2), WSP(const bf16, WS_WPLE) + (size_t)L * DM * PLE, M, DM, PLE, PLE}; pg8::StaticOrder S; S.init(M, DM, G, bx);
            pg8::EpiE E{WSP(bf16, WS_EPRE), DM, WSP(float, WS_RSE)};
            pg8::gemm_phase<pg8::EpiE, pg8::StaticOrder, true, true>(ldsl + RING_OFF, g, S, E); }
        GROUP_BAR(L + 1 < DEPTH ? 3 * L + 2 : 3 * (DEPTH - 1) + 1); STAMP();
        if (L + 1 < DEPTH) {   KA ka = get_ka(); int bx = blockIdx.x; asm volatile("" : "+s"(bx)); const int G = gridDim.x;
            pg8::Gemm g{WSP(bf16, WS_PROJ) + C_X1B, WSP(const bf16, WS_WG) + (size_t)L * DM * DM, M, DM, DM, INW}; pg8::StaticOrder S; S.init(M, DM, G, bx);
            pg8::EpiGate<false, G256> E{WSP(const bf16, WS_PROJ) + C_X1B, INW, WSP(const bf16, WS_EPRE), WSP(const float, WS_RSX1), WSP(const float, WS_RSE), ka->ple_norm_g + L * DM, WSP(bf16, WS_XB), WSP(float, WS_RSX), nullptr, DM, (const LAS float*)(ldsl + LDS_RS_OFF + 2048), (const LAS float*)(ldsl + LDS_RS_OFF + 4096), (const LAS float*)(ldsl + LDS_RS_OFF + 6144)};
            if constexpr (G256) { int t_ = threadIdx.x; asm volatile("" : "+v"(t_)); const size_t r_ = ((size_t)(16 * (bx & 7) + ((bx >> 3) & 7) + 8 * (t_ >> 8)) * 256 + (t_ & 255)) * 16; const f32x4* p1_ = (const f32x4*)(WSP(const float, WS_RSX1) + r_); const f32x4* pe_ = (const f32x4*)(WSP(const float, WS_RSE) + r_);
                E.f1q[0] = p1_[0]; E.f1q[1] = p1_[1]; E.f1q[2] = p1_[2]; E.f1q[3] = p1_[3]; E.feq[0] = pe_[0]; E.feq[1] = pe_[1]; E.feq[2] = pe_[2]; E.feq[3] = pe_[3];
                E.gq = ka->ple_norm_g[L * DM + (bx >> 6) * 256 + (t_ & 255)]; E.rw = (LAS float*)(ldsl + LDS_RS_OFF + 2048) + t_; }
            pg8::gemm_phase<pg8::EpiGate<false, G256>, pg8::StaticOrder, true, true>(ldsl + RING_OFF, g, S, E); }
        else {                 KA ka = get_ka(); int bx = blockIdx.x; asm volatile("" : "+s"(bx)); const int G = gridDim.x;
            pg8::Gemm g{WSP(bf16, WS_PROJ) + C_X1B, WSP(const bf16, WS_WG) + (size_t)L * DM * DM, M, DM, DM, INW}; pg8::StaticOrder S; S.init(M, DM, G, bx);
            pg8::EpiGate<true, G256> E{WSP(const bf16, WS_PROJ) + C_X1B, INW, WSP(const bf16, WS_EPRE), WSP(const float, WS_RSX1), WSP(const float, WS_RSE), ka->ple_norm_g + L * DM, nullptr, nullptr, ka->out, DM, (const LAS float*)(ldsl + LDS_RS_OFF + 2048), (const LAS float*)(ldsl + LDS_RS_OFF + 4096), (const LAS float*)(ldsl + LDS_RS_OFF + 6144)};
            if constexpr (G256) { int t_ = threadIdx.x; asm volatile("" : "+v"(t_)); const size_t r_ = ((size_t)(16 * (bx & 7) + ((bx >> 3) & 7) + 8 * (t_ >> 8)) * 256 + (t_ & 255)) * 16; const f32x4* p1_ = (const f32x4*)(WSP(const float, WS_RSX1) + r_); const f32x4* pe_ = (const f32x4*)(WSP(const float, WS_RSE) + r_);
                E.f1q[0] = p1_[0]; E.f1q[1] = p1_[1]; E.f1q[2] = p1_[2]; E.f1q[3] = p1_[3]; E.feq[0] = pe_[0]; E.feq[1] = pe_[1]; E.feq[2] = pe_[2]; E.feq[3] = pe_[3];
                E.gq = ka->ple_norm_g[L * DM + (bx >> 6) * 256 + (t_ & 255)]; E.rw = (LAS float*)(ldsl + LDS_RS_OFF + 2048) + t_; }
            pg8::gemm_phase<pg8::EpiGate<true, G256>, pg8::StaticOrder, true, true>(ldsl + RING_OFF, g, S, E); }
        if (L + 1 < DEPTH) {
            {   KA ka = get_ka(); PHASE_IDS();
                const long gtid = (long)vcu * (NWAVES * 64) + tid, gthreads = (long)G * NWAVES * 64;
                cvt_f32_bf16(ka->p + (size_t)(L + 1) * M * PLE, WSP(bf16, WS_PE2), (long)M * PLE / 8, gtid, gthreads); }
            GROUP_BAR(3 * L + 3); STAMP();
        }
    }
#if defined(PROBE_T0)
    GRID_BAR(); STAMP();
    if (blockIdx.x == 0 && threadIdx.x == 0) get_ka()->out[0] = 1000.0f * (float)((MISC[32 + PROBE_T1] - MISC[32 + PROBE_T0] + PROBE_OFF) / PROBE_BKT);
#endif
}

extern "C" void kernel_launch(void* const* d_in, const int* in_sizes, int n_in, void* d_out, int out_size, void* d_ws, size_t ws_size, hipStream_t stream) {
    static int grid = 0;
    if (grid == 0) {
        if (n_in != 12 || in_sizes[0] != M * DM || out_size != M * DM || ws_size < 512 * MiB) {
            fprintf(stderr, "kernel_launch: shape mismatch: n_in %d in0 %d out %d ws %zu (need >= %zu)\n", n_in, n_in > 0 ? in_sizes[0] : -1, out_size, ws_size, (size_t)(512 * MiB)); grid = -1; return; }
        int dev = 0, cus = 0, per_cu = 0;
        if (hipGetDevice(&dev) != hipSuccess || hipDeviceGetAttribute(&cus, hipDeviceAttributeMultiprocessorCount, dev) != hipSuccess) { fprintf(stderr, "kernel_launch: device query failed\n"); grid = -1; return; }
        const void* kfn = (cus == 256) ? (const void*)hymba_fwd<true> : (const void*)hymba_fwd<false>;
        if (hipFuncSetAttribute(kfn, hipFuncAttributeMaxDynamicSharedMemorySize, LDS_BYTES) != hipSuccess) { fprintf(stderr, "kernel_launch: hipFuncSetAttribute failed\n"); grid = -1; return; }
        if (hipOccupancyMaxActiveBlocksPerMultiprocessor(&per_cu, kfn, NWAVES * 64, LDS_BYTES) != hipSuccess || per_cu < 1)
            fprintf(stderr, "kernel_launch: note: occupancy query reports %d workgroups per CU\n", per_cu);
        (void)hipGetLastError();
        grid = cus;
        if (cus != 256) fprintf(stderr, "kernel_launch: note: %d CUs reported; the unit counts of the phases are tuned for 256 workgroups (any grid that is fully resident is still correct)\n", cus);
        fprintf(stderr, "kernel_launch: grid %d, ws %zu bytes\n", grid, ws_size);
    }
    if (grid < 0) return;
    if (hipMemsetAsync((char*)d_ws + WS_CTL, 0, CTL_ZERO_BYTES, stream) != hipSuccess) { fprintf(stderr, "kernel_launch: memset failed\n"); return; }
    Args a{};
    a.x = (const float*)d_in[0]; a.p = (const float*)d_in[1]; a.norm_g = (const float*)d_in[2]; a.w_in = (const float*)d_in[3]; a.ret_norm_g = (const float*)d_in[4];
    a.q_norm_g = (const float*)d_in[5]; a.k_norm_g = (const float*)d_in[6]; a.rel_bias = (const float*)d_in[7]; a.w_out = (const float*)d_in[8]; a.w_ple = (const float*)d_in[9];
    a.ple_norm_g = (const float*)d_in[10]; a.w_ple_gate = (const float*)d_in[11]; a.out = (float*)d_out; a.ws = (unsigned char*)d_ws;
    if (grid == 256) hipLaunchKernelGGL(hymba_fwd<true>, dim3(grid), dim3(NWAVES * 64), LDS_BYTES, stream, a);
    else hipLaunchKernelGGL(hymba_fwd<false>, dim3(grid), dim3(NWAVES * 64), LDS_BYTES, stream, a);
    const hipError_t le = hipPeekAtLastError();
    if (le != hipSuccess) fprintf(stderr, "kernel_launch: launch failed: %s\n", hipGetErrorName(le));
}
```

```cpp
#include <hip/hip_runtime.h>
#include <cstdio>
#include <cstdint>

namespace pg8 {
#define PG8_LAS __attribute__((address_space(3)))
typedef unsigned short bf16_t;
typedef short bf16x8 __attribute__((ext_vector_type(8)));
typedef float f32x4 __attribute__((ext_vector_type(4)));
typedef unsigned u32x4 __attribute__((ext_vector_type(4)));
typedef unsigned u32x2 __attribute__((ext_vector_type(2)));
constexpr int BM = 256, BK = 64, HALF = 128, HTB = HALF * BK * 2  , STAGE_BYTES = 8 * HTB, NXCD = 8, WGM = 8;

__host__ __device__ __forceinline__ int lds_byte(int r, int c) { const int st = (r >> 4) * 2 + (c >> 5), rr = r & 15, cc = c & 31, ob = rr * 64 + cc * 2; return st * 1024 + (ob ^ (((ob >> 9) & 1) << 5)); }
__host__ __device__ __forceinline__ void stage_rc(int b, int& R, int& C) { const int st = b / 1024, sb = b % 1024, swz = sb ^ (((sb >> 9) & 1) << 5); R = (st >> 1) * 16 + swz / 64; C = (st & 1) * 32 + (swz % 64) / 2; }
__host__ __device__ __forceinline__ int perm32(int rho) { const int n = rho >> 4, i = rho & 15; return 8 * (i >> 2) + 4 * n + (i & 3); }

struct Unit { int pm, pn; };
struct Gemm { const bf16_t* A; const bf16_t* Bt; int M, N, K, lda; };

struct StaticOrder {
    int nM, nN, nwg, G, c;
    __host__ __device__ __forceinline__ void init(int M, int N, int G_, int c_) { nM = M / BM; nN = N / BM; nwg = nM * nN; G = G_; c = c_; }
    __host__ __device__ __forceinline__ bool next(int i, Unit& u) const {
        const long L = (long)i * G + c; if (L >= nwg) return false;
        int wgid = (int)L; { const int q = nwg / NXCD, r = nwg % NXCD, xcd = wgid % NXCD, off = wgid / NXCD; wgid = (xcd < r ? xcd * (q + 1) : r * (q + 1) + (xcd - r) * q) + off; }
        const int nig = WGM * nN, gid = wgid / nig, fm = gid * WGM, gsz = (nM - fm) < WGM ? (nM - fm) : WGM;
        u.pm = fm + ((wgid % nig) % gsz); u.pn = (wgid % nig) / gsz; return true;
    }
    __device__ __forceinline__ void a_ready(const Unit&) const {}
    __device__ __forceinline__ void done(const Unit&) const {}
};

struct SubsetOrder {
    StaticOrder S; int kind;
    __host__ __device__ __forceinline__ void init(int M, int kind_, int G_, int c_) { kind = kind_; S.init(M, (kind_ >= 2 ? 8 : 4) * BM, G_, c_); }
    __host__ __device__ __forceinline__ bool next(int i, Unit& u) const {
        if (!S.next(i, u)) return false;
        const int p = u.pn; u.pn = (kind == 0) ? ((p & 1) + 4 * (p >> 1)) : (kind == 1) ? (2 + (p & 1) + 8 * (p >> 1)) : (kind == 2) ? (6 + p + 2 * (p >> 2)) : (p < 6 ? p : p + 4); return true;
    }
    __device__ __forceinline__ void a_ready(const Unit&) const {}
    __device__ __forceinline__ void done(const Unit&) const {}
};

typedef float f32x2 __attribute__((ext_vector_type(2)));
typedef __bf16 bf16x2_t __attribute__((ext_vector_type(2)));
__device__ __forceinline__ unsigned pk2(float lo, float hi) { f32x2 v = {lo, hi}; bf16x2_t b = __builtin_convertvector(v, bf16x2_t); return __builtin_bit_cast(unsigned, b); }
__device__ __forceinline__ float bflo(unsigned w) { return __uint_as_float(w << 16); }
__device__ __forceinline__ float bfhi(unsigned w) { return __uint_as_float(w & 0xffff0000u); }
__device__ __forceinline__ float sum16(const float* p) {
    const f32x4 a = *(const f32x4*)p, b = *(const f32x4*)(p + 4), c = *(const f32x4*)(p + 8), d = *(const f32x4*)(p + 12);
    return (((a[0] + a[1]) + (a[2] + a[3])) + ((b[0] + b[1]) + (b[2] + b[3]))) + (((c[0] + c[1]) + (c[2] + c[3])) + ((d[0] + d[1]) + (d[2] + d[3])));
}
constexpr float EPS = 1e-6f;
__device__ __forceinline__ float rowsum16(const float* p16, int fq) {
    const f32x4 a = *(const f32x4*)(p16 + 4 * fq); float s = (a[0] + a[1]) + (a[2] + a[3]);
    s += __shfl_xor(s, 16); s += __shfl_xor(s, 32); return s;
}

#ifndef ROT_UP_L
#define ROT_UP_L 3
#endif
template <int KIND  , bool LDSR  > struct EpiProj {
    static constexpr bool PERM = true, AFTER_DRAIN = false;
    bf16_t* O; int ldc; const float* rss; const float* tab  ; const float* qg; const float* kg; float* kmean  ; PG8_LAS float* xl; const PG8_LAS float* rl  ; bf16_t* kvc  ;
    bf16_t* qc;
    f32x4 f0, f1, f2, f3; PG8_LAS float* rw;
    __device__ __forceinline__ void after_stage(int) const {
        if constexpr (LDSR) { if (rw) { const float t = (((f0[0] + f0[1]) + (f0[2] + f0[3])) + ((f1[0] + f1[1]) + (f1[2] + f1[3]))) + (((f2[0] + f2[1]) + (f2[2] + f2[3])) + ((f3[0] + f3[1]) + (f3[2] + f3[3]))); *rw = 1.0f / sqrtf(t * (1.0f / 1024.0f) + EPS); } } }
    __device__ __forceinline__ void store8(bf16_t* p, const f32x4& v0, const f32x4& v1) const { u32x4 w; w.x = pk2(v0[0], v0[1]); w.y = pk2(v0[2], v0[3]); w.z = pk2(v1[0], v1[1]); w.w = pk2(v1[2], v1[3]); *(u32x4*)p = w; }
    __device__ __forceinline__ void operator()(const f32x4 (&acc)[2][2][4][2], const Unit& u, int wr, int wc, int fr, int fq) const {
        const int row0 = u.pm * BM + wr * 64 + fr, col0 = u.pn * BM + wc * 32 + 8 * fq;
        const int grp = u.pn >> 1;
        f32x4 T0[KIND == 0 ? 4 : 1][2], T1[KIND == 0 ? 4 : 1][2], g0, g1;
        if constexpr (KIND == 0) {
#pragma unroll
            for (int m = 0; m < 0; ++m)
#pragma unroll
                for (int ai = 0; ai < 2; ++ai) { const int pos = (row0 + ai * HALF + m * 16) & 8191; const f32x4* cs = (const f32x4*)(tab + ((size_t)pos * 64 + 16 * wc + 4 * fq) * 2); T0[m][ai] = cs[0]; T1[m][ai] = cs[1]; }
        }
        if constexpr (KIND == 1) { const float* gp = ((grp == 1) ? qg : kg) + wc * 32 + 8 * fq; g0 = *(const f32x4*)gp; g1 = *(const f32x4*)(gp + 4); }
        float rstd[2][4];
        if constexpr (LDSR) { const PG8_LAS float* rp = rl + ((u.pm >> 3) & 1) * 256 + wr * 64 + fr;
#pragma unroll
            for (int ai = 0; ai < 2; ++ai)
#pragma unroll
                for (int m = 0; m < 4; ++m) rstd[ai][m] = rp[ai * HALF + m * 16];
        } else {
#pragma unroll
            for (int ai = 0; ai < 2; ++ai)
#pragma unroll
                for (int m = 0; m < 4; ++m) rstd[ai][m] = 1.0f / sqrtf(rowsum16(rss + (size_t)(row0 + ai * HALF + m * 16) * 16, fq) * (1.0f / 1024.0f) + EPS);
        }
        asm volatile("" ::: "memory");
        if (KIND == 0 || (KIND == 3 && (grp == 0 || grp == 2))) {
            constexpr int ROT_UP = LDSR ? ROT_UP_L : 2;
            float lg2[2];
#pragma unroll
            for (int bj = 0; bj < 2; ++bj) lg2[bj] = log2f(1.0f - exp2f(-5.0f - (float)(2 * (u.pn & 1) + bj)));
            if constexpr (KIND == 0) {
#pragma unroll
                for (int m = 0; m < ROT_UP; ++m)
#pragma unroll
                    for (int ai = 0; ai < 2; ++ai) { const int pos = (row0 + ai * HALF + m * 16) & 8191; const f32x4* cs = (const f32x4*)(tab + ((size_t)pos * 64 + 16 * wc + 4 * fq) * 2); T0[m][ai] = cs[0]; T1[m][ai] = cs[1]; }
                asm volatile("" ::: "memory");
            }
#pragma unroll
            for (int m = 0; m < 4; ++m) { const float jf = (float)(wr * 64 + m * 16 + fr);
                float sc[2];
#pragma unroll
                for (int bj = 0; bj < 2; ++bj) sc[bj] = (grp == 0) ? exp2f(jf * lg2[bj]) : 0.08838834764831845f * exp2f(-jf * lg2[bj]);
#pragma unroll
                for (int ai = 0; ai < 2; ++ai) { const int row = row0 + ai * HALF + m * 16;
                    const f32x4 cs0 = T0[KIND == 0 ? m : 0][ai], cs1 = T1[KIND == 0 ? m : 0][ai];
                    bf16_t* rowp = O + (size_t)row * ldc + col0;
#pragma unroll
                    for (int bj = 0; bj < 2; ++bj) { const float r = rstd[ai][m]; const f32x4 a0 = acc[ai][bj][m][0] * r, a1 = acc[ai][bj][m][1] * r; const float s = sc[bj];
                        f32x4 v0, v1;
                        v0[0] = (a0[0] * cs0[0] - a0[1] * cs0[1]) * s; v0[1] = (a0[0] * cs0[1] + a0[1] * cs0[0]) * s; v0[2] = (a0[2] * cs0[2] - a0[3] * cs0[3]) * s; v0[3] = (a0[2] * cs0[3] + a0[3] * cs0[2]) * s;
                        v1[0] = (a1[0] * cs1[0] - a1[1] * cs1[1]) * s; v1[1] = (a1[0] * cs1[1] + a1[1] * cs1[0]) * s; v1[2] = (a1[2] * cs1[2] - a1[3] * cs1[3]) * s; v1[3] = (a1[2] * cs1[3] + a1[3] * cs1[2]) * s;
                        store8(rowp + bj * HALF, v0, v1); } }
                if (KIND == 0 && m + ROT_UP < 4) {
                    asm volatile("" ::: "memory");
#pragma unroll
                    for (int ai = 0; ai < 2; ++ai) { const int pos = (row0 + ai * HALF + (m + ROT_UP) * 16) & 8191; const f32x4* cs = (const f32x4*)(tab + ((size_t)pos * 64 + 16 * wc + 4 * fq) * 2); T0[KIND == 0 ? (m + ROT_UP) & 3 : 0][ai] = cs[0]; T1[KIND == 0 ? (m + ROT_UP) & 3 : 0][ai] = cs[1]; }
                    asm volatile("" ::: "memory"); } }
        } else if (KIND == 1 || KIND == 3) {
            PG8_LAS float* P = xl;
#pragma unroll
            for (int ai = 0; ai < 2; ++ai)
#pragma unroll
                for (int m = 0; m < 4; ++m)
#pragma unroll
                    for (int bj = 0; bj < 2; ++bj) { const float r = rstd[ai][m]; const f32x4 a0 = acc[ai][bj][m][0] * r, a1 = acc[ai][bj][m][1] * r;
                        float s = ((a0[0] * a0[0] + a0[1] * a0[1]) + (a0[2] * a0[2] + a0[3] * a0[3])) + ((a1[0] * a1[0] + a1[1] * a1[1]) + (a1[2] * a1[2] + a1[3] * a1[3]));
                        s += __shfl_xor(s, 16); s += __shfl_xor(s, 32);
                        if (fq == 0) P[((ai * HALF + wr * 64 + m * 16 + fr) * 2 + bj) * 4 + wc] = s; }
            asm volatile("s_waitcnt lgkmcnt(0)" ::: "memory"); __builtin_amdgcn_s_barrier(); asm volatile("" ::: "memory");
            const float qs = (grp == 1) ? 0.08838834764831845f : 1.0f;
            f32x4 cs0[2], cs1[2];
#pragma unroll
            for (int bj = 0; bj < 2; ++bj) { cs0[bj] = (f32x4){0.f, 0.f, 0.f, 0.f}; cs1[bj] = (f32x4){0.f, 0.f, 0.f, 0.f}; }
#pragma unroll
            for (int ai = 0; ai < 2; ++ai)
#pragma unroll
                for (int m = 0; m < 4; ++m) { const int row = row0 + ai * HALF + m * 16;
                    bf16_t* rowp = (LDSR && grp == 5) ? kvc + ((size_t)u.pm * 8 + 2 * (u.pn & 1)) * 32768 + (row & 255) * 128 + wc * 32 + 8 * fq
                                 : (LDSR && grp == 1) ? qc + ((size_t)((row >> 13) * 4 + 2 * (u.pn & 1)) * 8192 + (row & 8191)) * 128 + wc * 32 + 8 * fq
                                 : O + (size_t)row * ldc + col0;
                    const int bjs = (LDSR && grp == 5) ? 32768 : (LDSR && grp == 1) ? 8192 * 128 : HALF;
#pragma unroll
                    for (int bj = 0; bj < 2; ++bj) { const f32x4 pq = *(const PG8_LAS f32x4*)(P + ((ai * HALF + wr * 64 + m * 16 + fr) * 2 + bj) * 4);
                        const float tot = (pq[0] + pq[1]) + (pq[2] + pq[3]);
                        const float r = rstd[ai][m] * qs / sqrtf(tot * (1.0f / 128.0f) + EPS);
                        const f32x4 v0 = acc[ai][bj][m][0] * r * g0, v1 = acc[ai][bj][m][1] * r * g1;
                        if (grp == 5) { cs0[bj] += v0; cs1[bj] += v1; }
                        store8(rowp + bj * bjs, v0, v1); } }
            if (grp == 5) {
                PG8_LAS float* KS = xl + 2048;
#pragma unroll
                for (int bj = 0; bj < 2; ++bj)
#pragma unroll
                    for (int e = 0; e < 4; ++e) { float a = cs0[bj][e], b = cs1[bj][e];
                        a += __shfl_xor(a, 1); a += __shfl_xor(a, 2); a += __shfl_xor(a, 4); a += __shfl_xor(a, 8);
                        b += __shfl_xor(b, 1); b += __shfl_xor(b, 2); b += __shfl_xor(b, 4); b += __shfl_xor(b, 8);
                        if (fr == 0) { KS[wr * 256 + bj * HALF + wc * 32 + 8 * fq + e] = a; KS[wr * 256 + bj * HALF + wc * 32 + 8 * fq + 4 + e] = b; } }
                asm volatile("s_waitcnt lgkmcnt(0)" ::: "memory"); __builtin_amdgcn_s_barrier(); asm volatile("" ::: "memory");
                const int t = (wr * 4 + wc) * 64 + fq * 16 + fr;
                if (t < 256) { const int b = u.pm >> 5, blk = u.pm & 31, hh = 2 * (u.pn & 1) + (t >> 7);
                    kmean[((size_t)(b * 4 + hh) * 32 + blk) * 128 + (t & 127)] = (KS[t] + KS[256 + t]) * (1.0f / 256.0f); }
            }
            asm volatile("s_waitcnt lgkmcnt(0)" ::: "memory"); __builtin_amdgcn_s_barrier(); asm volatile("" ::: "memory");
        } else {
#pragma unroll
            for (int ai = 0; ai < 2; ++ai)
#pragma unroll
                for (int m = 0; m < 4; ++m) { const int row = row0 + ai * HALF + m * 16; const float r = rstd[ai][m];
                    bf16_t* rowp = (LDSR && grp == 6) ? kvc + ((size_t)u.pm * 8 + 4 + 2 * (u.pn & 1)) * 32768 + (row & 255) * 128 + wc * 32 + 8 * fq : O + (size_t)row * ldc + col0;
                    const int bjs = (LDSR && grp == 6) ? 32768 : HALF;
#pragma unroll
                    for (int bj = 0; bj < 2; ++bj) { const f32x4 v0 = acc[ai][bj][m][0] * r, v1 = acc[ai][bj][m][1] * r;
                        if (grp == 4 || grp == 7) { u32x4 w; w.x = pk2(v0[0], v0[1]); w.y = pk2(v0[2], v0[3]); w.z = pk2(v1[0], v1[1]); w.w = pk2(v1[2], v1[3]); __builtin_nontemporal_store(w, (u32x4*)(rowp + bj * HALF)); }
                        else store8(rowp + bj * bjs, v0, v1); } }
        }
    }
};
struct EpiE {
    static constexpr bool PERM = true, AFTER_DRAIN = false;
    __device__ __forceinline__ void after_stage(int) const {}
    bf16_t* O; int ldc; float* rs;
    __device__ __forceinline__ void operator()(const f32x4 (&acc)[2][2][4][2], const Unit& u, int wr, int wc, int fr, int fq) const {
        const int row0 = u.pm * BM + wr * 64 + fr, col0 = u.pn * BM + wc * 32 + 8 * fq;
#pragma unroll
        for (int ai = 0; ai < 2; ++ai)
#pragma unroll
            for (int m = 0; m < 4; ++m) { const int row = row0 + ai * HALF + m * 16; float s = 0.f;
                bf16_t* rowp = O + (size_t)row * ldc + col0;
#pragma unroll
                for (int bj = 0; bj < 2; ++bj) { const f32x4 v0 = acc[ai][bj][m][0], v1 = acc[ai][bj][m][1];
                    s += (v0[0] * v0[0] + v0[1] * v0[1]) + (v0[2] * v0[2] + v0[3] * v0[3]); s += (v1[0] * v1[0] + v1[1] * v1[1]) + (v1[2] * v1[2] + v1[3] * v1[3]);
                    u32x4 w; w.x = pk2(v0[0], v0[1]); w.y = pk2(v0[2], v0[3]); w.z = pk2(v1[0], v1[1]); w.w = pk2(v1[2], v1[3]);
                    *(u32x4*)(rowp + bj * HALF) = w; }
                s += __shfl_xor(s, 16); s += __shfl_xor(s, 32);
                if (fq == 0) rs[(size_t)row * 16 + u.pn * 4 + wc] = s; }
    }
};
template <bool BASE_BF16> struct EpiRes {
    static constexpr bool PERM = true, AFTER_DRAIN = false;
    __device__ __forceinline__ void after_stage(int) const {}
    const void* base; bf16_t* xb; float* rs; int ldc; int ldxb;
    __device__ __forceinline__ void operator()(const f32x4 (&acc)[2][2][4][2], const Unit& u, int wr, int wc, int fr, int fq) const {
#if defined(EXP_NOEPI_RES)
        if (acc[0][0][0][0][0] != 123456.789f) return;
#endif
        const int row0 = u.pm * BM + wr * 64 + fr, col0 = u.pn * BM + wc * 32 + 8 * fq;
        static_assert(BASE_BF16, "f32 base: not used");
        u32x4 bsh[2][4][2];
#pragma unroll
        for (int ai = 0; ai < 2; ++ai)
#pragma unroll
            for (int m = 0; m < 4; ++m) { const size_t off = (size_t)(row0 + ai * HALF + m * 16) * ldc + col0;
#pragma unroll
                for (int bj = 0; bj < 2; ++bj) bsh[ai][m][bj] = __builtin_nontemporal_load((const u32x4*)((const bf16_t*)base + off + bj * HALF)); }
        asm volatile("" ::: "memory");
#pragma unroll
        for (int ai = 0; ai < 2; ++ai) {
#pragma unroll
            for (int m = 0; m < 4; ++m) { const int row = row0 + ai * HALF + m * 16; float s = 0.f; const size_t offb = (size_t)row * ldxb + col0;
#pragma unroll
                for (int bj = 0; bj < 2; ++bj) { f32x4 b0, b1;
                    { const u32x4 w = bsh[ai][m][bj]; b0[0] = bflo(w.x); b0[1] = bfhi(w.x); b0[2] = bflo(w.y); b0[3] = bfhi(w.y); b1[0] = bflo(w.z); b1[1] = bfhi(w.z); b1[2] = bflo(w.w); b1[3] = bfhi(w.w); }
                    const f32x4 x0 = b0 + acc[ai][bj][m][0], x1 = b1 + acc[ai][bj][m][1];
                    s += ((x0[0] * x0[0] + x0[1] * x0[1]) + (x0[2] * x0[2] + x0[3] * x0[3])) + ((x1[0] * x1[0] + x1[1] * x1[1]) + (x1[2] * x1[2] + x1[3] * x1[3]));
                    u32x4 w; w.x = pk2(x0[0], x0[1]); w.y = pk2(x0[2], x0[3]); w.z = pk2(x1[0], x1[1]); w.w = pk2(x1[2], x1[3]); *(u32x4*)(xb + offb + bj * HALF) = w; }
                s += __shfl_xor(s, 16); s += __shfl_xor(s, 32);
                if (fq == 0) rs[(size_t)row * 16 + u.pn * 4 + wc] = s; }
            asm volatile("" ::: "memory");
        }
    }
};
#ifndef GATE_PIPE
#define GATE_PIPE 1
#endif
#ifndef GATE_L0
#define GATE_L0 3
#define GATE_L1 5
#endif
template <bool LAST, bool LDSR  > struct EpiGate {
    static constexpr bool PERM = true, AFTER_DRAIN = false;
    const bf16_t* x1b; int ldx1; const bf16_t* epre; const float* rs1; const float* rse; const float* pg; bf16_t* xb; float* rso; float* out; int ldc; const PG8_LAS float* r1l; const PG8_LAS float* rel; const PG8_LAS float* gl  ;
    f32x4 f1q[4], feq[4]; float gq; PG8_LAS float* rw;
    __device__ __forceinline__ void after_stage(int tid) const {
        if constexpr (LDSR) {
            const float t1 = (((f1q[0][0] + f1q[0][1]) + (f1q[0][2] + f1q[0][3])) + ((f1q[1][0] + f1q[1][1]) + (f1q[1][2] + f1q[1][3]))) + (((f1q[2][0] + f1q[2][1]) + (f1q[2][2] + f1q[2][3])) + ((f1q[3][0] + f1q[3][1]) + (f1q[3][2] + f1q[3][3])));
            const float te = (((feq[0][0] + feq[0][1]) + (feq[0][2] + feq[0][3])) + ((feq[1][0] + feq[1][1]) + (feq[1][2] + feq[1][3]))) + (((feq[2][0] + feq[2][1]) + (feq[2][2] + feq[2][3])) + ((feq[3][0] + feq[3][1]) + (feq[3][2] + feq[3][3])));
            rw[0] = 1.0f / sqrtf(t1 * (1.0f / 1024.0f) + EPS); rw[512] = 1.0f / sqrtf(te * (1.0f / 1024.0f) + EPS); if (tid < 256) rw[1024] = gq; } }
    template <int R0, int RG> __device__ __forceinline__ void issue(u32x4 (&xw)[RG][2], u32x4 (&ew)[RG][2], f32x4 (&q1)[LDSR ? 1 : RG], f32x4 (&qe)[LDSR ? 1 : RG], int row0, int col0, int fq) const {
        if constexpr (!LDSR) {
#pragma unroll
            for (int mm = 0; mm < RG; ++mm) { const int ai = (R0 + mm) >> 2, m = (R0 + mm) & 3; const size_t r16 = (size_t)(row0 + ai * HALF + m * 16) * 16 + 4 * fq; q1[mm] = *(const f32x4*)(rs1 + r16); qe[mm] = *(const f32x4*)(rse + r16); } }
#pragma unroll
        for (int mm = 0; mm < RG; ++mm) { const int ai = (R0 + mm) >> 2, m = (R0 + mm) & 3; const int row = row0 + ai * HALF + m * 16;
#pragma unroll
            for (int bj = 0; bj < 2; ++bj) { xw[mm][bj] = *(const u32x4*)(x1b + (size_t)row * ldx1 + col0 + bj * HALF); ew[mm][bj] = *(const u32x4*)(epre + (size_t)row * ldc + col0 + bj * HALF); } }
        asm volatile("" ::: "memory");
    }
    template <int R0, int RG> __device__ __forceinline__ void finish(const f32x4 (&acc)[2][2][4][2], const f32x4 (&g)[2][2], const u32x4 (&xw)[RG][2], const u32x4 (&ew)[RG][2], const f32x4 (&q1)[LDSR ? 1 : RG], const f32x4 (&qe)[LDSR ? 1 : RG],
                                                              const Unit& u, int row0, int col0, int wc, int fq) const {
        float r1[RG], re[RG];
#pragma unroll
        for (int mm = 0; mm < RG; ++mm) {
            if constexpr (LDSR) { const int ai = (R0 + mm) >> 2, m = (R0 + mm) & 3; const int li = ((u.pm >> 3) & 1) * 256 + (row0 & 255) + ai * HALF + m * 16; r1[mm] = r1l[li]; re[mm] = rel[li]; }
            else { float s1 = (q1[mm][0] + q1[mm][1]) + (q1[mm][2] + q1[mm][3]), se = (qe[mm][0] + qe[mm][1]) + (qe[mm][2] + qe[mm][3]);
                s1 += __shfl_xor(s1, 16); s1 += __shfl_xor(s1, 32); se += __shfl_xor(se, 16); se += __shfl_xor(se, 32);
                r1[mm] = 1.0f / sqrtf(s1 * (1.0f / 1024.0f) + EPS); re[mm] = 1.0f / sqrtf(se * (1.0f / 1024.0f) + EPS); } }
#pragma unroll
        for (int mm = 0; mm < RG; ++mm) { const int ai = (R0 + mm) >> 2, m = (R0 + mm) & 3; const int row = row0 + ai * HALF + m * 16; float s = 0.f; const size_t off = (size_t)row * ldc + col0;
#pragma unroll
            for (int bj = 0; bj < 2; ++bj) { const size_t o = off + bj * HALF; const u32x4 e4 = ew[mm][bj], x4 = xw[mm][bj];
                f32x4 xo[2];
#pragma unroll
                for (int n = 0; n < 2; ++n) { const f32x4 a = acc[ai][bj][m][n] * r1[mm]; const unsigned e_lo = n ? e4.z : e4.x, e_hi = n ? e4.w : e4.y, x_lo = n ? x4.z : x4.x, x_hi = n ? x4.w : x4.y;
                    f32x4 gg; if constexpr (LDSR) gg = *(const PG8_LAS f32x4*)(gl + (col0 & 255) + bj * HALF + n * 4); else gg = g[bj][n];
                    f32x4 e; e[0] = bflo(e_lo); e[1] = bfhi(e_lo); e[2] = bflo(e_hi); e[3] = bfhi(e_hi); e = e * re[mm] * gg;
                    f32x4 xr; xr[0] = bflo(x_lo); xr[1] = bfhi(x_lo); xr[2] = bflo(x_hi); xr[3] = bfhi(x_hi);
                    f32x4 sg; sg[0] = __builtin_amdgcn_rcpf(1.0f + __expf(-a[0])); sg[1] = __builtin_amdgcn_rcpf(1.0f + __expf(-a[1])); sg[2] = __builtin_amdgcn_rcpf(1.0f + __expf(-a[2])); sg[3] = __builtin_amdgcn_rcpf(1.0f + __expf(-a[3]));
                    xo[n] = xr + sg * e; }
                if constexpr (LAST) { __builtin_nontemporal_store(xo[0], (f32x4*)(out + o)); __builtin_nontemporal_store(xo[1], (f32x4*)(out + o + 4)); }
                else { s += ((xo[0][0] * xo[0][0] + xo[0][1] * xo[0][1]) + (xo[0][2] * xo[0][2] + xo[0][3] * xo[0][3])) + ((xo[1][0] * xo[1][0] + xo[1][1] * xo[1][1]) + (xo[1][2] * xo[1][2] + xo[1][3] * xo[1][3]));
                    u32x4 w; w.x = pk2(xo[0][0], xo[0][1]); w.y = pk2(xo[0][2], xo[0][3]); w.z = pk2(xo[1][0], xo[1][1]); w.w = pk2(xo[1][2], xo[1][3]); *(u32x4*)(xb + o) = w; } }
            if constexpr (!LAST) { s += __shfl_xor(s, 16); s += __shfl_xor(s, 32); if (fq == 0) rso[(size_t)row * 16 + u.pn * 4 + wc] = s; } }
        asm volatile("" ::: "memory");
    }
    template <int R0, int RG> __device__ __forceinline__ void batch(const f32x4 (&acc)[2][2][4][2], const f32x4 (&g)[2][2], const Unit& u, int row0, int col0, int wc, int fq) const {
        u32x4 xw[RG][2], ew[RG][2]; f32x4 q1[LDSR ? 1 : RG], qe[LDSR ? 1 : RG];
        issue<R0, RG>(xw, ew, q1, qe, row0, col0, fq); finish<R0, RG>(acc, g, xw, ew, q1, qe, u, row0, col0, wc, fq);
    }
    __device__ __forceinline__ void operator()(const f32x4 (&acc)[2][2][4][2], const Unit& u, int wr, int wc, int fr_, int fq_) const {
        int t_ = (int)__builtin_amdgcn_mbcnt_hi(~0u, __builtin_amdgcn_mbcnt_lo(~0u, 0u)); asm volatile("" : "+v"(t_));
        const int fr = t_ & 15, fq = t_ >> 4;
        const int row0 = u.pm * BM + wr * 64 + fr, col0 = u.pn * BM + wc * 32 + 8 * fq;
        f32x4 g[2][2];
        if constexpr (!LDSR) {
#pragma unroll
            for (int bj = 0; bj < 2; ++bj)
#pragma unroll
                for (int n = 0; n < 2; ++n) g[bj][n] = *(const f32x4*)(pg + col0 + bj * HALF + n * 4);
            asm volatile("" ::: "memory"); }
        if constexpr (LDSR && GATE_PIPE) {
            u32x4 x0[1][2], e0[1][2], x1_[1][2], e1[1][2], x2[1][2], e2[1][2]; f32x4 qd[1], qf[1];
            issue<0, 1>(x0, e0, qd, qf, row0, col0, fq); issue<1, 1>(x1_, e1, qd, qf, row0, col0, fq); issue<2, 1>(x2, e2, qd, qf, row0, col0, fq);
            finish<0, 1>(acc, g, x0, e0, qd, qf, u, row0, col0, wc, fq); issue<3, 1>(x0, e0, qd, qf, row0, col0, fq);
            finish<1, 1>(acc, g, x1_, e1, qd, qf, u, row0, col0, wc, fq); issue<4, 1>(x1_, e1, qd, qf, row0, col0, fq);
            finish<2, 1>(acc, g, x2, e2, qd, qf, u, row0, col0, wc, fq); issue<5, 1>(x2, e2, qd, qf, row0, col0, fq);
            finish<3, 1>(acc, g, x0, e0, qd, qf, u, row0, col0, wc, fq); issue<6, 1>(x0, e0, qd, qf, row0, col0, fq);
            finish<4, 1>(acc, g, x1_, e1, qd, qf, u, row0, col0, wc, fq); issue<7, 1>(x1_, e1, qd, qf, row0, col0, fq);
            finish<5, 1>(acc, g, x2, e2, qd, qf, u, row0, col0, wc, fq);
            finish<6, 1>(acc, g, x0, e0, qd, qf, u, row0, col0, wc, fq);
            finish<7, 1>(acc, g, x1_, e1, qd, qf, u, row0, col0, wc, fq);
        } else if constexpr (LDSR) {
            batch<0, GATE_L0>(acc, g, u, row0, col0, wc, fq);
            batch<GATE_L0, GATE_L1>(acc, g, u, row0, col0, wc, fq);
            if constexpr (GATE_L0 + GATE_L1 < 8) batch<GATE_L0 + GATE_L1, 8 - GATE_L0 - GATE_L1>(acc, g, u, row0, col0, wc, fq);
        } else { batch<0, 2>(acc, g, u, row0, col0, wc, fq); batch<2, 2>(acc, g, u, row0, col0, wc, fq); batch<4, 2>(acc, g, u, row0, col0, wc, fq); batch<6, 2>(acc, g, u, row0, col0, wc, fq); }
    }
};

template <class Epi, class Sched, bool ALIGN_EPI = false, bool SP2 = false, bool CHAIN = false>
__device__ __forceinline__ void gemm_phase(PG8_LAS unsigned char* lds, const Gemm g, const Sched& S, const Epi& E, const bool chain_in = false, const char* chainA = nullptr, const char* chainB = nullptr) {
    static_assert(!CHAIN || (ALIGN_EPI && SP2 && !Epi::AFTER_DRAIN), "CHAIN needs aligned epilogues");
    int tid = threadIdx.x; asm volatile("" : "+v"(tid));
    const int wid = __builtin_amdgcn_readfirstlane(tid >> 6), lane = tid & 63, wr = wid >> 2, wc = wid & 3, fr = lane & 15, fq = lane >> 4;
    const int K = g.K, lda = g.lda, nt = K / BK;
    unsigned voffA[2], voffB[2];
#pragma unroll
    for (int i = 0; i < 2; ++i) { int R, C; stage_rc(tid * 16 + i * 8192, R, C); const int Rb = Epi::PERM ? ((R & ~31) + perm32(R & 31)) : R;
        voffA[i] = (unsigned)(R * lda + C) * 2u; voffB[i] = (unsigned)(Rb * K + C) * 2u; }
    const size_t kstep = (size_t)(BK * 2);
    const size_t hstepB = (size_t)HALF * K * 2, hstepA = (size_t)HALF * lda * 2;
    const size_t tstepB = 2 * hstepB, tstepA = 2 * hstepA;
    const unsigned ldsw = (unsigned)wid * 1024u;
    const int aoff = lds_byte(wr * 64 + fr, fq * 8), boff = lds_byte(wc * 32 + fr, fq * 8);
#define PG8_SA(b, h) (((b) * 2 + (h)) * HTB)
#define PG8_SB(b, h) ((4 + (b) * 2 + (h)) * HTB)
#define PG8_STAGE(bufoff, gbase, voff) do { _Pragma("unroll") for (int _i = 0; _i < 2; ++_i) \
        __builtin_amdgcn_global_load_lds((const unsigned*)((const char*)(gbase) + (voff)[_i]), (PG8_LAS unsigned*)(lds + (bufoff) + ldsw + _i * 8192), 16, 0, 0); } while (0)
#define PG8_LDA(dst, b, h) do { _Pragma("unroll") for (int m = 0; m < 4; ++m) _Pragma("unroll") for (int k = 0; k < 2; ++k) dst[m][k] = *(const PG8_LAS bf16x8*)(lds + PG8_SA(b, h) + aoff + m * 2048 + k * 1024); } while (0)
#define PG8_LDB(dst, b, h) do { _Pragma("unroll") for (int n = 0; n < 2; ++n) _Pragma("unroll") for (int k = 0; k < 2; ++k) dst[n][k] = *(const PG8_LAS bf16x8*)(lds + PG8_SB(b, h) + boff + n * 2048 + k * 1024); } while (0)
#define PG8_MMA(ai, bj, At, Bt) do { __builtin_amdgcn_s_setprio(1); _Pragma("unroll") for (int m = 0; m < 4; ++m) _Pragma("unroll") for (int n = 0; n < 2; ++n) _Pragma("unroll") for (int k = 0; k < 2; ++k) \
        acc[ai][bj][m][n] = __builtin_amdgcn_mfma_f32_16x16x32_bf16(Bt[n][k], At[m][k], acc[ai][bj][m][n], 0, 0, 0); __builtin_amdgcn_s_setprio(0); } while (0)
#define PG8_WAIT_V(n) asm volatile("s_waitcnt vmcnt(" #n ")" ::: "memory")
#define PG8_WAIT_L(n) asm volatile("s_waitcnt lgkmcnt(" #n ")" ::: "memory")
#define PG8_BAR __builtin_amdgcn_s_barrier()
#define PG8_SCHED __builtin_amdgcn_sched_barrier(0)
    Unit cur, nxt; int ui = 0;
    if (!S.next(0, cur)) return;
    f32x4 acc[2][2][4][2];
#pragma unroll
    for (int a = 0; a < 2; ++a)
#pragma unroll
        for (int b = 0; b < 2; ++b)
#pragma unroll
            for (int m = 0; m < 4; ++m)
#pragma unroll
                for (int n = 0; n < 2; ++n) acc[a][b][m][n] = (f32x4){0.f, 0.f, 0.f, 0.f};
    bf16x8 At[4][2], B0[2][2], B1[2][2];
    const char* cA = (const char*)g.A + (size_t)cur.pm * tstepA; const char* cB = (const char*)g.Bt + (size_t)cur.pn * tstepB;
    S.a_ready(cur);
    if (CHAIN && chain_in) { if (wr == 1) PG8_BAR; }
    else if constexpr (SP2) {
        PG8_STAGE(PG8_SB(0, 0), cB, voffB); PG8_STAGE(PG8_SB(0, 1), cB + hstepB, voffB); PG8_STAGE(PG8_SA(0, 0), cA, voffA); PG8_STAGE(PG8_SA(0, 1), cA + hstepA, voffA);
        E.after_stage(tid);
        if (wr == 1) PG8_BAR;
        PG8_WAIT_V(2); PG8_BAR;
        PG8_STAGE(PG8_SB(1, 0), cB + kstep, voffB); PG8_STAGE(PG8_SA(1, 0), cA + kstep, voffA); PG8_STAGE(PG8_SB(1, 1), cB + hstepB + kstep, voffB);
        PG8_WAIT_V(6); PG8_BAR;
    } else {
        PG8_STAGE(PG8_SB(0, 0), cB, voffB); PG8_STAGE(PG8_SA(0, 0), cA, voffA); PG8_STAGE(PG8_SB(0, 1), cB + hstepB, voffB); PG8_STAGE(PG8_SA(0, 1), cA + hstepA, voffA);
        if (wr == 1) PG8_BAR;
        PG8_WAIT_V(4); PG8_BAR;
        PG8_STAGE(PG8_SB(1, 0), cB + kstep, voffB); PG8_STAGE(PG8_SA(1, 0), cA + kstep, voffA); PG8_STAGE(PG8_SB(1, 1), cB + hstepB + kstep, voffB);
        PG8_WAIT_V(6); PG8_BAR;
    }
    for (;;) {
        const bool has_next = S.next(ui + 1, nxt);
        const char* nA = has_next ? (const char*)g.A + (size_t)nxt.pm * tstepA : (CHAIN && chainA) ? chainA : cA; const char* nB = has_next ? (const char*)g.Bt + (size_t)nxt.pn * tstepB : (CHAIN && chainA) ? chainB : cB;
#if defined(EXP_KSTAMP)
        if (blockIdx.x == 0 && tid == 0) { volatile PG8_LAS unsigned* M_ = (volatile PG8_LAS unsigned*)(lds + 163136); const unsigned k_ = M_[31]; M_[32 + k_] = (unsigned)__builtin_amdgcn_s_memrealtime(); M_[31] = k_ + 1; }
#endif
#pragma nounroll
        for (int t = 0; t < nt; t += 2) {
            const bool last = (t == nt - 2);
            const char* a1 = cA + (size_t)(t + 1) * kstep;
            const char* a2 = last ? nA : cA + (size_t)(t + 2) * kstep; const char* b2 = last ? nB : cB + (size_t)(t + 2) * kstep;
            const char* a3 = a2 + kstep; const char* b3 = b2 + kstep;
            if (last && has_next) S.a_ready(nxt);
            if constexpr (SP2) {
            PG8_LDB(B0, 0, 0); PG8_LDB(B1, 0, 1); PG8_SCHED; PG8_LDA(At, 0, 0); PG8_STAGE(PG8_SA(1, 1), a1 + hstepA, voffA);
            PG8_WAIT_V(8); PG8_WAIT_L(0); PG8_BAR; PG8_MMA(0, 0, At, B0); PG8_MMA(0, 1, At, B1); PG8_BAR; PG8_SCHED;
            PG8_LDA(At, 0, 1); PG8_STAGE(PG8_SB(0, 0), b2, voffB); PG8_STAGE(PG8_SB(0, 1), b2 + hstepB, voffB); PG8_STAGE(PG8_SA(0, 0), a2, voffA);
            PG8_WAIT_V(8); PG8_WAIT_L(0); PG8_BAR; PG8_MMA(1, 0, At, B0); PG8_MMA(1, 1, At, B1); PG8_BAR; PG8_SCHED;
            PG8_LDB(B0, 1, 0); PG8_LDB(B1, 1, 1); PG8_SCHED; PG8_LDA(At, 1, 0); PG8_STAGE(PG8_SA(0, 1), a2 + hstepA, voffA);
            PG8_WAIT_V(8); PG8_WAIT_L(0); PG8_BAR; PG8_MMA(0, 0, At, B0); PG8_MMA(0, 1, At, B1); PG8_BAR; PG8_SCHED;
            PG8_LDA(At, 1, 1); PG8_STAGE(PG8_SB(1, 0), b3, voffB); PG8_STAGE(PG8_SB(1, 1), b3 + hstepB, voffB); PG8_STAGE(PG8_SA(1, 0), a3, voffA);
            PG8_WAIT_V(8); PG8_WAIT_L(0); PG8_BAR; PG8_MMA(1, 0, At, B0); PG8_MMA(1, 1, At, B1); PG8_BAR; PG8_SCHED;
            } else {
            PG8_LDB(B0, 0, 0); PG8_SCHED; PG8_LDA(At, 0, 0); PG8_STAGE(PG8_SA(1, 1), a1 + hstepA, voffA);
            PG8_WAIT_L(8); PG8_BAR; PG8_WAIT_L(0); PG8_MMA(0, 0, At, B0); PG8_BAR; PG8_SCHED;
            PG8_LDB(B1, 0, 1); PG8_STAGE(PG8_SB(0, 0), b2, voffB);
            PG8_BAR; PG8_WAIT_L(0); PG8_MMA(0, 1, At, B1); PG8_BAR;
            PG8_LDA(At, 0, 1); PG8_STAGE(PG8_SA(0, 0), a2, voffA);
            PG8_BAR; PG8_WAIT_L(0); PG8_MMA(1, 0, At, B0); PG8_BAR; PG8_SCHED;
            PG8_STAGE(PG8_SB(0, 1), b2 + hstepB, voffB);
            PG8_WAIT_V(6); PG8_BAR; PG8_MMA(1, 1, At, B1); PG8_BAR;
            PG8_LDB(B0, 1, 0); PG8_SCHED; PG8_LDA(At, 1, 0); PG8_STAGE(PG8_SA(0, 1), a2 + hstepA, voffA);
            PG8_WAIT_L(8); PG8_BAR; PG8_WAIT_L(0); PG8_MMA(0, 0, At, B0); PG8_BAR; PG8_SCHED;
            PG8_LDB(B1, 1, 1); PG8_STAGE(PG8_SB(1, 0), b3, voffB);
            PG8_BAR; PG8_WAIT_L(0); PG8_MMA(0, 1, At, B1); PG8_BAR;
            PG8_LDA(At, 1, 1); PG8_STAGE(PG8_SA(1, 0), a3, voffA);
            PG8_BAR; PG8_WAIT_L(0); PG8_MMA(1, 0, At, B0); PG8_BAR; PG8_SCHED;
            PG8_STAGE(PG8_SB(1, 1), b3 + hstepB, voffB);
            PG8_WAIT_V(6); PG8_BAR; PG8_MMA(1, 1, At, B1); PG8_BAR;
            }
        }
#if defined(EXP_KSTAMP)
        if (blockIdx.x == 0 && tid == 0) { volatile PG8_LAS unsigned* M_ = (volatile PG8_LAS unsigned*)(lds + 163136); const unsigned k_ = M_[31]; M_[32 + k_] = (unsigned)__builtin_amdgcn_s_memrealtime(); M_[31] = k_ + 1; }
#endif
        if constexpr (ALIGN_EPI) { if (wr == 0) PG8_BAR; }
#if defined(EXP_NOEPI)
        if constexpr (!Epi::AFTER_DRAIN) { if (acc[0][0][0][0][0] == 123456.789f) E(acc, cur, wr, wc, fr, fq); S.done(cur); }
#else
        if constexpr (!Epi::AFTER_DRAIN) { E(acc, cur, wr, wc, fr, fq); S.done(cur); }
#endif
        if (!has_next) break;
#pragma unroll
        for (int a = 0; a < 2; ++a)
#pragma unroll
            for (int b = 0; b < 2; ++b)
#pragma unroll
                for (int m = 0; m < 4; ++m)
#pragma unroll
                    for (int n = 0; n < 2; ++n) acc[a][b][m][n] = (f32x4){0.f, 0.f, 0.f, 0.f};
        cur = nxt; cA = nA; cB = nB; ++ui;
        if constexpr (ALIGN_EPI) { if (wr == 1) PG8_BAR; }
    }
    if (CHAIN && chainA) return;
    PG8_WAIT_V(0);
    if constexpr (!ALIGN_EPI) { if (wr == 0) PG8_BAR; }
    PG8_BAR;
    if constexpr (Epi::AFTER_DRAIN) { E.fused(acc, cur, wr, wc, fr, fq, lds, wid, lane); S.done(cur); }
#undef PG8_SA
#undef PG8_SB
#undef PG8_STAGE
#undef PG8_LDA
#undef PG8_LDB
#undef PG8_MMA
#undef PG8_WAIT_V
#undef PG8_WAIT_L
#undef PG8_BAR
#undef PG8_SCHED
}
}

constexpr int NWAVES = 8;
constexpr int DM = 1024, SEQ = 8192, NBATCH = 4, M = NBATCH * SEQ, INW = 4096, PLE = 256, DEPTH = 2, HD = 128, NH = 4, NBLK = 32  , NCH = 64  ;
constexpr int C_RQ = 0, C_MQ = 512, C_RK = 1024, C_RV = 1536, C_RZ = 2048, C_MK = 2560, C_MV = 3072, C_MZ = 3584;
constexpr int C_X1B = 1024;
constexpr float RSQRT_HD = 0.08838834764831845f;

constexpr size_t MiB = 1u << 20;
constexpr size_t WS_CTL = 0, CTL_ZERO_BYTES = 64 * 1024;
constexpr size_t WS_WIN = 1 * MiB;
constexpr size_t WS_WOUT = 17 * MiB;
constexpr size_t WS_WG = 21 * MiB;
constexpr size_t WS_WPLE = 25 * MiB;
constexpr size_t WS_TAB = 26 * MiB;
constexpr size_t WS_LUT = 30 * MiB;
constexpr size_t WS_KMEAN = 30 * MiB + 128 * 1024;
constexpr size_t WS_SEL = 30 * MiB + 512 * 1024;
constexpr size_t WS_RSX = 31 * MiB;
constexpr size_t WS_RSX1 = 33 * MiB;
constexpr size_t WS_RSE = 35 * MiB;
constexpr size_t WS_PE = 37 * MiB;
constexpr size_t WS_PE2 = 213 * MiB;
constexpr size_t WS_KV = 53 * MiB;
constexpr size_t WS_EPRE = 85 * MiB;
constexpr size_t WS_XB = 149 * MiB;
constexpr size_t WS_PROJ = 245 * MiB;
constexpr size_t WS_END = 501 * MiB;
constexpr int CW_BAR = 4096;
constexpr int CW_SCAN = 12288;
constexpr int CW_GRP = 10240;

constexpr int RING_OFF = 0, RING_BYTES = 131072;
constexpr int LDSCTL_OFF = 162816, MISC_OFF = LDSCTL_OFF + 320;
constexpr int LDS_RS_OFF = RING_BYTES + 12288;
constexpr int LDS_BYTES = 163840;

#define GAS __attribute__((address_space(1)))
#define LAS __attribute__((address_space(3)))
typedef unsigned short bf16;
typedef unsigned v4u __attribute__((ext_vector_type(4)));
typedef unsigned v2u __attribute__((ext_vector_type(2)));
typedef float f32x4 __attribute__((ext_vector_type(4)));
typedef float f32x2v __attribute__((ext_vector_type(2)));
typedef GAS unsigned gu32;
#define RLX_AGENT __ATOMIC_RELAXED, __HIP_MEMORY_SCOPE_AGENT
#define LDS_WAIT() asm volatile("s_waitcnt lgkmcnt(0)" ::: "memory")
#define VM_WAIT() asm volatile("s_waitcnt vmcnt(0)" ::: "memory")
using pg8::pk2; using pg8::bflo; using pg8::bfhi;
__device__ __forceinline__ float bf2f(unsigned short u) { return __uint_as_float(((unsigned)u) << 16); }

#if defined(PROBE_T0)
#define PSTAMP() do { if (blockIdx.x == 0 && threadIdx.x == 0) { extern __shared__ unsigned char l_probe_[]; volatile LAS unsigned* M_ = (volatile LAS unsigned*)((LAS unsigned char*)l_probe_ + MISC_OFF); const unsigned k_ = M_[31]; M_[32 + k_] = (unsigned)__builtin_amdgcn_s_memrealtime(); M_[31] = k_ + 1; } } while (0)
#else
#define PSTAMP() do { } while (0)
#endif
#define XB_TMO      128
#define XB_XCNT(j)  (256  + 64 * (j))
#define XB_XSUB(j)  (1280 + 64 * (j))
#define XB_XGEN(j)  (2304 + 64 * (j))
#define XB_TOP      3328
#define XB_TOPGEN   3392
#define XCD_BAR_WORDS 3456
#define XB_SPIN_CAP (1u << 18)

__device__ __forceinline__ unsigned xb_ld(unsigned* p)              { return __hip_atomic_load(p, __ATOMIC_RELAXED, __HIP_MEMORY_SCOPE_AGENT); }
__device__ __forceinline__ unsigned xb_add(unsigned* p, unsigned v) { return __hip_atomic_fetch_add(p, v, __ATOMIC_RELAXED, __HIP_MEMORY_SCOPE_AGENT); }
__device__ __forceinline__ unsigned xb_xcc_id() { return (unsigned)__builtin_amdgcn_s_getreg((3 << 11) | 20) & 0xFu; }
#define XB_SPIN(cond, bar) do { unsigned _sp = 0; while (cond) { __builtin_amdgcn_s_sleep(1); \
    if ((++_sp & 255u) == 0u) { if (xb_ld(&(bar)[XB_TMO])) break; if (_sp > XB_SPIN_CAP) { atomicAdd(&(bar)[XB_TMO], 1u); break; } } } } while (0)

struct XcdBarrier {
    unsigned* bar; unsigned x;
    volatile LAS unsigned* st;
};

__device__ __forceinline__ XcdBarrier xcd_barrier_post(unsigned* bar, volatile LAS unsigned* st) {
    XcdBarrier b; b.bar = bar; b.x = xb_xcc_id(); b.st = st;
    if (threadIdx.x == 0) (void)xb_add(&bar[XB_XCNT(b.x)], 1u);
    return b;
}
__device__ __forceinline__ void xcd_barrier_complete(unsigned* bar, unsigned x, unsigned& nloc, unsigned& nx, unsigned& xmask) {
    const unsigned G = gridDim.x * gridDim.y * gridDim.z;
    unsigned sum, cnt, mine, msk, sp = 0u;
    for (;;) {
        sum = 0u; cnt = 0u; mine = 0u; msk = 0u;
#pragma nounroll
        for (unsigned j = 0; j < 16; ++j) { const unsigned c = xb_ld(&bar[XB_XCNT(j)]); sum += c; cnt += (c > 0u) ? 1u : 0u; msk |= (c > 0u) ? (1u << j) : 0u; mine = (j == x) ? c : mine; }
        if (sum == G) break;
        __builtin_amdgcn_s_sleep(1);
        if ((++sp & 255u) == 0u) { if (xb_ld(&bar[XB_TMO])) break; if (sp > XB_SPIN_CAP) { atomicAdd(&bar[XB_TMO], 1u); break; } }
    }
    nloc = mine > 0u ? mine : 1u; nx = cnt > 0u ? cnt : 1u; xmask = msk;
}

__device__ __forceinline__ void xcd_barrier(const XcdBarrier& b) {
    asm volatile("s_waitcnt vmcnt(0)" ::: "memory");
    __syncthreads();
    if (threadIdx.x == 64) { asm volatile("buffer_inv sc1" ::: "memory"); asm volatile("s_waitcnt vmcnt(0)" ::: "memory"); }
    if (threadIdx.x == 0) {
        unsigned* bar = b.bar;
        __builtin_amdgcn_s_waitcnt(0);
        unsigned nloc = b.st[0], nx = b.st[1];
        if (nloc == 0u) { unsigned xm; xcd_barrier_complete(bar, b.x, nloc, nx, xm); b.st[0] = nloc; b.st[1] = nx; b.st[2] = xm; }
        const unsigned old = xb_add(&bar[XB_XSUB(b.x)], 1u);
        const unsigned gen = old / nloc;
        if (old + 1u == (gen + 1u) * nloc) {
            __builtin_amdgcn_fence(__ATOMIC_RELEASE, "agent");
            asm volatile("s_waitcnt vmcnt(0)" ::: "memory");
            const unsigned og = xb_add(&bar[XB_TOP], 1u);
            const unsigned tg = og / nx;
            if (og + 1u == (tg + 1u) * nx) {
                const unsigned xm = b.st[2];
#pragma nounroll
                for (unsigned j = 0; j < 16; ++j) if ((xm >> j) & 1u) xb_add(&bar[XB_XGEN(j)], 1u);
            } else XB_SPIN(xb_ld(&bar[XB_XGEN(b.x)]) == gen, bar);
            asm volatile("s_waitcnt vmcnt(0)" ::: "memory");
        } else {
            XB_SPIN(xb_ld(&bar[XB_XGEN(b.x)]) == gen, bar);
            asm volatile("s_waitcnt vmcnt(0)" ::: "memory");
            asm volatile("s_waitcnt vmcnt(0)" ::: "memory");
        }
    }
    __syncthreads();
}

__device__ __forceinline__ float wave_sum(float v) {
#pragma unroll
    for (int o = 1; o < 64; o <<= 1) v += __shfl_xor(v, o);
    return v;
}
__device__ __forceinline__ float wave_max(float v) {
#pragma unroll
    for (int o = 1; o < 64; o <<= 1) v = fmaxf(v, __shfl_xor(v, o));
    return v;
}
__device__ __forceinline__ float ret_log2g(int h) { return log2f(1.0f - exp2f(-5.0f - (float)h)); }

__device__ __forceinline__ int win_dst(int c) {
    const int g = c >> 9, w = c & 511, hd = w >> 7, i = w & 127;
    const int base = (g == 0) ? C_RQ : (g == 1) ? C_RK : (g == 2) ? C_RV : (g == 3) ? C_RZ : (g == 4) ? C_MQ : (g == 5) ? C_MK : (g == 6) ? C_MV : C_MZ;
    const int pos = (g <= 1) ? ((i < 64) ? 2 * i : 2 * (i - 64) + 1) : i;
    return base + hd * 128 + pos;
}
template <int MODE>
__device__ __forceinline__ void p0_transpose_item(const float* W, int K, int N, bf16* WT, const float* gk, LAS float* scr, int item, int lane) {
    const int nblk = N / 32, kb = item / nblk, nb = item % nblk, k0 = 64 * kb, n0 = 32 * nb;
    float wv[32];
#pragma unroll
    for (int i = 0; i < 32; ++i) { const int kk = 2 * i + (lane >> 5); wv[i] = __builtin_nontemporal_load(W + (size_t)(k0 + kk) * N + n0 + (lane & 31)); }
#pragma unroll
    for (int i = 0; i < 32; ++i) { const int kk = 2 * i + (lane >> 5); float v = wv[i]; if (MODE == 1) v *= gk[k0 + kk]; scr[kk * 33 + (lane & 31)] = v; }
    LDS_WAIT(); asm volatile("" ::: "memory");
    const int c = lane & 7;
#pragma unroll
    for (int j = 0; j < 4; ++j) { const int n = (lane >> 3) + 8 * j; const LAS float* s = scr + (8 * c) * 33 + n;
        v4u o; o.x = pk2(s[0 * 33], s[1 * 33]); o.y = pk2(s[2 * 33], s[3 * 33]); o.z = pk2(s[4 * 33], s[5 * 33]); o.w = pk2(s[6 * 33], s[7 * 33]);
        const int dst = (MODE == 1) ? win_dst(n0 + n) : (n0 + n);
        *(v4u*)(WT + (size_t)dst * K + k0 + 8 * c) = o; }
    LDS_WAIT(); asm volatile("" ::: "memory");
}
__device__ __forceinline__ void cvt_f32_bf16(const float* src, bf16* dst, long n8, long gtid, long gthreads) {
    long i = gtid;
    for (; i + 3 * gthreads < n8; i += 4 * gthreads) {
        f32x4 a[4], b[4];
#pragma unroll
        for (int k = 0; k < 4; ++k) { a[k] = __builtin_nontemporal_load((const f32x4*)(src + (i + k * gthreads) * 8)); b[k] = __builtin_nontemporal_load((const f32x4*)(src + (i + k * gthreads) * 8 + 4)); }
#pragma unroll
        for (int k = 0; k < 4; ++k) { v4u w; w.x = pk2(a[k][0], a[k][1]); w.y = pk2(a[k][2], a[k][3]); w.z = pk2(b[k][0], b[k][1]); w.w = pk2(b[k][2], b[k][3]); *(v4u*)(dst + (i + k * gthreads) * 8) = w; }
    }
    for (; i < n8; i += gthreads) {
        const f32x4 a = *(const f32x4*)(src + i * 8), b = *(const f32x4*)(src + i * 8 + 4);
        v4u w; w.x = pk2(a[0], a[1]); w.y = pk2(a[2], a[3]); w.z = pk2(b[0], b[1]); w.w = pk2(b[2], b[3]);
        *(v4u*)(dst + i * 8) = w; }
}
__device__ __forceinline__ void sincos_d(double a, double& s, double& c) {
    const double k = rint(a * 0.63661977236758134308);
    double r = fma(-k, 1.57079632679489655800e+00, a); r = fma(-k, 6.12323399573676603587e-17, r);
    const double r2 = r * r;
    double sp = 1.0 / 6227020800.0; sp = fma(sp, r2, -1.0 / 39916800.0); sp = fma(sp, r2, 1.0 / 362880.0); sp = fma(sp, r2, -1.0 / 5040.0); sp = fma(sp, r2, 1.0 / 120.0); sp = fma(sp, r2, -1.0 / 6.0); sp = fma(sp * r2, r, r);
    double cp = 1.0 / 87178291200.0; cp = fma(cp, r2, -1.0 / 479001600.0); cp = fma(cp, r2, 1.0 / 3628800.0); cp = fma(cp, r2, -1.0 / 40320.0); cp = fma(cp, r2, 1.0 / 720.0); cp = fma(cp, r2, -1.0 / 24.0); cp = fma(cp, r2, 0.5); cp = fma(-cp, r2, 1.0);
    const int q = ((int)k) & 3;
    s = (q == 0) ? sp : (q == 1) ? cp : (q == 2) ? -sp : -cp;
    c = (q == 0) ? cp : (q == 1) ? -sp : (q == 2) ? -cp : sp;
}
__device__ __forceinline__ int t5_bucket(int n) {
    if (n < 16) return n;
    const float v = logf((float)n * (1.0f / 16.0f)) / 4.852030263919617f * 16.0f;
    int b = 16 + (int)v; return b > 31 ? 31 : b;
}

struct Args {
    const float* x; const float* p; const float* norm_g; const float* w_in; const float* ret_norm_g; const float* q_norm_g; const float* k_norm_g; const float* rel_bias;
    const float* w_out; const float* w_ple; const float* ple_norm_g; const float* w_ple_gate; float* out; unsigned char* ws;
};
typedef const __attribute__((address_space(4))) Args* KA;
__device__ __forceinline__ KA get_ka() { KA p = (KA)__builtin_amdgcn_kernarg_segment_ptr(); asm volatile("" : "+s"(p)); return p; }
#define PHASE_IDS() int tid = threadIdx.x; asm volatile("" : "+v"(tid)); const int lane = tid & 63; const int wave = __builtin_amdgcn_readfirstlane(tid >> 6); \
    int bx_ = blockIdx.x; asm volatile("" : "+s"(bx_)); const int G = gridDim.x; const int vcu = (G % 8 == 0) ? (bx_ % 8) * (G / 8) + bx_ / 8 : bx_; (void)lane; (void)wave; (void)vcu

__device__ __forceinline__ void p0_prologue(KA A, LAS unsigned char* lds) {
    PHASE_IDS();
    unsigned char* ws = A->ws;
    LAS float* scr = (LAS float*)(lds + RING_OFF + wave * 16384);
    const int gw = vcu * NWAVES + wave, NGW = G * NWAVES;
    constexpr int I_IN = (DM / 64) * (INW / 32), I_O = (DM / 64) * (DM / 32), I_G = I_O, I_P = (PLE / 64) * (DM / 32), I_L = I_IN + I_O + I_G + I_P;
    for (int it = gw; it < DEPTH * I_L; it += NGW) {
        const int L = it / I_L; int r = it % I_L;
        if (r < I_IN) { p0_transpose_item<1>(A->w_in + (size_t)L * DM * INW, DM, INW, (bf16*)(ws + WS_WIN) + (size_t)L * INW * DM, A->norm_g + L * DM, scr, r, lane); continue; } r -= I_IN;
        if (r < I_O) { p0_transpose_item<0>(A->w_out + (size_t)L * DM * DM, DM, DM, (bf16*)(ws + WS_WOUT) + (size_t)L * DM * DM, nullptr, scr, r, lane); continue; } r -= I_O;
        if (r < I_G) { p0_transpose_item<0>(A->w_ple_gate + (size_t)L * DM * DM, DM, DM, (bf16*)(ws + WS_WG) + (size_t)L * DM * DM, nullptr, scr, r, lane); continue; } r -= I_G;
        p0_transpose_item<0>(A->w_ple + (size_t)L * PLE * DM, PLE, DM, (bf16*)(ws + WS_WPLE) + (size_t)L * DM * PLE, nullptr, scr, r, lane);
    }
#if defined(P0_STAMPS)
    PSTAMP();
#endif
    for (int m0 = gw * 4; m0 < M; m0 += NGW * 4) {
        f32x4 v[4][4]; float ss[4];
#pragma unroll
        for (int r = 0; r < 4; ++r) { const f32x4* xr = (const f32x4*)(A->x + (size_t)(m0 + r) * DM) + lane;
#pragma unroll
            for (int j = 0; j < 4; ++j) v[r][j] = __builtin_nontemporal_load(xr + 64 * j); }
#pragma unroll
        for (int r = 0; r < 4; ++r) { float t = 0.f;
#pragma unroll
            for (int j = 0; j < 4; ++j) t += (v[r][j][0] * v[r][j][0] + v[r][j][1] * v[r][j][1]) + (v[r][j][2] * v[r][j][2] + v[r][j][3] * v[r][j][3]);
            ss[r] = wave_sum(t); }
#pragma unroll
        for (int r = 0; r < 4; ++r) { v2u* o8 = (v2u*)((bf16*)(ws + WS_XB) + (size_t)(m0 + r) * DM) + lane;
#pragma unroll
            for (int j = 0; j < 4; ++j) { v2u w; w.x = pk2(v[r][j][0], v[r][j][1]); w.y = pk2(v[r][j][2], v[r][j][3]); o8[64 * j] = w; }
            if (lane < 16) ((float*)(ws + WS_RSX))[(size_t)(m0 + r) * 16 + lane] = (lane == 0) ? ss[r] : 0.f; }
    }
#if defined(P0_STAMPS)
    PSTAMP();
#endif
    const long gtid = (long)vcu * (NWAVES * 64) + tid, gthreads = (long)G * NWAVES * 64;
    cvt_f32_bf16(A->p, (bf16*)(ws + WS_PE), (long)M * PLE / 8, gtid, gthreads);
#if defined(P0_STAMPS)
    PSTAMP();
#endif
    for (long i = gtid; i < (long)SEQ * 64; i += gthreads) {
        const int pos = (int)(i >> 6), fi = (int)(i & 63);
        const float inv = (float)exp2(-(double)fi * (1.0 / 64.0) * 13.287712379549449);
        const float ang = (float)pos * inv;
        double s, c; sincos_d((double)ang, s, c);
        ((f32x2v*)(ws + WS_TAB))[i] = (f32x2v){(float)c, (float)s};
    }
    for (long i = gtid; i < (long)NH * SEQ; i += gthreads) {
        const int h = (int)(i >> 13), n = (int)(i & 8191);
        ((float*)(ws + WS_LUT))[i] = A->rel_bias[t5_bucket(n) * NH + h];
    }
#if defined(P0_STAMPS)
    PSTAMP();
#endif
}

template <bool DYN>
__device__ __forceinline__ void p3_scan(KA A, int L, volatile LAS unsigned* bc  ) {
    PHASE_IDS();
    unsigned* ST = (unsigned*)(A->ws + WS_KV);
    unsigned* ctr = (unsigned*)(A->ws + WS_CTL) + CW_SCAN + L * 32;
    for (int item = vcu; ; item += G) {
        if constexpr (DYN) {
            __syncthreads();
            if (tid == 0) *bc = __hip_atomic_fetch_add(ctr, 1u, __ATOMIC_RELAXED, __HIP_MEMORY_SCOPE_AGENT);
            __syncthreads();
            item = (int)*bc;
        }
        if (item >= 16 * 8192 / (NWAVES * 64)) break;
        const int idx = item * (NWAVES * 64) + tid;
        {
        const int bh = idx >> 13, pr = idx & 8191, h = bh & 3;
        const float lg2 = ret_log2g(h), g1 = exp2f(lg2), g127 = exp2f(127.f * lg2), g128 = exp2f(128.f * lg2);
        unsigned* p = ST + (size_t)bh * NCH * 8192 + pr;
        float s0 = 0.f, s1 = 0.f;
        unsigned w[NCH];
#pragma unroll
        for (int c = 0; c < NCH; ++c) w[c] = p[(size_t)c * 8192];
        asm volatile("" ::: "memory");
#pragma unroll
        for (int c = 0; c < NCH; ++c) {
            p[(size_t)c * 8192] = pk2(g1 * s0, g1 * s1);
            s0 = s0 * g128 + g127 * bflo(w[c]); s1 = s1 * g128 + g127 * bfhi(w[c]);
        }
    } }
}


constexpr size_t WS_PARTML = 501 * MiB;
constexpr size_t WS_LIST = 504 * MiB;
constexpr size_t WS_CNT = 508 * MiB;
constexpr int CW_TOT = 8192;
static_assert((size_t)M * NH * 3 * 128 * 2 <= (size_t)M * DM * 4 && WS_CNT + 16 * 32 * 32 * 4 <= 512 * MiB, "MoBA workspace");

namespace mb {
using bf16x8 = __attribute__((ext_vector_type(8))) short;
using s16x4  = __attribute__((ext_vector_type(4))) short;
using f32x16 = __attribute__((ext_vector_type(16))) float;
using u32x4  = __attribute__((ext_vector_type(4))) unsigned;
constexpr int KVBLK = 64, QBLK = 32;
constexpr int SHM_V = KVBLK * 128 * 2, SHM_K = KVBLK * 128 * 2;
#define MB_KSWZ(row, colB) ((row) * 256 + ((colB) ^ (((row) & 7) << 4)))
#define MB_SBAR() __builtin_amdgcn_sched_barrier(0)
__device__ __forceinline__ int crow(int r, int hi) { return (r & 3) + 8 * (r >> 2) + 4 * hi; }
__device__ __forceinline__ unsigned cvtpk(float lo, float hi) { unsigned r; asm volatile("v_cvt_pk_bf16_f32 %0, %1, %2" : "=v"(r) : "v"(lo), "v"(hi)); return r; }
constexpr float LOG2E = 1.4426950408889634f;
#if defined(EXP_THR)
constexpr float THR = EXP_THR;
#else
constexpr float THR = 4.f;
#endif

__device__ __forceinline__ void partialSM(f32x16& p0, f32x16& p1, float& m_reg, float& mn, float& alpha) {
  float pmax = p0[0];
#pragma unroll
  for (int r = 1; r < 16; ++r) pmax = fmaxf(pmax, p0[r]);
#pragma unroll
  for (int r = 0; r < 16; ++r) pmax = fmaxf(pmax, p1[r]);
  { auto rr = __builtin_amdgcn_permlane32_swap(__float_as_uint(pmax), __float_as_uint(pmax), false, false);
    pmax = fmaxf(__uint_as_float(rr[0]), __uint_as_float(rr[1])); }
  if (__builtin_expect(__all(pmax - m_reg <= THR), 1)) { mn = m_reg; alpha = 1.f; }
  else { mn = fmaxf(m_reg, pmax); alpha = __builtin_amdgcn_exp2f((m_reg - mn) * LOG2E); m_reg = mn; }
  const float mnC = -mn * LOG2E;
#pragma unroll
  for (int r = 0; r < 16; ++r) p0[r] = fmaf(p0[r], LOG2E, mnC);
#pragma unroll
  for (int r = 0; r < 16; ++r) p1[r] = fmaf(p1[r], LOG2E, mnC);
#pragma unroll
  for (int r = 0; r < 16; ++r) p0[r] = __builtin_amdgcn_exp2f(p0[r]);
}
__device__ __forceinline__ void finishSM(f32x16& p0, f32x16& p1, float alpha, float& l_reg, bf16x8& pa0, bf16x8& pa1, bf16x8& pa2, bf16x8& pa3) {
#pragma unroll
  for (int r = 0; r < 16; ++r) p1[r] = __builtin_amdgcn_exp2f(p1[r]);
  float ps = 0;
#pragma unroll
  for (int r = 0; r < 16; ++r) ps += p0[r];
#pragma unroll
  for (int r = 0; r < 16; ++r) ps += p1[r];
  { auto rr = __builtin_amdgcn_permlane32_swap(__float_as_uint(ps), __float_as_uint(ps), false, false);
    ps = __uint_as_float(rr[0]) + __uint_as_float(rr[1]); }
  l_reg = l_reg * alpha + ps;
#define MB_PK4(P, BASE, OUT) do { unsigned a0 = cvtpk(P[BASE + 0], P[BASE + 1]), a1 = cvtpk(P[BASE + 2], P[BASE + 3]);   \
    unsigned b0 = cvtpk(P[BASE + 4], P[BASE + 5]), b1 = cvtpk(P[BASE + 6], P[BASE + 7]);                              \
    auto r0 = __builtin_amdgcn_permlane32_swap(a0, b0, false, false); auto r1 = __builtin_amdgcn_permlane32_swap(a1, b1, false, false); \
    u32x4 w = {r0[0], r1[0], r0[1], r1[1]}; OUT = *reinterpret_cast<bf16x8*>(&w); } while (0)
  MB_PK4(p0, 0, pa0); MB_PK4(p0, 8, pa1); MB_PK4(p1, 0, pa2); MB_PK4(p1, 8, pa3);
#undef MB_PK4
}
__device__ __forceinline__ int v_st(int k, int c) { const int kk = (k & ~0xC) | ((k & 4) << 1) | ((k & 8) >> 1); return ((kk >> 3) * 4 + (c >> 5)) * 512 + ((kk & 7) * 32 + (c & 31)) * 2; }
__device__ __forceinline__ int v_rd_base(int lane) { return ((lane & 3) << 3) | (((lane >> 2) & 3) << 6) | (((lane >> 4) & 1) << 5) | (((lane >> 5) & 1) << 8); }
constexpr int v_rd_off(int d0, int ks, int half) { return d0 * 512 + ks * 4096 + half * 2048; }
}


namespace mb2 {
using mb::bf16x8; using mb::s16x4; using mb::f32x16; using mb::u32x4; using mb::crow; using mb::cvtpk; using mb::v_st; using mb::v_rd_base; using mb::v_rd_off; using mb::LOG2E; using mb::THR;
constexpr int L_K = 0, L_V = 65536, L_STG = 131072  , L_LUT = 147456  , L_WSC = 153856  , WSC_F = 192  , L_TAB = 160000  , L_END = 161024;
static_assert(L_END <= LDSCTL_OFF, "MoBA LDS map");
constexpr int LUT_N = 1600, DQ_CLAMP = LUT_N - 1;

typedef __attribute__((address_space(3))) const char* lds_cptr;
typedef short v4i16_t __attribute__((ext_vector_type(4)));
__device__ __forceinline__ s16x4 vtr(lds_cptr p) { return __builtin_bit_cast(s16x4, __builtin_amdgcn_ds_read_tr16_b64_v4i16((__attribute__((address_space(3))) v4i16_t*)p)); }

template <int IMAX>
__device__ __forceinline__ void qkt(f32x16& p0, f32x16& p1, const char* Ks, const bf16x8* qr, int r32, int hi, int dq, const float* lut) {
  const float* lb = lut + ((dq > IMAX ? IMAX : dq) - 63) - 4 * hi;
#pragma unroll
  for (int r = 0; r < 16; ++r) { p0[r] = lb[63 - crow(r, 0)]; p1[r] = lb[31 - crow(r, 0)]; }
#pragma unroll
  for (int d0 = 0; d0 < 8; ++d0) { const int cb = (d0 * 16 + hi * 8) * 2;
    const bf16x8 b0 = *reinterpret_cast<const bf16x8*>(Ks + MB_KSWZ(r32, cb));
    const bf16x8 b1 = *reinterpret_cast<const bf16x8*>(Ks + MB_KSWZ(32 + r32, cb));
    p0 = __builtin_amdgcn_mfma_f32_32x32x16_bf16(b0, qr[d0], p0, 0, 0, 0);
    p1 = __builtin_amdgcn_mfma_f32_32x32x16_bf16(b1, qr[d0], p1, 0, 0, 0); }
}
__device__ __forceinline__ void pv(f32x16* o, lds_cptr vb, bf16x8 pa0, bf16x8 pa1, bf16x8 pa2, bf16x8 pa3) {
  s16x4 l[2][4], h[2][4];
#pragma unroll
  for (int ks = 0; ks < 4; ++ks) { l[0][ks] = vtr(vb + v_rd_off(0, ks, 0)); h[0][ks] = vtr(vb + v_rd_off(0, ks, 1)); }
#pragma unroll
  for (int d0 = 0; d0 < 4; ++d0) { const int c = d0 & 1, n = c ^ 1;
    if (d0 < 3) {
#pragma unroll
      for (int ks = 0; ks < 4; ++ks) { l[n][ks] = vtr(vb + v_rd_off(d0 + 1, ks, 0)); h[n][ks] = vtr(vb + v_rd_off(d0 + 1, ks, 1)); } }
#define MB2_PK(k) (bf16x8){l[c][k][0], l[c][k][1], l[c][k][2], l[c][k][3], h[c][k][0], h[c][k][1], h[c][k][2], h[c][k][3]}
    o[d0] = __builtin_amdgcn_mfma_f32_32x32x16_bf16(pa0, MB2_PK(0), o[d0], 0, 0, 0);
    o[d0] = __builtin_amdgcn_mfma_f32_32x32x16_bf16(pa1, MB2_PK(1), o[d0], 0, 0, 0);
    o[d0] = __builtin_amdgcn_mfma_f32_32x32x16_bf16(pa2, MB2_PK(2), o[d0], 0, 0, 0);
    o[d0] = __builtin_amdgcn_mfma_f32_32x32x16_bf16(pa3, MB2_PK(3), o[d0], 0, 0, 0);
#undef MB2_PK
  }
}
template <bool OWN, int QRS  >
__device__ __forceinline__ void attend_wave(const bf16* __restrict__ Qseq, int qp, int kpos0, int nt, char* lds, float* wsf, f32x16 (&o)[4], float& m_out, float& l_out, int lane) {
  const int r32 = lane & 31, hi = lane >> 5;
  const char* K_lds = lds + L_K; const lds_cptr vb0 = (lds_cptr)lds + L_V + v_rd_base(lane);
  float* al_l = wsf + 32; const float* lut = (const float*)(lds + L_LUT);
  float m_reg = -1e30f, l_reg = 0; bf16x8 qr[8];
  const bf16* Qw = Qseq + (size_t)qp * QRS + hi * 8;
#pragma unroll
  for (int d0 = 0; d0 < 8; ++d0) qr[d0] = *reinterpret_cast<const bf16x8*>(Qw + d0 * 16);
#pragma unroll
  for (int d = 0; d < 4; ++d) o[d] = f32x16{};
  const int dq0 = qp - kpos0 + (OWN ? 256 : 0); constexpr int IMAX = OWN ? 511 : DQ_CLAMP;
#define MB2_RESC(a) do { if (__any((a) < 1.f)) { if (hi == 0) al_l[r32] = (a); asm volatile("s_waitcnt lgkmcnt(0)" ::: "memory"); \
    _Pragma("unroll") for (int d = 0; d < 4; ++d) _Pragma("unroll") for (int r = 0; r < 16; ++r) o[d][r] *= al_l[crow(r, hi)]; } } while (0)
#pragma nounroll
  for (int t = 0; t < nt; ++t) {
    f32x16 p0, p1; float mn, al; bf16x8 pa0, pa1, pa2, pa3;
    qkt<IMAX>(p0, p1, K_lds + t * 16384, qr, r32, hi, dq0 - 64 * t, lut);
    mb::partialSM(p0, p1, m_reg, mn, al);
    MB2_RESC(al);
    mb::finishSM(p0, p1, al, l_reg, pa0, pa1, pa2, pa3);
    pv(o, vb0 + t * 16384, pa0, pa1, pa2, pa3);
  }
  m_out = m_reg; l_out = l_reg;
#undef MB2_RESC
}
template <int QRS = INW  >
__device__ __forceinline__ void load_q(bf16x8 (&qr)[8], const bf16* __restrict__ Qseq, int qp, int hi) {
  const bf16* Qw = Qseq + (size_t)qp * QRS + hi * 8;
#pragma unroll
  for (int d0 = 0; d0 < 8; ++d0) qr[d0] = *reinterpret_cast<const bf16x8*>(Qw + d0 * 16);
}
template <bool OWN>
__device__ __forceinline__ void attend_wave4(const bf16x8 (&qr)[8], int qp, int kpos0, char* lds, float* wsf, f32x16 (&o)[4], float& m_out, float& l_out, int lane) {
  const int r32 = lane & 31, hi = lane >> 5;
  const char* K_lds = lds + L_K; const lds_cptr vb0 = (lds_cptr)lds + L_V + v_rd_base(lane);
  float* al_l = wsf + 32; const float* lut = (const float*)(lds + L_LUT);
  float m_reg = -1e30f, l_reg = 0;
#pragma unroll
  for (int d = 0; d < 4; ++d) o[d] = f32x16{};
  const int dq0 = qp - kpos0 + (OWN ? 256 : 0); constexpr int IMAX = OWN ? 511 : DQ_CLAMP;
#define MB2_RESC(a) do { if (__any((a) < 1.f)) { if (hi == 0) al_l[r32] = (a); asm volatile("s_waitcnt lgkmcnt(0)" ::: "memory"); \
    _Pragma("unroll") for (int d = 0; d < 4; ++d) _Pragma("unroll") for (int r = 0; r < 16; ++r) o[d][r] *= al_l[crow(r, hi)]; } } while (0)
  f32x16 pA0, pA1, pB0, pB1; float mnA, mnB, alA, alB; bf16x8 pa0, pa1, pa2, pa3;
  qkt<IMAX>(pA0, pA1, K_lds, qr, r32, hi, dq0, lut); mb::partialSM(pA0, pA1, m_reg, mnA, alA);
  MB_SBAR(); qkt<IMAX>(pB0, pB1, K_lds + 16384, qr, r32, hi, dq0 - 64, lut);
  mb::finishSM(pA0, pA1, alA, l_reg, pa0, pa1, pa2, pa3); MB_SBAR();
  pv(o, vb0, pa0, pa1, pa2, pa3); mb::partialSM(pB0, pB1, m_reg, mnB, alB); MB_SBAR(); MB2_RESC(alB);
  MB_SBAR(); qkt<IMAX>(pA0, pA1, K_lds + 2 * 16384, qr, r32, hi, dq0 - 128, lut);
  mb::finishSM(pB0, pB1, alB, l_reg, pa0, pa1, pa2, pa3); MB_SBAR();
  pv(o, vb0 + 16384, pa0, pa1, pa2, pa3); mb::partialSM(pA0, pA1, m_reg, mnA, alA); MB_SBAR(); MB2_RESC(alA);
  MB_SBAR(); qkt<IMAX>(pB0, pB1, K_lds + 3 * 16384, qr, r32, hi, dq0 - 192, lut);
  mb::finishSM(pA0, pA1, alA, l_reg, pa0, pa1, pa2, pa3); MB_SBAR();
  pv(o, vb0 + 2 * 16384, pa0, pa1, pa2, pa3); mb::partialSM(pB0, pB1, m_reg, mnB, alB); MB_SBAR(); MB2_RESC(alB);
  mb::finishSM(pB0, pB1, alB, l_reg, pa0, pa1, pa2, pa3); MB_SBAR();
  pv(o, vb0 + 3 * 16384, pa0, pa1, pa2, pa3);
  m_out = m_reg; l_out = l_reg;
#undef MB2_RESC
}
struct BlockHalf { v4u kk[4], vv[4]; };
template <bool HM  >
__device__ __forceinline__ void block_issue(BlockHalf& B, int half, const bf16* __restrict__ Kh, const bf16* __restrict__ Vh, int tid) {
  constexpr int RS = HM ? 128 : INW;
#pragma unroll
  for (int i = 0; i < 4; ++i) { const int ch = tid + (half * 4 + i) * 512, row = ch >> 4, c16 = ch & 15; B.kk[i] = *(const v4u*)(Kh + (size_t)row * RS + c16 * 8); B.vv[i] = *(const v4u*)(Vh + (size_t)row * RS + c16 * 8); }
}
__device__ __forceinline__ void block_store(const BlockHalf& B, int half, char* lds, int tid) {
#pragma unroll
  for (int i = 0; i < 4; ++i) { const int ch = tid + (half * 4 + i) * 512, row = ch >> 4, c16 = ch & 15;
    *(v4u*)(lds + L_K + (row >> 6) * 16384 + MB_KSWZ(row & 63, c16 * 16)) = B.kk[i];
    *(v4u*)(lds + L_V + (row >> 6) * 16384 + v_st(row & 63, c16 * 8)) = B.vv[i]; }
}
template <bool HM>
__device__ __forceinline__ void load_block(const bf16* __restrict__ Kh, const bf16* __restrict__ Vh, char* lds, int tid) {
  BlockHalf A, B; block_issue<HM>(A, 0, Kh, Vh, tid); block_issue<HM>(B, 1, Kh, Vh, tid); block_store(A, 0, lds, tid); block_store(B, 1, lds, tid);
}
template <class F>
__device__ __forceinline__ void emit_rows(const f32x16 (&o)[4], const float* rowscale, char* stg, int lane, F f) {
  const int r32 = lane & 31, hi = lane >> 5;
#pragma unroll
  for (int g = 0; g < 4; ++g) {
#pragma unroll
    for (int rr = 0; rr < 4; ++rr) { const int r = 4 * g + rr; const int row = 4 * hi + rr; const float s = rowscale[8 * g + row];
#pragma unroll
      for (int d0 = 0; d0 < 4; ++d0) *(unsigned short*)(stg + row * 256 + (d0 * 32 + r32) * 2) = (unsigned short)(cvtpk(o[d0][r] * s, 0.f) & 0xffffu); }
    asm volatile("s_waitcnt lgkmcnt(0)" ::: "memory");
#pragma unroll
    for (int c = 0; c < 2; ++c) { const int row = lane >> 3, ch = (lane & 7) + 8 * c; const v4u val = *(const v4u*)(stg + row * 256 + ch * 16); f(g, row, ch, val); }
    asm volatile("s_waitcnt lgkmcnt(0)" ::: "memory");
  }
}
template <bool HM> __device__ __forceinline__ const bf16* kv_block(const unsigned char* ws, int b, int blk, int h, int kv) {
  if constexpr (HM) return (const bf16*)(ws + WS_EPRE) + ((size_t)(b * 32 + blk) * 8 + kv * 4 + h) * 32768;
  else return (const bf16*)(ws + WS_PROJ) + ((size_t)b * SEQ + blk * 256) * INW + (kv ? C_MV : C_MK) + h * HD;
}
template <bool HM> __device__ __forceinline__ const bf16* q_rows(const unsigned char* ws, const float* out, int b, int h) {
  if constexpr (HM) return (const bf16*)((const unsigned char*)out + 96 * MiB) + (size_t)(b * 4 + h) * SEQ * 128;
  else return (const bf16*)(ws + WS_PROJ) + (size_t)b * SEQ * INW + C_MQ + h * HD;
}
}

template <bool HM>
__device__ __forceinline__ void p3_moba_sel2(KA A, int L, unsigned char* ldsu) {
    PHASE_IDS();
    char* lds = (char*)ldsu;
    unsigned char* ws = A->ws; const bf16* PROJ = (const bf16*)(ws + WS_PROJ); const unsigned* SEL = (const unsigned*)(ws + WS_SEL);
    const unsigned char* LIST = ws + WS_LIST; const unsigned* CNT = (const unsigned*)(ws + WS_CNT); unsigned* TOT = (unsigned*)(ws + WS_CTL) + CW_TOT + L * 512;
    bf16* PARTO = (bf16*)A->out; float* PARTML = (float*)(ws + WS_PARTML);
    constexpr int LOADEQ = 12;
    unsigned short* tab = (unsigned short*)(lds + mb2::L_TAB);
    volatile LAS unsigned* ctr = (volatile LAS unsigned*)((LAS unsigned char*)ldsu + MISC_OFF) + 16;
    if (wave == 0) {
        int c[8]; int s = 0;
#pragma unroll
        for (int k = 0; k < 8; ++k) { const int e = lane * 8 + k; int n = 0; if (e < 496) { const int bh = e / 31, j = e % 31; n = (int)((__hip_atomic_load(&TOT[bh * 32 + j], __ATOMIC_RELAXED, __HIP_MEMORY_SCOPE_AGENT) + 31u) >> 5); if (n > 0) n += LOADEQ; } c[k] = s; s += n; }
        int incl = s;
#pragma unroll
        for (int o = 1; o < 64; o <<= 1) { const int v = __shfl_up(incl, o); if (lane >= o) incl += v; }
        const int excl = incl - s;
#pragma unroll
        for (int k = 0; k < 8; ++k) { const int e = lane * 8 + k; if (e <= 496) tab[e] = (unsigned short)(excl + c[k]); }
    }
    __syncthreads();
    const int WT = tab[496]; PSTAMP();     bool first_ = true;
    const int w_lo = (int)(((long)vcu * WT) / G), w_hi = (int)(((long)(vcu + 1) * WT) / G);
    int cpos = w_lo, cur_h = -1;
    int e_pf = -1, ncnt_pf = 0;
    while (cpos < w_hi) {
        int lo = 0, hi_ = 495;
        while (lo < hi_) { const int mid = (lo + hi_ + 1) >> 1; if ((int)tab[mid] <= cpos) lo = mid; else hi_ = mid - 1; }
        const int e = lo, bh = e / 31, j = e % 31, b = bh >> 2, h = bh & 3, T_e = tab[e], T_n = tab[e + 1];
        const int n_e = T_n - T_e - LOADEQ;
        int cur = cpos - T_e - LOADEQ; if (cur < 0) cur = 0;
        int p_hi = w_hi - T_e - LOADEQ; if (p_hi > n_e) p_hi = n_e;
        cpos = T_n;
        if (p_hi <= cur) continue;
        constexpr int t0 = 0;
        int tid_p = threadIdx.x; asm volatile("" : "+v"(tid_p));
        const bf16* Kh = mb2::kv_block<HM>(ws, b, j, h, 0); const bf16* Vh = mb2::kv_block<HM>(ws, b, j, h, 1);
        int ncnt = 0;
        if (e_pf == e) ncnt = ncnt_pf; else if (lane > j && lane < 32) ncnt = (int)CNT[(size_t)(bh * 32 + j) * 32 + lane];
        if (T_n < w_hi && e + 1 < 496) { const int bh_n = (e + 1) / 31, j_n = (e + 1) % 31; e_pf = e + 1; ncnt_pf = 0; if (lane > j_n && lane < 32) ncnt_pf = (int)CNT[(size_t)(bh_n * 32 + j_n) * 32 + lane]; }
        mb2::BlockHalf BA, BB; mb2::block_issue<HM>(BA, 0, Kh, Vh, tid_p); mb2::block_issue<HM>(BB, 1, Kh, Vh, tid_p);
        int segE, segT;
        { int incl = ncnt;
#pragma unroll
          for (int o = 1; o < 32; o <<= 1) { const int v = __shfl_up(incl, o); if (lane >= o) incl += v; }
          segE = incl - ncnt; segT = __shfl(incl, 31); }
        const bf16* Qseq = mb2::q_rows<HM>(ws, A->out, b, h); constexpr int QRS = HM ? 128 : INW;
        float* wsf = (float*)(lds + mb2::L_WSC) + wave * mb2::WSC_F; char* stg = lds + mb2::L_STG + wave * 2048;
        const unsigned char* LISTp = LIST + (size_t)(bh * 32 + j) * 32 * 256;
        auto meta = [&](int u, int& qbo, unsigned& raw, bool& valid) {
            const int s = (u - t0) * 32 + (lane & 31); valid = s < segT;
            int qb = j + 1;
            for (int q = j + 2; q < 32; ++q) { const int v = __builtin_amdgcn_readlane(segE, q); qb += (v <= s) ? 1 : 0; }
            const int idx = s - __shfl(segE, qb);
            qbo = qb; raw = 0u; if (valid) raw = LISTp[(size_t)qb * 256 + idx]; };
        int u = cur + wave;
        int pos = (j + 1) * 256, slot = 0; bool valid = false; mb::bf16x8 qr[8];
        int qb0 = j + 1; unsigned raw0 = 0u;
        if (u < p_hi) meta(u, qb0, raw0, valid);
        mb2::block_store(BA, 0, lds, tid_p);
        if (u < p_hi) { if (valid) pos = qb0 * 256 + (int)raw0;
            const unsigned msk = SEL[((size_t)b * SEQ + pos) * NH + h]; slot = __popc(msk & ((1u << j) - 1u)); mb2::load_q<QRS>(qr, Qseq, pos, lane >> 5); }
        mb2::block_store(BB, 1, lds, tid_p);
        if (cur_h != h) { cur_h = h; const float* src = (const float*)(ws + WS_LUT) + h * SEQ; float* dst = (float*)(lds + mb2::L_LUT);
#pragma unroll
            for (int i = 0; i < 4; ++i) { const int k = tid_p + i * 512; if (k < mb2::LUT_N) dst[k] = src[k]; } }
        __syncthreads();
        if (first_) PSTAMP();
        while (u < p_hi) {
            const int u2 = u + 8; const bool has2 = u2 < p_hi;
            int qb2 = j + 1; unsigned raw2 = 0u; bool valid2 = false;
            if (has2) meta(u2, qb2, raw2, valid2);
            mb::f32x16 o[4]; float m_reg, l_reg;
            mb2::attend_wave4<false>(qr, pos, j * 256, lds, wsf, o, m_reg, l_reg, lane);
            if (first_) PSTAMP();
            int lane_e = lane; asm volatile("" : "+v"(lane_e), "+v"(raw2));
            int pos2 = (j + 1) * 256; unsigned msk2 = 0u;
            if (has2) { if (valid2) pos2 = qb2 * 256 + (int)raw2; msk2 = SEL[((size_t)b * SEQ + pos2) * NH + h]; mb2::load_q<QRS>(qr, Qseq, pos2, lane_e >> 5); }
            const int r32e = lane_e & 31, hie = lane_e >> 5;
            const size_t trow = (size_t)b * SEQ + pos;
            if (hie == 0) { wsf[r32e] = 1.0f / l_reg; if (valid) { float* ml = PARTML + ((trow * NH + h) * 3 + slot) * 2; ml[0] = m_reg; ml[1] = l_reg; } }
            asm volatile("s_waitcnt lgkmcnt(0)" ::: "memory");
            const int code = valid ? (int)(pos | (slot << 16)) : -1;
            mb2::emit_rows(o, wsf, stg, lane_e, [&](int g, int row, int ch, const v4u& val) {
                const int cd = __shfl(code, 8 * g + row);
                if (cd >= 0) { const size_t tr = (size_t)b * SEQ + (cd & 0xffff); const int sl = cd >> 16;
                    *(v4u*)(PARTO + ((tr * NH + h) * 3 + sl) * 128 + ch * 8) = val; } });
            if (first_) { PSTAMP(); first_ = false; }
            pos = pos2; valid = valid2; slot = __popc(msk2 & ((1u << j) - 1u)); u = u2;
        }
        __syncthreads();
    }
    PSTAMP();
}

template <bool HM  >
__device__ __forceinline__ void p4_moba_own2(KA A, unsigned char* ldsu) {
    PHASE_IDS();
    char* lds = (char*)ldsu;
    unsigned char* ws = A->ws; bf16* PROJ = (bf16*)(ws + WS_PROJ); const unsigned* SEL = (const unsigned*)(ws + WS_SEL);
    const bf16* PARTO = (const bf16*)A->out; const float* PARTML = (const float*)(ws + WS_PARTML);
    const int qblk = (wave < 4) ? wave : 11 - wave;
    auto item = [&](int j) -> int { if constexpr (HM) { const int p_ = 16 * (bx_ & 7) + ((bx_ >> 3) & 7) + 8 * j; return ((p_ >> 5) * 4 + (bx_ >> 6)) * 32 + (p_ & 31); } else return vcu + j * G; };
    const int nit = HM ? 2 : (vcu < 16 * NBLK ? (16 * NBLK - vcu + G - 1) / G : 0);
    if (nit > 0) { const int it0 = item(0); const int bh = it0 >> 5, qb = it0 & 31, b = bh >> 2, h = bh & 3;
        mb2::load_block<HM>(mb2::kv_block<HM>(ws, b, qb, h, 0), mb2::kv_block<HM>(ws, b, qb, h, 1), lds, tid);
        const float* src = (const float*)(ws + WS_LUT) + h * SEQ; float* dst = (float*)(lds + mb2::L_LUT);
        dst[tid] = (tid < 256) ? -1e30f : src[tid - 256]; }
    __syncthreads();
    for (int j = 0; j < nit; ++j) { const int it = item(j);
        const int bh = it >> 5, qb = it & 31, b = bh >> 2, h = bh & 3;
        const bf16* Qseq = mb2::q_rows<HM>(ws, A->out, b, h);
        float* wsf = (float*)(lds + mb2::L_WSC) + wave * mb2::WSC_F; float* coef = wsf + 64; char* stg = lds + mb2::L_STG + wave * 2048;
        const int pos = qb * 256 + qblk * 32 + (lane & 31);
        unsigned msk_pf = 0u; f32x2v ml_pf[3] = {{0.f, 0.f}, {0.f, 0.f}, {0.f, 0.f}};
        if ((lane >> 5) == 0) { const size_t tr = (size_t)b * SEQ + pos; msk_pf = SEL[tr * NH + h]; const f32x2v* ml2 = (const f32x2v*)(PARTML + (tr * NH + h) * 6); ml_pf[0] = ml2[0]; ml_pf[1] = ml2[1]; ml_pf[2] = ml2[2]; }
        mb::f32x16 o[4]; float m_reg, l_reg;
        mb2::attend_wave<true, (HM ? 128 : INW)>(Qseq, pos, qb * 256, (qblk >> 1) + 1, lds, wsf, o, m_reg, l_reg, lane);
        __syncthreads();
        const bool has2 = j + 1 < nit; const int it2 = has2 ? item(j + 1) : it;
        mb2::BlockHalf BA;
        if (has2) { const int bh2 = it2 >> 5, qb2 = it2 & 31, b2 = bh2 >> 2, h2 = bh2 & 3; int tid_n = threadIdx.x; asm volatile("" : "+v"(tid_n));
            const bf16* Kh2 = mb2::kv_block<HM>(ws, b2, qb2, h2, 0); const bf16* Vh2 = mb2::kv_block<HM>(ws, b2, qb2, h2, 1);
            mb2::block_issue<HM>(BA, 0, Kh2, Vh2, tid_n); }
        int lane_e = lane; asm volatile("" : "+v"(lane_e));
        const int r32 = lane_e & 31, hi = lane_e >> 5;
        const size_t trow0 = (size_t)b * SEQ + qb * 256 + qblk * 32;
        if (hi == 0) {
            const int ns = __popc(msk_pf);
            float pm[3], pl[3]; float mx = m_reg;
#pragma unroll
            for (int i = 0; i < 3; ++i) { pm[i] = (i < ns) ? ml_pf[i][0] : -1e30f; pl[i] = (i < ns) ? ml_pf[i][1] : 0.f; mx = fmaxf(mx, pm[i]); }
            const float wo = __expf(m_reg - mx); float den = wo * l_reg; float w[3];
#pragma unroll
            for (int i = 0; i < 3; ++i) { w[i] = (i < ns) ? pl[i] * __expf(pm[i] - mx) : 0.f; den += w[i]; }
            const float inv = 1.0f / den;
            coef[r32] = wo * inv; coef[32 + r32] = w[0] * inv; coef[64 + r32] = w[1] * inv; coef[96 + r32] = w[2] * inv;
        }
        asm volatile("s_waitcnt lgkmcnt(0)" ::: "memory");
        {   struct Cell { v4u p[3]; v4u z; float cf[3]; };
            const int erow = lane_e >> 3, ech = lane_e & 7;
            auto issue = [&](int g, Cell (&C)[2]) {
#pragma unroll
                for (int c = 0; c < 2; ++c) { const int rw = 8 * g + erow, ch = ech + 8 * c; const size_t tr = trow0 + rw;
#pragma unroll
                    for (int k = 0; k < 3; ++k) { const float cf = coef[32 * (k + 1) + rw]; C[c].cf[k] = cf; C[c].p[k] = (v4u){0u, 0u, 0u, 0u};
                        if (cf != 0.f) C[c].p[k] = __builtin_nontemporal_load((const v4u*)(PARTO + ((tr * NH + h) * 3 + k) * 128 + ch * 8)); }
                    C[c].z = __builtin_nontemporal_load((const v4u*)(PROJ + tr * INW + C_MZ + h * HD + ch * 8)); } };
            auto finish = [&](int g, const Cell (&C)[2]) {
#pragma unroll
                for (int rr = 0; rr < 4; ++rr) { const int r = 4 * g + rr; const int row = 4 * hi + rr; const float sc = coef[8 * g + row];
#pragma unroll
                    for (int d0 = 0; d0 < 4; ++d0) *(unsigned short*)(stg + row * 256 + (d0 * 32 + r32) * 2) = (unsigned short)(mb::cvtpk(o[d0][r] * sc, 0.f) & 0xffffu); }
                asm volatile("s_waitcnt lgkmcnt(0)" ::: "memory");
#pragma unroll
                for (int c = 0; c < 2; ++c) { const int rw = 8 * g + erow, ch = ech + 8 * c; const size_t tr = trow0 + rw;
                    const v4u ow = *(const v4u*)(stg + erow * 256 + ch * 16);
                    float acc[8] = {bflo(ow.x), bfhi(ow.x), bflo(ow.y), bfhi(ow.y), bflo(ow.z), bfhi(ow.z), bflo(ow.w), bfhi(ow.w)};
#pragma unroll
                    for (int k = 0; k < 3; ++k) { const float cf = C[c].cf[k]; const v4u pw = C[c].p[k];
                        acc[0] += cf * bflo(pw.x); acc[1] += cf * bfhi(pw.x); acc[2] += cf * bflo(pw.y); acc[3] += cf * bfhi(pw.y); acc[4] += cf * bflo(pw.z); acc[5] += cf * bfhi(pw.z); acc[6] += cf * bflo(pw.w); acc[7] += cf * bfhi(pw.w); }
                    const v4u zw = C[c].z;
                    const float z[8] = {bflo(zw.x), bfhi(zw.x), bflo(zw.y), bfhi(zw.y), bflo(zw.z), bfhi(zw.z), bflo(zw.w), bfhi(zw.w)};
#pragma unroll
                    for (int e2 = 0; e2 < 8; ++e2) acc[e2] *= z[e2] / (1.0f + __expf(-z[e2]));
                    v4u w; w.x = pk2(acc[0], acc[1]); w.y = pk2(acc[2], acc[3]); w.z = pk2(acc[4], acc[5]); w.w = pk2(acc[6], acc[7]);
                    *(v4u*)(PROJ + tr * INW + C_MQ + h * HD + ch * 8) = w; }
                asm volatile("s_waitcnt lgkmcnt(0)" ::: "memory"); };
            Cell CA[2], CB[2];
            issue(0, CA);
            issue(1, CB); finish(0, CA);
            issue(2, CA); finish(1, CB);
            issue(3, CB); finish(2, CA);
            finish(3, CB);
        }
        if (has2) { const int bh2 = it2 >> 5, qb2 = it2 & 31, b2 = bh2 >> 2, h2 = bh2 & 3; int tid_n = threadIdx.x; asm volatile("" : "+v"(tid_n));
            const bf16* Kh2 = mb2::kv_block<HM>(ws, b2, qb2, h2, 0); const bf16* Vh2 = mb2::kv_block<HM>(ws, b2, qb2, h2, 1);
            mb2::BlockHalf BB; mb2::block_issue<HM>(BB, 1, Kh2, Vh2, tid_n); mb2::block_store(BA, 0, lds, tid_n); mb2::block_store(BB, 1, lds, tid_n); }
        __syncthreads();
    }
}

template <bool HM>
__device__ __forceinline__ void p2b_gating_mfma(KA A, int L, unsigned char* ldsu) {
    PHASE_IDS();
    char* lds = (char*)ldsu;
    unsigned char* ws = A->ws; const bf16* PROJ = (const bf16*)(ws + WS_PROJ); const float* KM = (const float*)(ws + WS_KMEAN); unsigned* SEL = (unsigned*)(ws + WS_SEL);
    unsigned char* LIST = ws + WS_LIST; unsigned* CNT = (unsigned*)(ws + WS_CNT); unsigned* TOT = (unsigned*)(ws + WS_CTL) + CW_TOT + L * 512;
    char* KH = lds; char* KL = lds + 8192; int* wc = (int*)(lds + 16384);
    const int r32 = lane & 31, hi = lane >> 5;
    int kk = 0;
    f32x4 a_n = {0.f, 0.f, 0.f, 0.f}, c_n = {0.f, 0.f, 0.f, 0.f}; mb::bf16x8 q_n[8];
    auto fetch = [&](int it2, int kk2) { const int bh2 = it2 >> 5, qb2 = (kk2 & 1) ? 31 - (it2 & 31) : (it2 & 31), b2 = bh2 >> 2, h2 = bh2 & 3; const int row = tid >> 4, c8 = (tid & 15) * 8;
        a_n = (f32x4){0.f, 0.f, 0.f, 0.f}; c_n = a_n;
        if (row < qb2) { const float* src = KM + ((size_t)bh2 * NBLK + row) * HD + c8; a_n = *(const f32x4*)src; c_n = *(const f32x4*)(src + 4); }
        mb2::load_q<(HM ? 128 : INW)>(q_n, mb2::q_rows<HM>(ws, A->out, b2, h2), qb2 * 256 + wave * 32 + (lane & 31), lane >> 5); };
    if (vcu < 16 * NBLK) fetch(vcu, 0);
    for (int it = vcu; it < 16 * NBLK; it += G, ++kk) {
        const int bh = it >> 5, qb = (kk & 1) ? 31 - (it & 31) : (it & 31), b = bh >> 2, h = bh & 3;
        { const int row = tid >> 4, c8 = (tid & 15) * 8; const f32x4 a = a_n, c = c_n;
          v4u wh, wl;
          wh.x = pk2(a[0], a[1]); wh.y = pk2(a[2], a[3]); wh.z = pk2(c[0], c[1]); wh.w = pk2(c[2], c[3]);
          wl.x = pk2(a[0] - bflo(wh.x), a[1] - bfhi(wh.x)); wl.y = pk2(a[2] - bflo(wh.y), a[3] - bfhi(wh.y)); wl.z = pk2(c[0] - bflo(wh.z), c[1] - bfhi(wh.z)); wl.w = pk2(c[2] - bflo(wh.w), c[3] - bfhi(wh.w));
          *(v4u*)(KH + MB_KSWZ(row, c8 * 2)) = wh; *(v4u*)(KL + MB_KSWZ(row, c8 * 2)) = wl; }
        const int q = wave * 32 + r32;
        const size_t t = (size_t)b * SEQ + qb * 256 + q;
        mb::bf16x8 qr[8];
#pragma unroll
        for (int d0 = 0; d0 < 8; ++d0) qr[d0] = q_n[d0];
        __syncthreads();
        mb::f32x16 p = mb::f32x16{};
#pragma unroll
        for (int d0 = 0; d0 < 8; ++d0) { const int cb = (d0 * 16 + hi * 8) * 2;
            const mb::bf16x8 ah = *reinterpret_cast<const mb::bf16x8*>(KH + MB_KSWZ(r32, cb)), al = *reinterpret_cast<const mb::bf16x8*>(KL + MB_KSWZ(r32, cb));
            p = __builtin_amdgcn_mfma_f32_32x32x16_bf16(ah, qr[d0], p, 0, 0, 0);
            p = __builtin_amdgcn_mfma_f32_32x32x16_bf16(al, qr[d0], p, 0, 0, 0); }
        if (it + G < 16 * NBLK) fetch(it + G, kk + 1);
        float v0 = -3e38f, v1 = -3e38f, v2 = -3e38f; int i0 = -1, i1 = -1, i2 = -1;
#pragma unroll
        for (int r = 0; r < 16; ++r) { const int n = mb::crow(r, hi); const float d = p[r];
            if (n < qb) {
                if (d > v0) { v2 = v1; i2 = i1; v1 = v0; i1 = i0; v0 = d; i0 = n; }
                else if (d > v1) { v2 = v1; i2 = i1; v1 = d; i1 = n; }
                else if (d > v2) { v2 = d; i2 = n; } } }
        { const float w0 = __shfl_xor(v0, 32), w1 = __shfl_xor(v1, 32), w2 = __shfl_xor(v2, 32); const int j0 = __shfl_xor(i0, 32), j1 = __shfl_xor(i1, 32), j2 = __shfl_xor(i2, 32);
          const float wv[3] = {w0, w1, w2}; const int wi[3] = {j0, j1, j2};
#pragma unroll
          for (int k = 0; k < 3; ++k) { const float d = wv[k]; const int n = wi[k];
              if (n >= 0) {
                  if (d > v0 || (d == v0 && n < i0)) { v2 = v1; i2 = i1; v1 = v0; i1 = i0; v0 = d; i0 = n; }
                  else if (d > v1 || (d == v1 && n < i1)) { v2 = v1; i2 = i1; v1 = d; i1 = n; }
                  else if (d > v2 || (d == v2 && n < i2)) { v2 = d; i2 = n; } } } }
        unsigned mask = 0u;
        if (i0 >= 0) mask |= 1u << i0; if (i1 >= 0) mask |= 1u << i1; if (i2 >= 0) mask |= 1u << i2;
        if (hi == 0) SEL[t * NH + h] = mask;
        for (int j = 0; j < qb; ++j) { const unsigned long long bal = __ballot(hi == 0 && ((mask >> j) & 1u)); if (lane == 0) wc[j * 8 + wave] = __popcll(bal); }
        __syncthreads();
        for (int j = 0; j < qb; ++j) {
            const bool f = (hi == 0) && ((mask >> j) & 1u);
            const unsigned long long bal = __ballot(f);
            int off = __popcll(bal & ((1ull << lane) - 1ull));
            int tot = 0;
#pragma unroll
            for (int w = 0; w < 8; ++w) { const int c = wc[j * 8 + w]; off += (w < wave) ? c : 0; tot += c; }
            const size_t seg = ((size_t)(bh * 32 + j) * 32 + qb);
            if (f) LIST[seg * 256 + off] = (unsigned char)q;
            if (tid == 0) { CNT[seg] = (unsigned)tot; atomicAdd(&TOT[bh * 32 + j], (unsigned)tot); }
        }
        __syncthreads();
    }
}

namespace rt {
using mb::bf16x8; using mb::s16x4; using mb::f32x16; using mb::u32x4; using mb::crow; using mb::cvtpk; using mb::v_st; using mb::v_rd_base; using mb::v_rd_off;
typedef short v4i16_t __attribute__((ext_vector_type(4)));
typedef __attribute__((address_space(3))) const char* lds_cptr;
__device__ __forceinline__ s16x4 vtr(lds_cptr p) { return __builtin_bit_cast(s16x4, __builtin_amdgcn_ds_read_tr16_b64_v4i16((__attribute__((address_space(3))) v4i16_t*)p)); }
__device__ __forceinline__ bf16x8 tr_frag(lds_cptr base, int d0, int ks) {
  const s16x4 l = vtr(base + v_rd_off(d0, ks, 0)), h = vtr(base + v_rd_off(d0, ks, 1));
  return (bf16x8){l[0], l[1], l[2], l[3], h[0], h[1], h[2], h[3]};
}
__device__ __forceinline__ void pack32(const f32x16& p, bf16x8& pa0, bf16x8& pa1) {
#define RT_PK4(P, BASE, OUT) do { unsigned a0 = pk2(P[BASE + 0], P[BASE + 1]), a1 = pk2(P[BASE + 2], P[BASE + 3]);     \
    unsigned b0 = pk2(P[BASE + 4], P[BASE + 5]), b1 = pk2(P[BASE + 6], P[BASE + 7]);                              \
    auto r0 = __builtin_amdgcn_permlane32_swap(a0, b0, false, false); auto r1 = __builtin_amdgcn_permlane32_swap(a1, b1, false, false); \
    u32x4 w = {r0[0], r1[0], r0[1], r1[1]}; OUT = *reinterpret_cast<bf16x8*>(&w); } while (0)
  RT_PK4(p, 0, pa0); RT_PK4(p, 8, pa1);
#undef RT_PK4
}
constexpr int SROW = 528;
constexpr int SBLK = 32 * SROW;
}

__device__ __forceinline__ void p2_kvsum_mfma(KA A, unsigned char* ldsu) {
    PHASE_IDS();
    char* lds = (char*)ldsu;
    unsigned char* ws = A->ws; const bf16* PROJ = (const bf16*)(ws + WS_PROJ); bf16* ST = (bf16*)(ws + WS_KV);
    const int r32 = lane & 31, hi = lane >> 5, eb = wave >> 1, db0 = 2 * (wave & 1);
    const rt::lds_cptr kb_ = (rt::lds_cptr)lds + mb::v_rd_base(lane), vb_ = (rt::lds_cptr)lds + 32768 + mb::v_rd_base(lane);
    v4u pk[4], pv[4];
    auto fetch = [&](int it) { const int bh = it >> 6, c = it & 63, b = bh >> 2, h = bh & 3; const size_t t0 = (size_t)b * SEQ + c * 128;
#pragma unroll
        for (int i = 0; i < 4; ++i) { const int ch = tid + i * 512, r = ch >> 4, c16 = ch & 15;
            pk[i] = *(const v4u*)(PROJ + (t0 + r) * INW + C_RK + h * HD + c16 * 8); pv[i] = *(const v4u*)(PROJ + (t0 + r) * INW + C_RV + h * HD + c16 * 8); } };
    if (vcu < 16 * NCH) fetch(vcu);
    for (int it = vcu; it < 16 * NCH; it += G) {
#pragma unroll
        for (int i = 0; i < 4; ++i) { const int ch = tid + i * 512, r = ch >> 4, c16 = ch & 15; const int dst = (r >> 6) * 16384 + mb::v_st(r & 63, c16 * 8);
            *(v4u*)(lds + dst) = pk[i]; *(v4u*)(lds + 32768 + dst) = pv[i]; }
        __syncthreads();
        if (it + G < 16 * NCH) fetch(it + G);
        rt::f32x16 acc[2]; acc[0] = rt::f32x16{}; acc[1] = rt::f32x16{};
#pragma unroll
        for (int k8 = 0; k8 < 8; ++k8) { const int buf = (k8 >> 2) * 16384, ks = k8 & 3;
            const rt::bf16x8 af = rt::tr_frag(vb_ + buf, eb, ks);
#pragma unroll
            for (int dd = 0; dd < 2; ++dd) { const rt::bf16x8 bf_ = rt::tr_frag(kb_ + buf, db0 + dd, ks);
                acc[dd] = __builtin_amdgcn_mfma_f32_32x32x16_bf16(af, bf_, acc[dd], 0, 0, 0); } }
        bf16* o = ST + (size_t)it * 16384;
#pragma unroll
        for (int dd = 0; dd < 2; ++dd)
#pragma unroll
            for (int r = 0; r < 16; ++r) o[(32 * eb + rt::crow(r, hi)) * 128 + 32 * (db0 + dd) + r32] = (bf16)(pk2(acc[dd][r], 0.f) & 0xffffu);
        __syncthreads();
    }
}

template <bool PL>
__device__ __forceinline__ void p4_ret_mfma(KA A, int L, unsigned char* ldsu) {
    PHASE_IDS();
    char* lds = (char*)ldsu;
    unsigned char* ws = A->ws; bf16* PROJ = (bf16*)(ws + WS_PROJ); const bf16* ST = (const bf16*)(ws + WS_KV);
    const int r32 = lane & 31, hi = lane >> 5, wq = wave & 3, eh = wave >> 2;
    char* Ks = lds; char* Ss = lds + 65536;
    const rt::lds_cptr vb_ = (rt::lds_cptr)lds + 32768 + mb::v_rd_base(lane);
    v4u pk[4], pv[4], ps[4]; rt::bf16x8 qn[8];
    auto fetch = [&](int it) { const int bh = it >> 6, c = it & 63, b = bh >> 2, h = bh & 3; const size_t t0 = (size_t)b * SEQ + c * 128;
        const bf16* Qw = PROJ + (t0 + 32 * wq + r32) * INW + C_RQ + h * HD + hi * 8;
#pragma unroll
        for (int d0 = 0; d0 < 8; ++d0) qn[d0] = *reinterpret_cast<const rt::bf16x8*>(Qw + d0 * 16);
#pragma unroll
        for (int i = 0; i < 4; ++i) { const int ch = tid + i * 512, r = ch >> 4, c16 = ch & 15;
            pk[i] = *(const v4u*)(PROJ + (t0 + r) * INW + C_RK + h * HD + c16 * 8); pv[i] = *(const v4u*)(PROJ + (t0 + r) * INW + C_RV + h * HD + c16 * 8);
            ps[i] = __builtin_nontemporal_load((const v4u*)(ST + (size_t)it * 16384 + r * 128 + c16 * 8)); } };
    auto item = [&](int j) -> int { if constexpr (PL) { const int p_ = 16 * (bx_ & 7) + ((bx_ >> 3) & 7) + 8 * (j >> 1); return ((p_ >> 5) * 4 + (bx_ >> 6)) * 64 + 2 * (p_ & 31) + (j & 1); } else return vcu + j * G; };
    const int nit = PL ? 4 : (vcu < 16 * NCH ? (16 * NCH - vcu + G - 1) / G : 0);
    if (nit > 0) fetch(item(0));
    for (int j = 0; j < nit; ++j) { const int it = item(j);
        const int bh = it >> 6, c = it & 63, b = bh >> 2, h = bh & 3;
        const size_t t0 = (size_t)b * SEQ + c * 128;
        rt::bf16x8 qr[8];
#pragma unroll
        for (int d0 = 0; d0 < 8; ++d0) qr[d0] = qn[d0];
#pragma unroll
        for (int i = 0; i < 4; ++i) { const int ch = tid + i * 512, r = ch >> 4, c16 = ch & 15;
            *(v4u*)(Ks + MB_KSWZ(r, c16 * 16)) = pk[i];
            *(v4u*)(lds + 32768 + (r >> 6) * 16384 + mb::v_st(r & 63, c16 * 8)) = pv[i];
            *(v4u*)(Ss + MB_KSWZ(r, c16 * 16)) = ps[i]; }
        __syncthreads();
        if (j + 1 < nit) fetch(item(j + 1));
        rt::f32x16 o[2]; o[0] = rt::f32x16{}; o[1] = rt::f32x16{};
#pragma unroll
        for (int kb = 0; kb < 4; ++kb) {
            if (kb <= wq) {
                rt::f32x16 p = rt::f32x16{};
#pragma unroll
                for (int d0 = 0; d0 < 8; ++d0) { const rt::bf16x8 kf = *reinterpret_cast<const rt::bf16x8*>(Ks + MB_KSWZ(32 * kb + r32, (d0 * 16 + hi * 8) * 2));
                    p = __builtin_amdgcn_mfma_f32_32x32x16_bf16(kf, qr[d0], p, 0, 0, 0); }
                if (kb == wq) {
#pragma unroll
                    for (int r = 0; r < 16; ++r) p[r] = (rt::crow(r, hi) <= r32) ? p[r] : 0.f; }
                rt::bf16x8 pa0, pa1; rt::pack32(p, pa0, pa1);
                const int buf = (kb >> 1) * 16384, ks0 = 2 * (kb & 1);
#pragma unroll
                for (int dd = 0; dd < 2; ++dd) { const rt::bf16x8 v0 = rt::tr_frag(vb_ + buf, 2 * eh + dd, ks0), v1 = rt::tr_frag(vb_ + buf, 2 * eh + dd, ks0 + 1);
                    o[dd] = __builtin_amdgcn_mfma_f32_32x32x16_bf16(pa0, v0, o[dd], 0, 0, 0);
                    o[dd] = __builtin_amdgcn_mfma_f32_32x32x16_bf16(pa1, v1, o[dd], 0, 0, 0); }
            }
        }
#pragma unroll
        for (int dd = 0; dd < 2; ++dd)
#pragma unroll
            for (int s = 0; s < 8; ++s) { const rt::bf16x8 sf = *reinterpret_cast<const rt::bf16x8*>(Ss + MB_KSWZ(32 * (2 * eh + dd) + r32, (s * 16 + hi * 8) * 2));
                o[dd] = __builtin_amdgcn_mfma_f32_32x32x16_bf16(qr[s], sf, o[dd], 0, 0, 0); }
        __syncthreads();
        { char* stg = lds + wq * rt::SBLK;
#pragma unroll
          for (int dd = 0; dd < 2; ++dd)
#pragma unroll
              for (int r = 0; r < 16; ++r) *(float*)(stg + rt::crow(r, hi) * rt::SROW + (32 * (2 * eh + dd) + r32) * 4) = o[dd][r]; }
        __syncthreads();
        {   int tid_e = tid; asm volatile("" : "+v"(tid_e));
            const int n = tid_e >> 2, part = tid_e & 3;
            const char* src = lds + (n >> 5) * rt::SBLK + (n & 31) * rt::SROW + part * 128;
            float ov[32];
#pragma unroll
            for (int q = 0; q < 8; ++q) { const f32x4 v = *(const f32x4*)(src + q * 16); ov[q * 4 + 0] = v[0]; ov[q * 4 + 1] = v[1]; ov[q * 4 + 2] = v[2]; ov[q * 4 + 3] = v[3]; }
            float sm = 0.f;
#pragma unroll
            for (int i = 0; i < 32; ++i) sm += ov[i];
            sm += __shfl_xor(sm, 1); sm += __shfl_xor(sm, 2);
            const float mean = sm * (1.0f / 128.0f);
            float vr = 0.f;
#pragma unroll
            for (int i = 0; i < 32; ++i) { const float dlt = ov[i] - mean; vr += dlt * dlt; }
            vr += __shfl_xor(vr, 1); vr += __shfl_xor(vr, 2);
            const float rstd = 1.0f / sqrtf(vr * (1.0f / 128.0f) + pg8::EPS);
            const float* gn = A->ret_norm_g + L * 512 + h * HD + part * 32;
            const bf16* zrow = PROJ + (t0 + n) * INW + C_RZ + h * HD + part * 32;
            bf16* orow = PROJ + (t0 + n) * INW + C_RQ + h * HD + part * 32;
#pragma unroll
            for (int q = 0; q < 4; ++q) { const v4u zw = __builtin_nontemporal_load((const v4u*)(zrow + q * 8)); const f32x4 g0 = *(const f32x4*)(gn + q * 8), g1 = *(const f32x4*)(gn + q * 8 + 4);
                const float z[8] = {bflo(zw.x), bfhi(zw.x), bflo(zw.y), bfhi(zw.y), bflo(zw.z), bfhi(zw.z), bflo(zw.w), bfhi(zw.w)};
                float r[8];
#pragma unroll
                for (int e = 0; e < 8; ++e) { const float gg = (e < 4) ? g0[e & 3] : g1[e & 3]; r[e] = (ov[q * 8 + e] - mean) * rstd * gg * (z[e] / (1.0f + __expf(-z[e]))); }
                v4u w; w.x = pk2(r[0], r[1]); w.y = pk2(r[2], r[3]); w.z = pk2(r[4], r[5]); w.w = pk2(r[6], r[7]);
                *(v4u*)(orow + q * 8) = w; }
        }
        __syncthreads();
    }
}


template <bool G256> __global__ void __launch_bounds__(NWAVES * 64, 2) hymba_fwd(Args args_unused) {
    extern __shared__ __attribute__((aligned(16))) unsigned char lds[];
    LAS unsigned char* ldsl = (LAS unsigned char*)lds;
    volatile LAS unsigned* MISC = (volatile LAS unsigned*)(ldsl + MISC_OFF);
    { const int tid = threadIdx.x; for (int u = tid; u < (LDS_BYTES - LDSCTL_OFF) / 4; u += NWAVES * 64) ((LAS unsigned*)(ldsl + LDSCTL_OFF))[u] = 0u; }
    __syncthreads();
    (void)xcd_barrier_post((unsigned*)(get_ka()->ws + WS_CTL) + CW_BAR, MISC + 8);
    { int bx_ = blockIdx.x; asm volatile("" : "+s"(bx_)); unsigned* gx_ = (unsigned*)(get_ka()->ws + WS_CTL) + CW_GRP + (bx_ & 63) * 32 + 1; const unsigned xbit_ = 1u << xb_xcc_id(); if (threadIdx.x == 0) (void)__hip_atomic_fetch_or(gx_, xbit_, __ATOMIC_RELAXED, __HIP_MEMORY_SCOPE_AGENT); }
#define GRID_BAR() do { XcdBarrier b_; b_.bar = (unsigned*)(get_ka()->ws + WS_CTL) + CW_BAR; b_.x = xb_xcc_id(); b_.st = (volatile LAS unsigned*)((LAS unsigned char*)lds + MISC_OFF) + 8; xcd_barrier(b_); } while (0)
#define WSP(T, off) ((T*)(ka->ws + (off)))
#define WSPK(T, off) ((T*)(get_ka()->ws + (off)))
#define GROUP_BAR(k) do { if constexpr (!G256) { GRID_BAR(); } else { \
        asm volatile("s_waitcnt vmcnt(0)" ::: "memory"); __syncthreads(); \
        if (threadIdx.x == 64) { asm volatile("buffer_inv sc1" ::: "memory"); asm volatile("s_waitcnt vmcnt(0)" ::: "memory"); }     \
        if (threadIdx.x == 0) { unsigned* bar_ = (unsigned*)(get_ka()->ws + WS_CTL) + CW_BAR; unsigned* cnt_ = (unsigned*)(get_ka()->ws + WS_CTL) + CW_GRP + (blockIdx.x & 63) * 32; \
            __builtin_amdgcn_s_waitcnt(0); \
            { const unsigned xm_ = (unsigned)__builtin_amdgcn_readfirstlane((int)xb_ld(cnt_ + 1)); if (xm_ & (xm_ - 1u)) { __builtin_amdgcn_fence(__ATOMIC_RELEASE, "agent"); asm volatile("s_waitcnt vmcnt(0)" ::: "memory"); } }     \
            (void)xb_add(cnt_, 1u); XB_SPIN(xb_ld(cnt_) < 4u * (k), bar_); \
            asm volatile("s_waitcnt vmcnt(0)" ::: "memory"); } \
        __syncthreads(); } } while (0)

#if defined(PROBE_T0)
#define STAMP() do { if (blockIdx.x == 0 && threadIdx.x == 0) { const unsigned k_ = MISC[31]; MISC[32 + k_] = (unsigned)__builtin_amdgcn_s_memrealtime(); MISC[31] = k_ + 1; } } while (0)
#else
#define STAMP() do { } while (0)
#endif
    STAMP();
    p0_prologue(get_ka(), ldsl);
    GRID_BAR(); STAMP();

    for (int L = 0; L < DEPTH; ++L) {
#if defined(PROBE_T0)
#define INPROJ_CHAIN false
#else
#define INPROJ_CHAIN true
#endif
#define INPROJ_PART(KIND, CIN, NEXTKIND) {   KA ka = get_ka(); int bx = blockIdx.x; asm volatile("" : "+s"(bx)); const int G = gridDim.x; \
            pg8::Gemm g{WSP(bf16, WS_XB), WSP(const bf16, WS_WIN) + (size_t)L * INW * DM, M, INW, DM, DM}; pg8::SubsetOrder S; S.init(M, KIND, G, bx); \
            const char* chA = nullptr; const char* chB = nullptr; bool cin = false; pg8::Unit u0, u1; \
            if (CIN >= 0) { pg8::SubsetOrder Sp; Sp.init(M, CIN, G, bx); cin = Sp.next(0, u1) && S.next(0, u0); } \
            if (NEXTKIND >= 0) { pg8::SubsetOrder Sn; Sn.init(M, NEXTKIND, G, bx); if (S.next(0, u1) && Sn.next(0, u0)) { chA = (const char*)g.A + (size_t)u0.pm * (256 * DM * 2); chB = (const char*)g.Bt + (size_t)u0.pn * (256 * DM * 2); } } \
            pg8::EpiProj<KIND, G256> E{WSP(bf16, WS_PROJ), INW, WSP(float, WS_RSX), WSP(const float, WS_TAB), ka->q_norm_g + L * HD, ka->k_norm_g + L * HD, WSP(float, WS_KMEAN), (LAS float*)(ldsl + RING_BYTES), (const LAS float*)(ldsl + LDS_RS_OFF), WSP(bf16, WS_EPRE)}; E.rw = nullptr; E.qc = (bf16*)((unsigned char*)ka->out + 96 * MiB); \
            if constexpr (G256) { if (CIN < 0) { int t_ = threadIdx.x; asm volatile("" : "+v"(t_)); const f32x4* p_ = (const f32x4*)(WSP(const float, WS_RSX) + ((size_t)(16 * (bx & 7) + ((bx >> 3) & 7) + 8 * (t_ >> 8)) * 256 + (t_ & 255)) * 16); \
                E.f0 = p_[0]; E.f1 = p_[1]; E.f2 = p_[2]; E.f3 = p_[3]; E.rw = (LAS float*)(ldsl + LDS_RS_OFF) + t_; } } \
            pg8::gemm_phase<pg8::EpiProj<KIND, G256>, pg8::SubsetOrder, true, true, INPROJ_CHAIN>(ldsl + RING_OFF, g, S, E, cin, chA, chB); }
        INPROJ_PART(2, -1, 0)
        INPROJ_PART(0, 2, 1)
        INPROJ_PART(1, 0, -1)
        GRID_BAR(); STAMP();
        p2_kvsum_mfma(get_ka(), lds); STAMP();
        p2b_gating_mfma<G256>(get_ka(), L, lds);
        GRID_BAR(); STAMP();
        if constexpr (G256) { p3_moba_sel2<G256>(get_ka(), L, lds); STAMP(); p3_scan<true>(get_ka(), L, MISC + 20); }
        else { p3_scan<false>(get_ka(), L, MISC + 20); STAMP(); p3_moba_sel2<G256>(get_ka(), L, lds); }
        GRID_BAR(); STAMP();
        p4_ret_mfma<G256>(get_ka(), L, lds); STAMP();
        p4_moba_own2<G256>(get_ka(), lds);
        if (G256 && L + 1 < DEPTH) { GROUP_BAR(3 * L + 1); } else { GRID_BAR(); }
        STAMP();
        {   KA ka = get_ka(); int bx = blockIdx.x; asm volatile("" : "+s"(bx)); const int G = gridDim.x;
            pg8::Gemm g{WSP(bf16, WS_PROJ), WSP(const bf16, WS_WOUT) + (size_t)L * DM * DM, M, DM, DM, INW}; pg8::StaticOrder S; S.init(M, DM, G, bx);
            pg8::EpiRes<true> E{WSP(const bf16, WS_XB), WSP(bf16, WS_PROJ) + C_X1B, WSP(float, WS_RSX1), DM, INW};
            pg8::gemm_phase<pg8::EpiRes<true>, pg8::StaticOrder, true, true>(ldsl + RING_OFF, g, S, E); }
        {   KA ka = get_ka(); int bx = blockIdx.x; asm volatile("" : "+s"(bx)); const int G = gridDim.x;
            pg8::Gemm g{WSP(bf16, L == 0 ? WS_PE : WS_PE2), WSP(const bf16, WS_WPLE) + (size_t)L * DM * PLE, M, DM, PLE, PLE}; pg8::StaticOrder S; S.init(M, DM, G, bx);
            pg8::EpiE E{WSP(bf16, WS_EPRE), DM, WSP(float, WS_RSE)};
            pg8::gemm_phase<pg8::EpiE, pg8::StaticOrder, true, true>(ldsl + RING_OFF, g, S, E); }
        GROUP_BAR(L + 1 < DEPTH ? 3 * L + 2 : 3 * (DEPTH - 1) + 1); STAMP();
        if (L + 1 < DEPTH) {   KA ka = get_ka(); int bx = blockIdx.x; asm volatile("" : "+s"(bx)); const int G = gridDim.x;
            pg8::Gemm g{WSP(bf16, WS_PROJ) + C_X1B, WSP(const bf16, WS_WG) + (size_t)L * DM * DM, M, DM, DM, INW}; pg8::StaticOrder S; S.init(M, DM, G, bx);
            pg8::EpiGate<false, G256> E{WSP(const bf16, WS_PROJ) + C_X1B, INW, WSP(const bf16, WS_EPRE), WSP(const float, WS_RSX1), WSP(const float, WS_RSE), ka->ple_norm_g + L * DM, WSP(bf16, WS_XB), WSP(float, WS_RSX), nullptr, DM, (const LAS float*)(ldsl + LDS_RS_OFF + 2048), (const LAS float*)(ldsl + LDS_RS_OFF + 4096), (const LAS float*)(ldsl + LDS_RS_OFF + 6144)};
            if constexpr (G256) { int t_ = threadIdx.x; asm volatile("" : "+v"(t_)); const size_t r_ = ((size_t)(16 * (bx & 7) + ((bx >> 3) & 7) + 8 * (t_ >> 8)) * 256 + (t_ & 255)) * 16; const f32x4* p1_ = (const f32x4*)(WSP(const float, WS_RSX1) + r_); const f32x4* pe_ = (const f32x4*)(WSP(const float, WS_RSE) + r_);
                E.f1q[0] = p1_[0]; E.f1q[1] = p1_[1]; E.f1q[2] = p1_[2]; E.f1q[3] = p1_[3]; E.feq[0] = pe_[0]; E.feq[1] = pe_[1]; E.feq[2] = pe_[2]; E.feq[3] = pe_[3];
                E.gq = ka->ple_norm_g[L * DM + (bx >> 6) * 256 + (t_ & 255)]; E.rw = (LAS float*)(ldsl + LDS_RS_OFF + 2048) + t_; }
            pg8::gemm_phase<pg8::EpiGate<false, G256>, pg8::StaticOrder, true, true>(ldsl + RING_OFF, g, S, E); }
        else {                 KA ka = get_ka(); int bx = blockIdx.x; asm volatile("" : "+s"(bx)); const int G = gridDim.x;
            pg8::Gemm g{WSP(bf16, WS_PROJ) + C_X1B, WSP(const bf16, WS_WG) + (size_t)L * DM * DM, M, DM, DM, INW}; pg8::StaticOrder S; S.init(M, DM, G, bx);
            pg8::EpiGate<true, G256> E{WSP(const bf16, WS_PROJ) + C_X1B, INW, WSP(const bf16, WS_EPRE), WSP(const float, WS_RSX1), WSP(const float, WS_RSE), ka->ple_norm_g + L * DM, nullptr, nullptr, ka->out, DM, (const LAS float*)(ldsl + LDS_RS_OFF + 2048), (const LAS float*)(ldsl + LDS_RS_OFF + 4096), (const LAS float*)(ldsl + LDS_RS_OFF + 6144)};
            if constexpr (G256) { int t_ = threadIdx.x; asm volatile("" : "+v"(t_)); const size_t r_ = ((size_t)(16 * (bx & 7) + ((bx >> 3) & 7) + 8 * (t_ >> 8)) * 256 + (t_ & 255)) * 16; const f32x4* p1_ = (const f32x4*)(WSP(const float, WS_RSX1) + r_); const f32x4* pe_ = (const f32x4*)(WSP(const float, WS_RSE) + r_);
                E.f1q[0] = p1_[0]; E.f1q[1] = p1_[1]; E.f1q[2] = p1_[2]; E.f1q[3] = p1_[3]; E.feq[0] = pe_[0]; E.feq[1] = pe_[1]; E.feq[2] = pe_[2]; E.feq[3] = pe_[3];
                E.gq = ka->ple_norm_g[L * DM + (bx >> 6) * 256 + (t_ & 255)]; E.rw = (LAS float*)(ldsl + LDS_RS_OFF + 2048) + t_; }
            pg8::gemm_phase<pg8::EpiGate<true, G256>, pg8::StaticOrder, true, true>(ldsl + RING_OFF, g, S, E); }
        if (L + 1 < DEPTH) {
            {   KA ka = get_ka(); PHASE_IDS();
                const long gtid = (long)vcu * (NWAVES * 64) + tid, gthreads = (long)G * NWAVES * 64;
                cvt_f32_bf16(ka->p + (size_t)(L + 1) * M * PLE, WSP(bf16, WS_PE2), (long)M * PLE / 8, gtid, gthreads); }
            GROUP_BAR(3 * L + 3); STAMP();
        }
    }
#if defined(PROBE_T0)
    GRID_BAR(); STAMP();
    if (blockIdx.x == 0 && threadIdx.x == 0) get_ka()->out[0] = 1000.0f * (float)((MISC[32 + PROBE_T1] - MISC[32 + PROBE_T0] + PROBE_OFF) / PROBE_BKT);
#endif
}

extern "C" void kernel_launch(void* const* d_in, const int* in_sizes, int n_in, void* d_out, int out_size, void* d_ws, size_t ws_size, hipStream_t stream) {
    static int grid = 0;
    if (grid == 0) {
        if (n_in != 12 || in_sizes[0] != M * DM || out_size != M * DM || ws_size < 512 * MiB) {
            fprintf(stderr, "kernel_launch: shape mismatch: n_in %d in0 %d out %d ws %zu (need >= %zu)\n", n_in, n_in > 0 ? in_sizes[0] : -1, out_size, ws_size, (size_t)(512 * MiB)); grid = -1; return; }
        int dev = 0, cus = 0, per_cu = 0;
        if (hipGetDevice(&dev) != hipSuccess || hipDeviceGetAttribute(&cus, hipDeviceAttributeMultiprocessorCount, dev) != hipSuccess) { fprintf(stderr, "kernel_launch: device query failed\n"); grid = -1; return; }
        const void* kfn = (cus == 256) ? (const void*)hymba_fwd<true> : (const void*)hymba_fwd<false>;
        if (hipFuncSetAttribute(kfn, hipFuncAttributeMaxDynamicSharedMemorySize, LDS_BYTES) != hipSuccess) { fprintf(stderr, "kernel_launch: hipFuncSetAttribute failed\n"); grid = -1; return; }
        if (hipOccupancyMaxActiveBlocksPerMultiprocessor(&per_cu, kfn, NWAVES * 64, LDS_BYTES) != hipSuccess || per_cu < 1)
            fprintf(stderr, "kernel_launch: note: occupancy query reports %d workgroups per CU\n", per_cu);
        (void)hipGetLastError();
        grid = cus;
        if (cus != 256) fprintf(stderr, "kernel_launch: note: %d CUs reported; the unit counts of the phases are tuned for 256 workgroups (any grid that is fully resident is still correct)\n", cus);
        fprintf(stderr, "kernel_launch: grid %d, ws %zu bytes\n", grid, ws_size);
    }
    if (grid < 0) return;
    if (hipMemsetAsync((char*)d_ws + WS_CTL, 0, CTL_ZERO_BYTES, stream) != hipSuccess) { fprintf(stderr, "kernel_launch: memset failed\n"); return; }
    Args a{};
    a.x = (const float*)d_in[0]; a.p = (const float*)d_in[1]; a.norm_g = (const float*)d_in[2]; a.w_in = (const float*)d_in[3]; a.ret_norm_g = (const float*)d_in[4];
    a.q_norm_g = (const float*)d_in[5]; a.k_norm_g = (const float*)d_in[6]; a.rel_bias = (const float*)d_in[7]; a.w_out = (const float*)d_in[8]; a.w_ple = (const float*)d_in[9];
    a.ple_norm_g = (const float*)d_in[10]; a.w_ple_gate = (const float*)d_in[11]; a.out = (float*)d_out; a.ws = (unsigned char*)d_ws;
    if (grid == 256) hipLaunchKernelGGL(hymba_fwd<true>, dim3(grid), dim3(NWAVES * 64), LDS_BYTES, stream, a);
    else hipLaunchKernelGGL(hymba_fwd<false>, dim3(grid), dim3(NWAVES * 64), LDS_BYTES, stream, a);
    const hipError_t le = hipPeekAtLastError();
    if (le != hipSuccess) fprintf(stderr, "kernel_launch: launch failed: %s\n", hipGetErrorName(le));
}
```
